# Optimizing an MI355X kernel written in HIP

```python
import math
import jax, jax.numpy as jnp
from jax import lax
import numpy as np

D_MODEL = 2048
BATCH = 8
SEQ = 2048
DEPTH = 1

CHUNK = 64
D_MIX = D_MODEL
D_SSM = D_MIX // 2
D_SGU = D_MIX - D_SSM
SSM_GROUP = 16
SSM_GROUPS = D_SSM // SSM_GROUP
SSM_STATE = 64
SGU_BLOCK = 128
SGU_HEADS = 8
SGU_HEAD_DIM = D_SGU // SGU_HEADS
D_FF = 4 * D_MODEL
D_IN = 2 * D_SSM + 2 * D_SGU
EPS = 1e-5
DT_MIN = 1e-3
DT_MAX = 1e-1

kernel_name = 'hybrid_s5_gmlp_parallel_heads'


def rms_norm(x, gain):
    xf = x.astype(jnp.float32)
    y = xf * lax.rsqrt(jnp.mean(xf * xf, axis=-1, keepdims=True) + EPS)
    return (y * gain.astype(jnp.float32)).astype(x.dtype)


def _complex_linear_combine(left, right):
    ar1, ai1, br1, bi1 = left
    ar2, ai2, br2, bi2 = right
    ar = ar2 * ar1 - ai2 * ai1
    ai = ar2 * ai1 + ai2 * ar1
    br = ar2 * br1 - ai2 * bi1 + br2
    bi = ar2 * bi1 + ai2 * br1 + bi2
    return (ar, ai, br, bi)


def s5_heads(u, g, a_re, a_im, log_dt, b_re, b_im, c_re, c_im, d_skip):
    bsz, seq, _ = u.shape
    f32 = jnp.float32
    uf = u.astype(f32).reshape(bsz, seq, SSM_GROUPS, SSM_GROUP)
    dt = jnp.exp(log_dt.astype(f32))[:, None]
    lam_re = jnp.minimum(a_re.astype(f32), -1e-4)
    lam_im = a_im.astype(f32)
    decay = jnp.exp(lam_re * dt)
    abar_re = decay * jnp.cos(lam_im * dt)
    abar_im = decay * jnp.sin(lam_im * dt)
    den = lam_re * lam_re + lam_im * lam_im
    num_re = abar_re - 1.0
    coef_re = (num_re * lam_re + abar_im * lam_im) / den
    coef_im = (abar_im * lam_re - num_re * lam_im) / den
    br = b_re.astype(f32)
    bi = b_im.astype(f32)
    bbar_re = coef_re[..., None] * br - coef_im[..., None] * bi
    bbar_im = coef_re[..., None] * bi + coef_im[..., None] * br
    bu_re = jnp.einsum('gnh,blgh->blgn', bbar_re, uf)
    bu_im = jnp.einsum('gnh,blgh->blgn', bbar_im, uf)
    a_seq_re = jnp.broadcast_to(abar_re[None, None], (1, seq) + abar_re.shape)
    a_seq_im = jnp.broadcast_to(abar_im[None, None], (1, seq) + abar_im.shape)
    _, _, s_re, s_im = lax.associative_scan(
        _complex_linear_combine, (a_seq_re, a_seq_im, bu_re, bu_im), axis=1)
    y = (jnp.einsum('ghn,blgn->blgh', c_re.astype(f32), s_re)
         - jnp.einsum('ghn,blgn->blgh', c_im.astype(f32), s_im)
         + d_skip.astype(f32).reshape(SSM_GROUPS, SSM_GROUP) * uf)
    y = y.reshape(bsz, seq, D_SSM)
    return (jax.nn.gelu(y) * jax.nn.sigmoid(g.astype(f32))).astype(u.dtype)


def sgu_heads(z, v_gain, w_s, b_s):
    bsz, seq, _ = z.shape
    z = jax.nn.gelu(z)
    u, v = jnp.split(z, 2, axis=-1)
    v = rms_norm(v, v_gain)
    v = v.reshape(bsz, seq // SGU_BLOCK, SGU_BLOCK, SGU_HEADS, SGU_HEAD_DIM)
    chunk_id = jnp.arange(SGU_BLOCK) // CHUNK
    mask = (chunk_id[None, :] <= chunk_id[:, None]).astype(w_s.dtype)
    w = w_s * mask[None]
    mixed = jnp.einsum('hij,bnjhc->bnihc', w, v) + b_s.T[None, None, :, :, None]
    return u * mixed.reshape(bsz, seq, D_SGU)


def setup_inputs(seed: int = 0) -> dict:
    key = jax.random.key(seed)
    ks = jax.random.split(key, 24)
    f32 = jnp.float32
    n_idx = jnp.arange(SSM_STATE, dtype=f32)
    x = jax.random.normal(ks[0], (BATCH, SEQ, D_MODEL), f32)
    w_in = jax.random.normal(ks[1], (DEPTH, D_MODEL, D_IN), f32) * D_MODEL ** -0.5
    ssm_a_re = -0.5 * (1.0 + 0.05 * jax.random.normal(ks[2], (DEPTH, SSM_GROUPS, SSM_STATE), f32))
    ssm_a_im = math.pi * n_idx[None, None, :] + 0.01 * jax.random.normal(ks[3], (DEPTH, SSM_GROUPS, SSM_STATE), f32)
    ssm_log_dt = jax.random.uniform(ks[4], (DEPTH, SSM_GROUPS), f32, math.log(DT_MIN), math.log(DT_MAX))
    ssm_b_re = jax.random.normal(ks[5], (DEPTH, SSM_GROUPS, SSM_STATE, SSM_GROUP), f32) * (2 * SSM_GROUP) ** -0.5
    ssm_b_im = jax.random.normal(ks[6], (DEPTH, SSM_GROUPS, SSM_STATE, SSM_GROUP), f32) * (2 * SSM_GROUP) ** -0.5
    ssm_c_re = jax.random.normal(ks[7], (DEPTH, SSM_GROUPS, SSM_GROUP, SSM_STATE), f32) * SSM_STATE ** -0.5
    ssm_c_im = jax.random.normal(ks[8], (DEPTH, SSM_GROUPS, SSM_GROUP, SSM_STATE), f32) * SSM_STATE ** -0.5
    ssm_d = jax.random.normal(ks[9], (DEPTH, D_SSM), f32)
    sgu_v_gain = 1.0 + 0.02 * jax.random.normal(ks[10], (DEPTH, D_SGU), f32)
    sgu_w = jax.random.normal(ks[11], (DEPTH, SGU_HEADS, SGU_BLOCK, SGU_BLOCK), f32) * SGU_BLOCK ** -0.5
    sgu_b = 1.0 + 0.1 * jax.random.normal(ks[12], (DEPTH, SGU_HEADS, SGU_BLOCK), f32)
    out_gain_ssm = 1.0 + 0.02 * jax.random.normal(ks[13], (DEPTH, D_SSM), f32)
    out_gain_sgu = 1.0 + 0.02 * jax.random.normal(ks[14], (DEPTH, D_SGU), f32)
    w_out = jax.random.normal(ks[15], (DEPTH, D_MIX, D_MODEL), f32) * D_MIX ** -0.5
    mix_norm_gain = 1.0 + 0.02 * jax.random.normal(ks[16], (DEPTH, D_MODEL), f32)
    ffn_norm_gain = 1.0 + 0.02 * jax.random.normal(ks[17], (DEPTH, D_MODEL), f32)
    w_ff1 = jax.random.normal(ks[18], (DEPTH, D_MODEL, D_FF), f32) * D_MODEL ** -0.5
    w_ff2 = jax.random.normal(ks[19], (DEPTH, D_FF, D_MODEL), f32) * D_FF ** -0.5
    final_norm_gain = 1.0 + 0.02 * jax.random.normal(ks[20], (D_MODEL,), f32)
    return {'x': x, 'w_in': w_in, 'ssm_a_re': ssm_a_re, 'ssm_a_im': ssm_a_im,
            'ssm_log_dt': ssm_log_dt, 'ssm_b_re': ssm_b_re, 'ssm_b_im': ssm_b_im,
            'ssm_c_re': ssm_c_re, 'ssm_c_im': ssm_c_im, 'ssm_d': ssm_d,
            'sgu_v_gain': sgu_v_gain, 'sgu_w': sgu_w, 'sgu_b': sgu_b,
            'out_gain_ssm': out_gain_ssm, 'out_gain_sgu': out_gain_sgu, 'w_out': w_out,
            'mix_norm_gain': mix_norm_gain, 'ffn_norm_gain': ffn_norm_gain,
            'w_ff1': w_ff1, 'w_ff2': w_ff2, 'final_norm_gain': final_norm_gain}


def reference(x, w_in, ssm_a_re, ssm_a_im, ssm_log_dt, ssm_b_re, ssm_b_im, ssm_c_re, ssm_c_im,
              ssm_d, sgu_v_gain, sgu_w, sgu_b, out_gain_ssm, out_gain_sgu, w_out,
              mix_norm_gain, ffn_norm_gain, w_ff1, w_ff2, final_norm_gain):
    h = x
    for layer in range(DEPTH):
        hn = rms_norm(h, mix_norm_gain[layer])
        proj = hn @ w_in[layer]
        u_a, g_a, z_b = jnp.split(proj, [D_SSM, 2 * D_SSM], axis=-1)
        y_a = s5_heads(u_a, g_a, ssm_a_re[layer], ssm_a_im[layer], ssm_log_dt[layer],
                       ssm_b_re[layer], ssm_b_im[layer], ssm_c_re[layer], ssm_c_im[layer],
                       ssm_d[layer])
        y_b = sgu_heads(z_b, sgu_v_gain[layer], sgu_w[layer], sgu_b[layer])
        mixed = jnp.concatenate([rms_norm(y_a, out_gain_ssm[layer]),
                                 rms_norm(y_b, out_gain_sgu[layer])], axis=-1)
        h = h + mixed @ w_out[layer]
        hn = rms_norm(h, ffn_norm_gain[layer])
        h = h + jnp.square(jax.nn.relu(hn @ w_ff1[layer])) @ w_ff2[layer]
    return rms_norm(h, final_norm_gain)
```

```cpp
#include <hip/hip_runtime.h>
#include <hip/hip_cooperative_groups.h>
#include <cstdio>
#include <cstdint>
namespace cg = cooperative_groups;

#ifndef MK_MULTI
#define MK_MULTI 0
#endif

#define LAS __attribute__((address_space(3)))
typedef unsigned short bf16_t;
typedef short bf16x8 __attribute__((ext_vector_type(8)));
typedef float f32x4 __attribute__((ext_vector_type(4)));
typedef float f32x2 __attribute__((ext_vector_type(2)));
typedef unsigned u32x4 __attribute__((ext_vector_type(4)));
typedef unsigned u32x2 __attribute__((ext_vector_type(2)));

typedef __bf16 bf16x2_t __attribute__((ext_vector_type(2)));
__device__ __forceinline__ unsigned cvt_pk_bf16(float lo, float hi) { const f32x2 v = {lo, hi}; const bf16x2_t b = __builtin_convertvector(v, bf16x2_t); return __builtin_bit_cast(unsigned, b); }
__device__ __forceinline__ float bf_lo(unsigned w) { return __uint_as_float(w << 16); }
__device__ __forceinline__ float bf_hi(unsigned w) { return __uint_as_float(w & 0xffff0000u); }
__device__ __forceinline__ float gelu_tanh(float x) {
    const float t = x * (1.0f + 0.044715f * x * x);
    const float e = __builtin_amdgcn_exp2f(-2.3022081984f * t);
    return x * __builtin_amdgcn_rcpf(1.0f + e);
}
__device__ __forceinline__ float sigmoid_f(float x) { return __builtin_amdgcn_rcpf(1.0f + __builtin_amdgcn_exp2f(-1.4426950409f * x)); }

namespace pg8 {
constexpr int BM = 256, BK = 64, HALF = 128, HTB = HALF * BK * 2, STAGE_BYTES = 8 * HTB, NXCD = 8, WGM = 8;
__host__ __device__ __forceinline__ int lds_byte(int r, int c) { const int st = (r >> 4) * 2 + (c >> 5), rr = r & 15, cc = c & 31, ob = rr * 64 + cc * 2; return st * 1024 + (ob ^ (((ob >> 9) & 1) << 5)); }
__host__ __device__ __forceinline__ void stage_rc(int b, int& R, int& C) { const int st = b / 1024, sb = b % 1024, swz = sb ^ (((sb >> 9) & 1) << 5); R = (st >> 1) * 16 + swz / 64; C = (st & 1) * 32 + (swz % 64) / 2; }
__host__ __device__ __forceinline__ int perm32(int rho) { const int n = rho >> 4, i = rho & 15; return 8 * (i >> 2) + 4 * n + (i & 3); }

struct Unit { int pm, pn; };
struct Gemm { const bf16_t* A; const bf16_t* Bt; int lda, ldb, K; };

struct StaticOrder {
    int nM, nN, nwg, G, c;
    __device__ void init(int M, int N, int G_, int c_) { nM = M / BM; nN = N / BM; nwg = nM * nN; G = G_; c = c_; }
    __device__ bool next(int i, Unit& u) const {
        const long L = (long)i * G + c; if (L >= nwg) return false;
        int wgid = (int)L; { const int q = nwg / NXCD, r = nwg % NXCD, xcd = wgid % NXCD, off = wgid / NXCD; wgid = (xcd < r ? xcd * (q + 1) : r * (q + 1) + (xcd - r) * q) + off; }
        const int nig = WGM * nN, gid = wgid / nig, fm = gid * WGM, gsz = (nM - fm) < WGM ? (nM - fm) : WGM;
        u.pm = fm + ((wgid % nig) % gsz); u.pn = (wgid % nig) / gsz; return true;
    }
};
struct GroupOrder {
    int G, c;
    __device__ void init(int G_, int c_) { G = G_; c = c_; }
    __device__ bool next(int i, Unit& u) const {
        const int L = i * G + c; if (L >= 256) return false;
        const int Lr = (L & 7) * 32 + (L >> 3); u.pm = Lr; u.pn = Lr >> 2; return true;
    }
};

template <class Epi, class Sched, bool ALIGN_EPI>
__device__ __forceinline__ void gemm_phase(LAS unsigned char* lds, const Gemm g, const Sched& S, const Epi& E) {
    const int tid = threadIdx.x, wid = __builtin_amdgcn_readfirstlane(tid >> 6), lane = tid & 63, wr = wid >> 2, wc = wid & 3, fr = lane & 15, fq = lane >> 4;
    int nt = g.K / BK; asm volatile("" : "+s"(nt));
    unsigned voffA[2], voffB[2];
#pragma unroll
    for (int i = 0; i < 2; ++i) { int R, C; stage_rc(tid * 16 + i * 8192, R, C); const int Rb = Epi::PERM ? ((R & ~31) + perm32(R & 31)) : R;
        voffA[i] = (unsigned)(R * g.lda + C) * 2u; voffB[i] = (unsigned)(Rb * g.ldb + C) * 2u; }
    const size_t kstep = (size_t)(BK * 2);
    const size_t hstepA = (size_t)HALF * g.lda * 2, hstepB = (size_t)HALF * g.ldb * 2;
    const size_t tstepA = 2 * hstepA, tstepB = 2 * hstepB;
    const unsigned ldsw = (unsigned)wid * 1024u;
    const int aoff = lds_byte(wr * 64 + fr, fq * 8), boff = lds_byte(wc * 32 + fr, fq * 8);
#define PG8_SA(b, h) (((b) * 2 + (h)) * HTB)
#define PG8_SB(b, h) ((4 + (b) * 2 + (h)) * HTB)
#define PG8_STAGE(bufoff, gbase, voff) do { _Pragma("unroll") for (int _i = 0; _i < 2; ++_i) \
        __builtin_amdgcn_global_load_lds((const unsigned*)((const char*)(gbase) + (voff)[_i]), (LAS unsigned*)(lds + (bufoff) + ldsw + _i * 8192), 16, 0, 0); } while (0)
#define PG8_LDA(dst, b, h) do { _Pragma("unroll") for (int m = 0; m < 4; ++m) _Pragma("unroll") for (int k = 0; k < 2; ++k) dst[m][k] = *(const LAS bf16x8*)(lds + PG8_SA(b, h) + aoff + m * 2048 + k * 1024); } while (0)
#define PG8_LDB(dst, b, h) do { _Pragma("unroll") for (int n = 0; n < 2; ++n) _Pragma("unroll") for (int k = 0; k < 2; ++k) dst[n][k] = *(const LAS bf16x8*)(lds + PG8_SB(b, h) + boff + n * 2048 + k * 1024); } while (0)
#define PG8_MMA(ai, bj, At, Bt) do { __builtin_amdgcn_s_setprio(1); _Pragma("unroll") for (int m = 0; m < 4; ++m) _Pragma("unroll") for (int n = 0; n < 2; ++n) _Pragma("unroll") for (int k = 0; k < 2; ++k) \
        acc[ai][bj][m][n] = __builtin_amdgcn_mfma_f32_16x16x32_bf16(Bt[n][k], At[m][k], acc[ai][bj][m][n], 0, 0, 0); __builtin_amdgcn_s_setprio(0); } while (0)
#define PG8_WAIT_V(n) asm volatile("s_waitcnt vmcnt(" #n ")" ::: "memory")
#define PG8_WAIT_L(n) asm volatile("s_waitcnt lgkmcnt(" #n ")" ::: "memory")
#define PG8_BAR __builtin_amdgcn_s_barrier()
#define PG8_SCHED __builtin_amdgcn_sched_barrier(0)
    Unit cur, nxt; int ui = 0;
    if (!S.next(0, cur)) return;
    f32x4 acc[2][2][4][2];
#pragma unroll
    for (int a = 0; a < 2; ++a)
#pragma unroll
        for (int b = 0; b < 2; ++b)
#pragma unroll
            for (int m = 0; m < 4; ++m)
#pragma unroll
                for (int n = 0; n < 2; ++n) acc[a][b][m][n] = (f32x4){0.f, 0.f, 0.f, 0.f};
    bf16x8 At[4][2], B0[2][2], B1[2][2];
    const char* cA = (const char*)g.A + (size_t)cur.pm * tstepA; const char* cB = (const char*)g.Bt + (size_t)cur.pn * tstepB;
    PG8_STAGE(PG8_SB(0, 0), cB, voffB); PG8_STAGE(PG8_SB(0, 1), cB + hstepB, voffB); PG8_STAGE(PG8_SA(0, 0), cA, voffA); PG8_STAGE(PG8_SA(0, 1), cA + hstepA, voffA);
    if (wr == 1) PG8_BAR;
    PG8_WAIT_V(2); PG8_BAR;
    PG8_STAGE(PG8_SB(1, 0), cB + kstep, voffB); PG8_STAGE(PG8_SA(1, 0), cA + kstep, voffA); PG8_STAGE(PG8_SB(1, 1), cB + hstepB + kstep, voffB);
    PG8_WAIT_V(6); PG8_BAR;
    for (;;) {
        const bool has_next = S.next(ui + 1, nxt);
        const char* nA = has_next ? (const char*)g.A + (size_t)nxt.pm * tstepA : cA; const char* nB = has_next ? (const char*)g.Bt + (size_t)nxt.pn * tstepB : cB;
#pragma nounroll
        for (int t = 0; t < nt; t += 2) {
            const bool last = (t == nt - 2);
            const char* a1 = cA + (size_t)(t + 1) * kstep;
            const char* a2 = last ? nA : cA + (size_t)(t + 2) * kstep; const char* b2 = last ? nB : cB + (size_t)(t + 2) * kstep;
            const char* a3 = a2 + kstep; const char* b3 = b2 + kstep;
            if constexpr (Epi::HAS_MID) { if (t == (nt >> 1)) E.mid(acc, ui, wr, fr); }
            PG8_LDB(B0, 0, 0); PG8_LDB(B1, 0, 1); PG8_SCHED; PG8_LDA(At, 0, 0); PG8_STAGE(PG8_SA(1, 1), a1 + hstepA, voffA);
            PG8_WAIT_V(8); PG8_WAIT_L(0); PG8_BAR; PG8_MMA(0, 0, At, B0); PG8_MMA(0, 1, At, B1); PG8_BAR; PG8_SCHED;
            PG8_LDA(At, 0, 1); PG8_STAGE(PG8_SB(0, 0), b2, voffB); PG8_STAGE(PG8_SB(0, 1), b2 + hstepB, voffB); PG8_STAGE(PG8_SA(0, 0), a2, voffA);
            PG8_WAIT_V(8); PG8_WAIT_L(0); PG8_BAR; PG8_MMA(1, 0, At, B0); PG8_MMA(1, 1, At, B1); PG8_BAR; PG8_SCHED;
            PG8_LDB(B0, 1, 0); PG8_LDB(B1, 1, 1); PG8_SCHED; PG8_LDA(At, 1, 0); PG8_STAGE(PG8_SA(0, 1), a2 + hstepA, voffA);
            PG8_WAIT_V(8); PG8_WAIT_L(0); PG8_BAR; PG8_MMA(0, 0, At, B0); PG8_MMA(0, 1, At, B1); PG8_BAR; PG8_SCHED;
            PG8_LDA(At, 1, 1); PG8_STAGE(PG8_SB(1, 0), b3, voffB); PG8_STAGE(PG8_SB(1, 1), b3 + hstepB, voffB); PG8_STAGE(PG8_SA(1, 0), a3, voffA);
            PG8_WAIT_V(8); PG8_WAIT_L(0); PG8_BAR; PG8_MMA(1, 0, At, B0); PG8_MMA(1, 1, At, B1); PG8_BAR; PG8_SCHED;
        }
        if constexpr (ALIGN_EPI) { if (wr == 0) PG8_BAR; }
        E(acc, cur, ui, wr, wc, fr, fq);
        if (!has_next) break;
#pragma unroll
        for (int a = 0; a < 2; ++a)
#pragma unroll
            for (int b = 0; b < 2; ++b)
#pragma unroll
                for (int m = 0; m < 4; ++m)
#pragma unroll
                    for (int n = 0; n < 2; ++n) acc[a][b][m][n] = (f32x4){0.f, 0.f, 0.f, 0.f};
        cur = nxt; cA = nA; cB = nB; ++ui;
        if constexpr (ALIGN_EPI) { if (wr == 1) PG8_BAR; }
    }
    PG8_WAIT_V(0);
    if constexpr (!ALIGN_EPI) { if (wr == 0) PG8_BAR; }
    PG8_BAR;
#undef PG8_SA
#undef PG8_SB
#undef PG8_STAGE
#undef PG8_LDA
#undef PG8_LDB
#undef PG8_MMA
#undef PG8_WAIT_V
#undef PG8_WAIT_L
#undef PG8_BAR
#undef PG8_SCHED
}
}
using pg8::Unit;

constexpr int BATCH = 8, SEQ = 2048, DM = 2048, M = BATCH * SEQ;
constexpr int DSSM = 1024, DSGU = 1024, DIN = 4096, DFF = 8192;
constexpr int NG = 64, GS = 16, NS = 64;
constexpr int LC = 16, NCH = SEQ / LC;
constexpr int KA = LC * GS + 2 * NS;
constexpr float EPS = 1e-5f;
constexpr int NWAVES = 8, NTHR = 512;

constexpr size_t MiB = 1u << 20;
constexpr size_t WS_WIN = 1 * MiB, WS_WOUT = 17 * MiB, WS_W1 = 25 * MiB, WS_W2 = 57 * MiB;
constexpr size_t WS_TME = 89 * MiB;
constexpr size_t WS_FT = 101 * MiB;
constexpr size_t WS_A16 = 109 * MiB;
constexpr size_t WS_PV = 110 * MiB;
constexpr size_t WS_PA = 111 * MiB;
constexpr size_t WS_PB = 115 * MiB;
constexpr size_t WS_P2 = 116 * MiB;
constexpr size_t WS_P3 = 118 * MiB;
constexpr size_t WS_H1B = 120 * MiB;
constexpr size_t WS_R1 = 184 * MiB;
constexpr size_t WS_XN = WS_R1;
constexpr size_t WS_S = WS_R1;
constexpr size_t WS_Y = WS_R1 + 64 * MiB;
constexpr size_t WS_AP = WS_R1 + 128 * MiB;
constexpr size_t WS_SG = WS_R1 + 176 * MiB;
constexpr size_t WS_UB = WS_R1 + 208 * MiB;
constexpr size_t WS_VB = WS_R1 + 240 * MiB;
constexpr size_t WS_HID = WS_R1;
constexpr size_t WS_END = WS_R1 + 272 * MiB;

constexpr int RING_BYTES = 131072, TAB_OFF = RING_BYTES, TAB_BYTES = 16384, LDS_BYTES = RING_BYTES + TAB_BYTES;

struct EpiProj {
    static constexpr bool PERM = true, HAS_MID = false;
    bf16_t *Ap, *SG, *UB, *VB; float* PV;
    template <int SECT> __device__ __forceinline__ void body(const f32x4 (&acc)[2][2][4][2], const Unit& u, int wr, int wc, int fr, int fq) const {
        const int colt = (u.pn & 3) * 256 + wc * 32 + 8 * fq;
        const int row0 = u.pm * 256 + wr * 64 + fr;
#pragma unroll
        for (int ai = 0; ai < 2; ++ai)
#pragma unroll
            for (int m = 0; m < 4; ++m) {
                const int row = row0 + ai * 128 + m * 16; float ss = 0.f;
#pragma unroll
                for (int bj = 0; bj < 2; ++bj) {
                    const int col8 = colt + bj * 128;
                    f32x4 v0 = acc[ai][bj][m][0], v1 = acc[ai][bj][m][1];
                    if (SECT == 1) {
#pragma unroll
                        for (int j = 0; j < 4; ++j) { v0[j] = sigmoid_f(v0[j]); v1[j] = sigmoid_f(v1[j]); }
                    }
                    if (SECT >= 2) {
#pragma unroll
                        for (int j = 0; j < 4; ++j) { v0[j] = gelu_tanh(v0[j]); v1[j] = gelu_tanh(v1[j]); }
                    }
                    if (SECT == 3) ss += (v0[0] * v0[0] + v0[1] * v0[1]) + (v0[2] * v0[2] + v0[3] * v0[3]) + (v1[0] * v1[0] + v1[1] * v1[1]) + (v1[2] * v1[2] + v1[3] * v1[3]);
                    u32x4 w; w.x = cvt_pk_bf16(v0[0], v0[1]); w.y = cvt_pk_bf16(v0[2], v0[3]); w.z = cvt_pk_bf16(v1[0], v1[1]); w.w = cvt_pk_bf16(v1[2], v1[3]);
                    bf16_t* dst;
                    if (SECT == 0) dst = Ap + ((size_t)((col8 >> 4) * 1024 + (row >> 4)) * KA + (row & 15) * 16 + (col8 & 15));
                    else if (SECT == 1) dst = SG + (size_t)row * 1024 + col8;
                    else if (SECT == 2) dst = UB + (size_t)row * 1024 + col8;
                    else dst = VB + (size_t)row * 1024 + col8;
                    *(u32x4*)dst = w;
                }
                if (SECT == 3) { ss += __shfl_xor(ss, 16); ss += __shfl_xor(ss, 32); if (fq == 0) PV[(size_t)row * 16 + (u.pn & 3) * 4 + wc] = ss; }
            }
    }
    __device__ __forceinline__ void operator()(const f32x4 (&acc)[2][2][4][2], const Unit& u, int ui, int wr, int wc, int fr, int fq) const {
        const int sect = u.pn >> 2;
        if (sect == 0) body<0>(acc, u, wr, wc, fr, fq); else if (sect == 1) body<1>(acc, u, wr, wc, fr, fq);
        else if (sect == 2) body<2>(acc, u, wr, wc, fr, fq); else body<3>(acc, u, wr, wc, fr, fq);
    }
};
struct EpiS {
    static constexpr bool PERM = false, HAS_MID = false;
    float* S;
    __device__ __forceinline__ void operator()(const f32x4 (&acc)[2][2][4][2], const Unit& u, int ui, int wr, int wc, int fr, int fq) const {
        const int row0 = u.pm * 256 + wr * 64 + fr, col0 = wc * 32 + 4 * fq;
#pragma unroll
        for (int ai = 0; ai < 2; ++ai)
#pragma unroll
            for (int m = 0; m < 4; ++m) { float* rp = S + (size_t)(row0 + ai * 128 + m * 16) * 128 + col0;
#pragma unroll
                for (int n = 0; n < 2; ++n) *(f32x4*)(rp + n * 16) = acc[ai][0][m][n]; }
    }
};
struct EpiSsm {
    static constexpr bool PERM = true, HAS_MID = false;
    const bf16_t *Ap, *SG; const float* dsk; bf16_t* Y; float* PA;
    __device__ __forceinline__ void operator()(const f32x4 (&acc)[2][2][4][2], const Unit& u, int ui, int wr, int wc, int fr, int fq) const {
        asm volatile("" : "+v"(fr), "+v"(fq));
        const int g = u.pn;
#pragma unroll
        for (int bj = 0; bj < 2; ++bj) {
            const int col8 = bj * 128 + wc * 32 + 8 * fq, t = col8 >> 4, hh = col8 & 15, ch = g * 16 + hh;
            const f32x4 d0 = *(const f32x4*)(dsk + ch), d1 = *(const f32x4*)(dsk + ch + 4);
#pragma unroll
            for (int ai = 0; ai < 2; ++ai)
#pragma unroll
                for (int m = 0; m < 4; ++m) {
                    const int R = u.pm * 256 + ai * 128 + wr * 64 + m * 16 + fr, rg = R & 1023, token = (rg >> 7) * SEQ + (rg & 127) * LC + t;
                    const u32x4 uu = *(const u32x4*)(Ap + (size_t)R * KA + t * 16 + hh);
                    const u32x4 sg = *(const u32x4*)(SG + (size_t)token * 1024 + ch);
                    const f32x4 a0 = acc[ai][bj][m][0], a1 = acc[ai][bj][m][1];
                    float o[8];
                    o[0] = gelu_tanh(a0[0] + d0[0] * bf_lo(uu.x)) * bf_lo(sg.x); o[1] = gelu_tanh(a0[1] + d0[1] * bf_hi(uu.x)) * bf_hi(sg.x);
                    o[2] = gelu_tanh(a0[2] + d0[2] * bf_lo(uu.y)) * bf_lo(sg.y); o[3] = gelu_tanh(a0[3] + d0[3] * bf_hi(uu.y)) * bf_hi(sg.y);
                    o[4] = gelu_tanh(a1[0] + d1[0] * bf_lo(uu.z)) * bf_lo(sg.z); o[5] = gelu_tanh(a1[1] + d1[1] * bf_hi(uu.z)) * bf_hi(sg.z);
                    o[6] = gelu_tanh(a1[2] + d1[2] * bf_lo(uu.w)) * bf_lo(sg.w); o[7] = gelu_tanh(a1[3] + d1[3] * bf_hi(uu.w)) * bf_hi(sg.w);
                    float ss = (o[0] * o[0] + o[1] * o[1]) + (o[2] * o[2] + o[3] * o[3]) + (o[4] * o[4] + o[5] * o[5]) + (o[6] * o[6] + o[7] * o[7]);
                    u32x4 w; w.x = cvt_pk_bf16(o[0], o[1]); w.y = cvt_pk_bf16(o[2], o[3]); w.z = cvt_pk_bf16(o[4], o[5]); w.w = cvt_pk_bf16(o[6], o[7]);
                    *(u32x4*)(Y + (size_t)token * DM + ch) = w;
                    ss += __shfl_xor(ss, 16);
                    if ((fq & 1) == 0) PA[(size_t)token * 64 + g] = ss;
                    asm volatile("" ::: "memory"); __builtin_amdgcn_sched_barrier(0);
                }
        }
    }
};
struct EpiOut {
    static constexpr bool PERM = true, HAS_MID = true;
    const float* x; float* h1; bf16_t* H1B; float* P2; const LAS f32x2* tab;
    __device__ __forceinline__ void mid(f32x4 (&acc)[2][2][4][2], int ui, int wr, int fr) const {
#pragma unroll
        for (int ai = 0; ai < 2; ++ai)
#pragma unroll
            for (int m = 0; m < 4; ++m) { const float s = tab[ui * 256 + ai * 128 + wr * 64 + m * 16 + fr].x;
#pragma unroll
                for (int bj = 0; bj < 2; ++bj)
#pragma unroll
                    for (int n = 0; n < 2; ++n) acc[ai][bj][m][n] *= s; }
    }
    __device__ __forceinline__ void operator()(const f32x4 (&acc)[2][2][4][2], const Unit& u, int ui, int wr, int wc, int fr, int fq) const {
#pragma unroll
        for (int ai = 0; ai < 2; ++ai)
#pragma unroll
            for (int m = 0; m < 4; ++m) {
                const int rl = ai * 128 + wr * 64 + m * 16 + fr, row = u.pm * 256 + rl; const float rb = tab[ui * 256 + rl].y; float ss = 0.f;
#pragma unroll
                for (int bj = 0; bj < 2; ++bj) {
                    const size_t off = (size_t)row * DM + u.pn * 256 + bj * 128 + wc * 32 + 8 * fq;
                    const f32x4 x0 = *(const f32x4*)(x + off), x1 = *(const f32x4*)(x + off + 4);
                    const f32x4 h0 = x0 + acc[ai][bj][m][0] * rb, hv1 = x1 + acc[ai][bj][m][1] * rb;
                    *(f32x4*)(h1 + off) = h0; *(f32x4*)(h1 + off + 4) = hv1;
                    ss += (h0[0] * h0[0] + h0[1] * h0[1]) + (h0[2] * h0[2] + h0[3] * h0[3]) + (hv1[0] * hv1[0] + hv1[1] * hv1[1]) + (hv1[2] * hv1[2] + hv1[3] * hv1[3]);
                    u32x4 w; w.x = cvt_pk_bf16(h0[0], h0[1]); w.y = cvt_pk_bf16(h0[2], h0[3]); w.z = cvt_pk_bf16(hv1[0], hv1[1]); w.w = cvt_pk_bf16(hv1[2], hv1[3]);
                    *(u32x4*)(H1B + off) = w;
                }
                ss += __shfl_xor(ss, 16); ss += __shfl_xor(ss, 32);
                if (fq == 0) P2[(size_t)row * 32 + u.pn * 4 + wc] = ss;
            }
    }
};
struct EpiFF1 {
    static constexpr bool PERM = true, HAS_MID = false;
    bf16_t* HID; const LAS float* tab;
    __device__ __forceinline__ void operator()(const f32x4 (&acc)[2][2][4][2], const Unit& u, int ui, int wr, int wc, int fr, int fq) const {
#pragma unroll
        for (int ai = 0; ai < 2; ++ai)
#pragma unroll
            for (int m = 0; m < 4; ++m) {
                const int rl = ai * 128 + wr * 64 + m * 16 + fr, row = u.pm * 256 + rl; const float r2 = tab[ui * 256 + rl];
#pragma unroll
                for (int bj = 0; bj < 2; ++bj) {
                    f32x4 v0 = acc[ai][bj][m][0] * r2, v1 = acc[ai][bj][m][1] * r2;
#pragma unroll
                    for (int j = 0; j < 4; ++j) { const float a = fmaxf(v0[j], 0.f), b = fmaxf(v1[j], 0.f); v0[j] = a * a; v1[j] = b * b; }
                    u32x4 w; w.x = cvt_pk_bf16(v0[0], v0[1]); w.y = cvt_pk_bf16(v0[2], v0[3]); w.z = cvt_pk_bf16(v1[0], v1[1]); w.w = cvt_pk_bf16(v1[2], v1[3]);
                    *(u32x4*)(HID + (size_t)row * DFF + u.pn * 256 + bj * 128 + wc * 32 + 8 * fq) = w;
                }
            }
    }
};
struct EpiFF2 {
    static constexpr bool PERM = true, HAS_MID = false;
    float* h; float* P3;
    __device__ __forceinline__ void operator()(const f32x4 (&acc)[2][2][4][2], const Unit& u, int ui, int wr, int wc, int fr, int fq) const {
#pragma unroll
        for (int ai = 0; ai < 2; ++ai)
#pragma unroll
            for (int m = 0; m < 4; ++m) {
                const int row = u.pm * 256 + ai * 128 + wr * 64 + m * 16 + fr; float ss = 0.f;
#pragma unroll
                for (int bj = 0; bj < 2; ++bj) {
                    const size_t off = (size_t)row * DM + u.pn * 256 + bj * 128 + wc * 32 + 8 * fq;
                    const f32x4 h0 = *(const f32x4*)(h + off) + acc[ai][bj][m][0], hv1 = *(const f32x4*)(h + off + 4) + acc[ai][bj][m][1];
                    *(f32x4*)(h + off) = h0; *(f32x4*)(h + off + 4) = hv1;
                    ss += (h0[0] * h0[0] + h0[1] * h0[1]) + (h0[2] * h0[2] + h0[3] * h0[3]) + (hv1[0] * hv1[0] + hv1[1] * hv1[1]) + (hv1[2] * hv1[2] + hv1[3] * hv1[3]);
                }
                ss += __shfl_xor(ss, 16); ss += __shfl_xor(ss, 32);
                if (fq == 0) P3[(size_t)row * 32 + u.pn * 4 + wc] = ss;
            }
    }
};

__device__ __forceinline__ float wave_sum(float v) {
#pragma unroll
    for (int o = 1; o < 64; o <<= 1) v += __shfl_xor(v, o);
    return v;
}
__device__ __forceinline__ void p0_transpose_item(const float* W, int K, int N, bf16_t* WT, const float* gain, const float* gain_hi, LAS float* scr, int item, int lane) {
    const int nblk = N / 32, kb = item / nblk, nb = item % nblk, k0 = 64 * kb, n0 = 32 * nb;
    const float* gk = gain ? ((gain_hi && k0 >= 1024) ? gain_hi + (k0 - 1024) : gain + k0) : nullptr;
#pragma unroll 8
    for (int i = 0; i < 32; ++i) { const int kk = 2 * i + (lane >> 5); float v = W[(size_t)(k0 + kk) * N + n0 + (lane & 31)]; if (gk) v *= gk[kk]; scr[kk * 33 + (lane & 31)] = v; }
    asm volatile("s_waitcnt lgkmcnt(0)" ::: "memory");
    const int c = lane & 7;
#pragma unroll
    for (int j = 0; j < 4; ++j) { const int n = (lane >> 3) + 8 * j; const LAS float* s = scr + (8 * c) * 33 + n;
        u32x4 o; o.x = cvt_pk_bf16(s[0 * 33], s[1 * 33]); o.y = cvt_pk_bf16(s[2 * 33], s[3 * 33]); o.z = cvt_pk_bf16(s[4 * 33], s[5 * 33]); o.w = cvt_pk_bf16(s[6 * 33], s[7 * 33]);
        *(u32x4*)(WT + (size_t)(n0 + n) * K + k0 + 8 * c) = o; }
    asm volatile("s_waitcnt lgkmcnt(0)" ::: "memory");
}
__device__ __forceinline__ f32x2 cpow_k(float lre, float lim, float dt, int k) {
    const float mag = expf((float)k * lre * dt);
    const double rev = (double)k * (double)lim * (double)dt * 0.15915494309189535;
    const float fr = (float)(rev - rint(rev));
    return (f32x2){mag * __builtin_amdgcn_cosf(fr), mag * __builtin_amdgcn_sinf(fr)};
}

struct Params { const float* in[21]; float* out; unsigned char* ws; int ph_lo, ph_hi; };

__device__ __forceinline__ void p0_ssm_task(const Params& p, LAS unsigned char* lds, int g, int d, int tid) {
    LAS float* coef = (LAS float*)lds;
    LAS float* pd = coef + 128;
    LAS float* pd1 = pd + 128;
    LAS float* wre = pd1 + 128;
    LAS float* wim = wre + 1024;
    LAS float* cre = wim + 1024;
    LAS float* cim = cre + 1024;
    const float* a_re = p.in[2]; const float* a_im = p.in[3]; const float* log_dt = p.in[4];
    const float* b_re = p.in[5]; const float* b_im = p.in[6]; const float* c_re = p.in[7]; const float* c_im = p.in[8];
    bf16_t* TmE = (bf16_t*)(p.ws + WS_TME) + (size_t)g * 256 * KA;
    bf16_t* Ft = (bf16_t*)(p.ws + WS_FT) + (size_t)g * 256 * 256;
    if (tid < 64) {
        const int n = tid; const float dt = expf(log_dt[g]); const float lre = fminf(a_re[g * 64 + n], -1e-4f), lim = a_im[g * 64 + n];
        const f32x2 ab = cpow_k(lre, lim, dt, 1);
        const float den = lre * lre + lim * lim, nre = ab.x - 1.0f;
        coef[2 * n] = (nre * lre + ab.y * lim) / den; coef[2 * n + 1] = (ab.y * lre - nre * lim) / den;
        const f32x2 q = cpow_k(lre, lim, dt, d), q1 = cpow_k(lre, lim, dt, d + 1);
        pd[2 * n] = q.x; pd[2 * n + 1] = q.y; pd1[2 * n] = q1.x; pd1[2 * n + 1] = q1.y;
        if (d == 0) { const f32x2 q16 = cpow_k(lre, lim, dt, 16); *(f32x2*)((float*)(p.ws + WS_A16) + (size_t)(g * 64 + n) * 2) = q16; }
    }
    __syncthreads();
    for (int idx = tid; idx < 1024; idx += NTHR) {
        const int n = idx >> 4;
        const float br = b_re[(size_t)g * 1024 + idx], bi = b_im[(size_t)g * 1024 + idx], cr = coef[2 * n], ci = coef[2 * n + 1];
        const float bbr = cr * br - ci * bi, bbi = cr * bi + ci * br, pr = pd[2 * n], pi = pd[2 * n + 1];
        wre[idx] = pr * bbr - pi * bbi; wim[idx] = pr * bbi + pi * bbr;
        cre[idx] = c_re[(size_t)g * 1024 + idx]; cim[idx] = c_im[(size_t)g * 1024 + idx];
    }
    __syncthreads();
    if (tid < 256) {
        const int h = tid >> 4, h2 = tid & 15; float s = 0.f;
#pragma unroll 8
        for (int n = 0; n < 64; ++n) s += cre[h * 64 + n] * wre[n * 16 + h2] - cim[h * 64 + n] * wim[n * 16 + h2];
        const bf16_t kb = (bf16_t)(cvt_pk_bf16(s, 0.f) & 0xffffu);
        for (int t = d; t < 16; ++t) TmE[(size_t)(t * 16 + h) * KA + (t - d) * 16 + h2] = kb;
        if (d > 0) for (int t = 0; t < 16 - d; ++t) TmE[(size_t)(t * 16 + h) * KA + (t + d) * 16 + h2] = 0;
    } else {
        const int q = tid - 256;
#pragma unroll
        for (int r = 0; r < 4; ++r) {
            const int idx = q + 256 * r;
            { const int h = idx >> 6, n = idx & 63; const float pr = pd1[2 * n], pi = pd1[2 * n + 1], cr = cre[h * 64 + n], ci = cim[h * 64 + n];
              const unsigned w = cvt_pk_bf16(cr * pr - ci * pi, -(cr * pi + ci * pr));
              bf16_t* rowp = TmE + (size_t)(d * 16 + h) * KA + 256; rowp[n] = (bf16_t)(w & 0xffffu); rowp[64 + n] = (bf16_t)(w >> 16); }
            { const int n = idx >> 4, h2 = idx & 15, col = (15 - d) * 16 + h2; const unsigned w = cvt_pk_bf16(wre[idx], wim[idx]);
              Ft[(size_t)n * 256 + col] = (bf16_t)(w & 0xffffu); Ft[(size_t)(64 + n) * 256 + col] = (bf16_t)(w >> 16);
              Ft[(size_t)(128 + n) * 256 + col] = 0; Ft[(size_t)(192 + n) * 256 + col] = 0; }
        }
    }
    __syncthreads();
}

__device__ __forceinline__ void sgu_unit(const Params& p, LAS unsigned char* lds, int unit, int tid) {
    constexpr int LDT = 136;
    LAS bf16_t* At = (LAS bf16_t*)lds;
    LAS bf16_t* Bt = (LAS bf16_t*)(lds + 128 * LDT * 2);
    LAS float* rvs = (LAS float*)(lds + 2 * 128 * LDT * 2);
    const int h = unit & 7, bnb = unit >> 3, tok0 = bnb * 128;
    const float* PV = (const float*)(p.ws + WS_PV); const bf16_t* VB = (const bf16_t*)(p.ws + WS_VB); const bf16_t* UB = (const bf16_t*)(p.ws + WS_UB);
    bf16_t* Y = (bf16_t*)(p.ws + WS_Y); float* PB = (float*)(p.ws + WS_PB);
    const float* vgain = p.in[10]; const float* sw = p.in[11] + (size_t)h * 128 * 128; const float* sb = p.in[12] + h * 128;
    if (tid < 128) { const f32x4* pp = (const f32x4*)(PV + (size_t)(tok0 + tid) * 16); const f32x4 a = pp[0], b = pp[1], c = pp[2], d = pp[3];
        const float s = ((a[0] + a[1]) + (a[2] + a[3])) + ((b[0] + b[1]) + (b[2] + b[3])) + ((c[0] + c[1]) + (c[2] + c[3])) + ((d[0] + d[1]) + (d[2] + d[3]));
        rvs[tid] = 1.0f / sqrtf(s * (1.0f / 1024.0f) + EPS); }
    __syncthreads();
#pragma unroll
    for (int q = 0; q < 4; ++q) {
        const int pc = tid + NTHR * q, r = pc >> 4, c0 = (pc & 15) * 8;
        {
            const bool on = (c0 >> 6) <= (r >> 6);
            const f32x4 w0 = *(const f32x4*)(sw + r * 128 + c0), w1 = *(const f32x4*)(sw + r * 128 + c0 + 4);
            const f32x4 r0 = *(const LAS f32x4*)(rvs + c0), r1 = *(const LAS f32x4*)(rvs + c0 + 4);
            u32x4 o;
            if (on) { o.x = cvt_pk_bf16(w0[0] * r0[0], w0[1] * r0[1]); o.y = cvt_pk_bf16(w0[2] * r0[2], w0[3] * r0[3]); o.z = cvt_pk_bf16(w1[0] * r1[0], w1[1] * r1[1]); o.w = cvt_pk_bf16(w1[2] * r1[2], w1[3] * r1[3]); }
            else { o = (u32x4){0u, 0u, 0u, 0u}; }
            *(LAS u32x4*)(At + r * LDT + c0) = o;
        }
        {
            const u32x4 vv = *(const u32x4*)(VB + (size_t)(tok0 + r) * 1024 + h * 128 + c0);
            Bt[(c0 + 0) * LDT + r] = (bf16_t)(vv.x & 0xffffu); Bt[(c0 + 1) * LDT + r] = (bf16_t)(vv.x >> 16);
            Bt[(c0 + 2) * LDT + r] = (bf16_t)(vv.y & 0xffffu); Bt[(c0 + 3) * LDT + r] = (bf16_t)(vv.y >> 16);
            Bt[(c0 + 4) * LDT + r] = (bf16_t)(vv.z & 0xffffu); Bt[(c0 + 5) * LDT + r] = (bf16_t)(vv.z >> 16);
            Bt[(c0 + 6) * LDT + r] = (bf16_t)(vv.w & 0xffffu); Bt[(c0 + 7) * LDT + r] = (bf16_t)(vv.w >> 16);
        }
    }
    __syncthreads();
    const int w = tid >> 6, lane = tid & 63, fr = lane & 15, fq = lane >> 4;
    bf16x8 wf[4];
#pragma unroll
    for (int ks = 0; ks < 4; ++ks) wf[ks] = *(const LAS bf16x8*)(At + (16 * w + fr) * LDT + ks * 32 + fq * 8);
    const int i = 16 * w + fr; const size_t tok = (size_t)(tok0 + i); const float bsi = sb[i]; float ss = 0.f;
#pragma unroll
    for (int ct = 0; ct < 8; ++ct) {
        f32x4 acc = (f32x4){0.f, 0.f, 0.f, 0.f};
#pragma unroll
        for (int ks = 0; ks < 4; ++ks) { const bf16x8 vf = *(const LAS bf16x8*)(Bt + (16 * ct + fr) * LDT + ks * 32 + fq * 8); acc = __builtin_amdgcn_mfma_f32_16x16x32_bf16(vf, wf[ks], acc, 0, 0, 0); }
        const int c = 16 * ct + 4 * fq;
        const u32x2 uu = *(const u32x2*)(UB + tok * 1024 + h * 128 + c); const f32x4 vg = *(const f32x4*)(vgain + h * 128 + c);
        const float o0 = bf_lo(uu.x) * (vg[0] * acc[0] + bsi), o1 = bf_hi(uu.x) * (vg[1] * acc[1] + bsi), o2 = bf_lo(uu.y) * (vg[2] * acc[2] + bsi), o3 = bf_hi(uu.y) * (vg[3] * acc[3] + bsi);
        ss += (o0 * o0 + o1 * o1) + (o2 * o2 + o3 * o3);
        u32x2 wv; wv.x = cvt_pk_bf16(o0, o1); wv.y = cvt_pk_bf16(o2, o3);
        *(u32x2*)(Y + tok * DM + DSSM + h * 128 + c) = wv;
    }
    ss += __shfl_xor(ss, 16); ss += __shfl_xor(ss, 32);
    if (fq == 0) PB[tok * 8 + h] = ss;
    __syncthreads();
}

__device__ __forceinline__ void carry_task(const Params& p, int g, int tid) {
    const int b = tid >> 6, n = tid & 63;
    const float* S = (const float*)(p.ws + WS_S); bf16_t* Ap = (bf16_t*)(p.ws + WS_AP);
    const f32x2 a16 = *(const f32x2*)((const float*)(p.ws + WS_A16) + (size_t)(g * 64 + n) * 2);
    float hr = 0.f, hi = 0.f; const size_t row0 = (size_t)g * 1024 + b * 128;
#pragma unroll 8
    for (int c = 0; c < NCH; ++c) {
        const size_t row = row0 + c; const float sr = S[row * 128 + n], si = S[row * 128 + 64 + n];
        const unsigned w = cvt_pk_bf16(hr, hi);
        Ap[row * KA + 256 + n] = (bf16_t)(w & 0xffffu); Ap[row * KA + 320 + n] = (bf16_t)(w >> 16);
        const float nr = a16.x * hr - a16.y * hi + sr, ni = a16.x * hi + a16.y * hr + si; hr = nr; hi = ni;
    }
}

__global__ void __launch_bounds__(NTHR, 2) fwd_megakernel(Params p) {
    extern __shared__ __attribute__((aligned(16))) unsigned char lds_raw[];
    LAS unsigned char* lds = (LAS unsigned char*)lds_raw;
    cg::grid_group grid = cg::this_grid();
    const int tid = threadIdx.x, lane = tid & 63, wave = __builtin_amdgcn_readfirstlane(tid >> 6);
    const int G = gridDim.x, bx = blockIdx.x;
    const int lo = p.ph_lo, hi = p.ph_hi;
    unsigned char* ws = p.ws;
#ifndef PH_MASK
#define PH_MASK 0x1ff
#endif
#define IN(k) (((PH_MASK >> (k)) & 1) && lo <= (k) && (k) < hi)
#define SEAM(k) do { if (IN(k) && IN((k) + 1)) grid.sync(); } while (0)

    if (IN(0)) {
        for (int t = bx; t < NG * 16; t += G) p0_ssm_task(p, lds, t >> 4, t & 15, tid);
        LAS float* scr = (LAS float*)(lds + wave * 16384);
        const int gw = bx * NWAVES + wave, NGW = G * NWAVES;
        constexpr int I_IN = (DM / 64) * (DIN / 32), I_OUT = (DM / 64) * (DM / 32), I_1 = (DM / 64) * (DFF / 32), I_2 = (DFF / 64) * (DM / 32);
        for (int it = gw; it < I_IN + I_OUT + I_1 + I_2; it += NGW) {
            int r = it;
            if (r < I_IN) { p0_transpose_item(p.in[1], DM, DIN, (bf16_t*)(ws + WS_WIN), nullptr, nullptr, scr, r, lane); continue; } r -= I_IN;
            if (r < I_OUT) { p0_transpose_item(p.in[15], DM, DM, (bf16_t*)(ws + WS_WOUT), p.in[13], p.in[14], scr, r, lane); continue; } r -= I_OUT;
            if (r < I_1) { p0_transpose_item(p.in[18], DM, DFF, (bf16_t*)(ws + WS_W1), p.in[17], nullptr, scr, r, lane); continue; } r -= I_1;
            p0_transpose_item(p.in[19], DFF, DM, (bf16_t*)(ws + WS_W2), nullptr, nullptr, scr, r, lane);
        }
        const float* x = p.in[0]; const float* mg = p.in[16]; bf16_t* XN = (bf16_t*)(ws + WS_XN);
        for (int m = gw; m < M; m += NGW) {
            const f32x4* xr = (const f32x4*)(x + (size_t)m * DM) + lane; f32x4 v[8]; float s = 0.f;
#pragma unroll
            for (int j = 0; j < 8; ++j) { v[j] = xr[64 * j]; s += (v[j][0] * v[j][0] + v[j][1] * v[j][1]) + (v[j][2] * v[j][2] + v[j][3] * v[j][3]); }
            const float r = 1.0f / sqrtf(wave_sum(s) * (1.0f / DM) + EPS);
            u32x2* o = (u32x2*)(XN + (size_t)m * DM) + lane;
#pragma unroll
            for (int j = 0; j < 8; ++j) { const f32x4 gg = *((const f32x4*)mg + 64 * j + lane); u32x2 w; w.x = cvt_pk_bf16(v[j][0] * r * gg[0], v[j][1] * r * gg[1]); w.y = cvt_pk_bf16(v[j][2] * r * gg[2], v[j][3] * r * gg[3]); o[64 * j] = w; }
        }
    }
    SEAM(0);
    if (IN(1)) {
        pg8::Gemm g{(const bf16_t*)(ws + WS_XN), (const bf16_t*)(ws + WS_WIN), DM, DM, DM}; pg8::StaticOrder S; S.init(M, DIN, G, bx);
        EpiProj E{(bf16_t*)(ws + WS_AP), (bf16_t*)(ws + WS_SG), (bf16_t*)(ws + WS_UB), (bf16_t*)(ws + WS_VB), (float*)(ws + WS_PV)};
        pg8::gemm_phase<EpiProj, pg8::StaticOrder, true>(lds, g, S, E);
    }
    SEAM(1);
    if (IN(2)) {
        pg8::Gemm g{(const bf16_t*)(ws + WS_AP), (const bf16_t*)(ws + WS_FT), KA, 256, 256}; pg8::GroupOrder S; S.init(G, bx);
        EpiS E{(float*)(ws + WS_S)};
        pg8::gemm_phase<EpiS, pg8::GroupOrder, true>(lds, g, S, E);
    }
    SEAM(2);
    if (IN(3)) {
        for (int g = bx; g < NG; g += G) carry_task(p, g, tid);
        if (G == 256) {
            if (bx < 64) sgu_unit(p, lds, bx, tid);
            else for (int u = bx; u < 1024; u += 192) sgu_unit(p, lds, u, tid);
        } else {
            for (int u = bx; u < 1024; u += G) sgu_unit(p, lds, u, tid);
        }
    }
    SEAM(3);
    if (IN(4)) {
        pg8::Gemm g{(const bf16_t*)(ws + WS_AP), (const bf16_t*)(ws + WS_TME), KA, KA, KA}; pg8::GroupOrder S; S.init(G, bx);
        EpiSsm E{(const bf16_t*)(ws + WS_AP), (const bf16_t*)(ws + WS_SG), p.in[9], (bf16_t*)(ws + WS_Y), (float*)(ws + WS_PA)};
        pg8::gemm_phase<EpiSsm, pg8::GroupOrder, true>(lds, g, S, E);
    }
    SEAM(4);
    if (IN(5)) {
        pg8::StaticOrder S; S.init(M, DM, G, bx);
        LAS f32x2* tab = (LAS f32x2*)(lds + TAB_OFF);
        const float* PA = (const float*)(ws + WS_PA); const float* PB = (const float*)(ws + WS_PB);
        for (int idx = tid; idx < TAB_BYTES / 8; idx += NTHR) {
            Unit u; if (!S.next(idx >> 8, u)) break;
            const int row = u.pm * 256 + (idx & 255); const f32x4* pa = (const f32x4*)(PA + (size_t)row * 64); float sa = 0.f;
#pragma unroll
            for (int j = 0; j < 16; ++j) { const f32x4 v = pa[j]; sa += (v[0] + v[1]) + (v[2] + v[3]); }
            const f32x4* pb = (const f32x4*)(PB + (size_t)row * 8); const f32x4 b0 = pb[0], b1 = pb[1]; const float sbb = ((b0[0] + b0[1]) + (b0[2] + b0[3])) + ((b1[0] + b1[1]) + (b1[2] + b1[3]));
            const float ra = 1.0f / sqrtf(sa * (1.0f / 1024.0f) + EPS), rb = 1.0f / sqrtf(sbb * (1.0f / 1024.0f) + EPS);
            tab[idx] = (f32x2){ra / rb, rb};
        }
        __syncthreads();
        pg8::Gemm g{(const bf16_t*)(ws + WS_Y), (const bf16_t*)(ws + WS_WOUT), DM, DM, DM};
        EpiOut E{p.in[0], p.out, (bf16_t*)(ws + WS_H1B), (float*)(ws + WS_P2), tab};
        pg8::gemm_phase<EpiOut, pg8::StaticOrder, true>(lds, g, S, E);
    }
    SEAM(5);
    if (IN(6)) {
        pg8::StaticOrder S; S.init(M, DFF, G, bx);
        LAS float* tab = (LAS float*)(lds + TAB_OFF);
        const float* P2 = (const float*)(ws + WS_P2);
        for (int idx = tid; idx < TAB_BYTES / 4; idx += NTHR) {
            Unit u; if (!S.next(idx >> 8, u)) break;
            const int row = u.pm * 256 + (idx & 255); const f32x4* pp = (const f32x4*)(P2 + (size_t)row * 32); float s = 0.f;
#pragma unroll
            for (int j = 0; j < 8; ++j) { const f32x4 v = pp[j]; s += (v[0] + v[1]) + (v[2] + v[3]); }
            tab[idx] = 1.0f / sqrtf(s * (1.0f / DM) + EPS);
        }
        __syncthreads();
        pg8::Gemm g{(const bf16_t*)(ws + WS_H1B), (const bf16_t*)(ws + WS_W1), DM, DM, DM};
        EpiFF1 E{(bf16_t*)(ws + WS_HID), tab};
        pg8::gemm_phase<EpiFF1, pg8::StaticOrder, true>(lds, g, S, E);
    }
    SEAM(6);
    if (IN(7)) {
        pg8::StaticOrder S; S.init(M, DM, G, bx);
        pg8::Gemm g{(const bf16_t*)(ws + WS_HID), (const bf16_t*)(ws + WS_W2), DFF, DFF, DFF};
        EpiFF2 E{p.out, (float*)(ws + WS_P3)};
        pg8::gemm_phase<EpiFF2, pg8::StaticOrder, true>(lds, g, S, E);
    }
    SEAM(7);
    if (IN(8)) {
        const int gw = bx * NWAVES + wave, NGW = G * NWAVES; const float* P3 = (const float*)(ws + WS_P3); const float* fg = p.in[20];
        for (int m = gw; m < M; m += NGW) {
            const float ps = (lane < 32) ? P3[(size_t)m * 32 + lane] : 0.f;
            const float r = 1.0f / sqrtf(wave_sum(ps) * (1.0f / DM) + EPS);
            f32x4* xr = (f32x4*)(p.out + (size_t)m * DM) + lane;
#pragma unroll
            for (int j = 0; j < 8; ++j) { const f32x4 gg = *((const f32x4*)fg + 64 * j + lane); f32x4 v = xr[64 * j]; v = v * r * gg; xr[64 * j] = v; }
        }
    }
#ifdef DBG_STOP
    grid.sync();
    {
        const size_t NT = (size_t)M * DM; const size_t gt = (size_t)bx * NTHR + tid, gs = (size_t)G * NTHR;
        const bf16_t* XN = (const bf16_t*)(ws + WS_XN); const bf16_t* WINp = (const bf16_t*)(ws + WS_WIN); const bf16_t* WOUTp = (const bf16_t*)(ws + WS_WOUT);
        const bf16_t* W1p = (const bf16_t*)(ws + WS_W1); const bf16_t* W2p = (const bf16_t*)(ws + WS_W2); const bf16_t* TMEp = (const bf16_t*)(ws + WS_TME); const bf16_t* FTp = (const bf16_t*)(ws + WS_FT);
        const bf16_t* SGp = (const bf16_t*)(ws + WS_SG); const bf16_t* UBp = (const bf16_t*)(ws + WS_UB); const bf16_t* VBp = (const bf16_t*)(ws + WS_VB); const bf16_t* APp = (const bf16_t*)(ws + WS_AP);
        const bf16_t* Yp = (const bf16_t*)(ws + WS_Y); const bf16_t* H1Bp = (const bf16_t*)(ws + WS_H1B); const bf16_t* HIDp = (const bf16_t*)(ws + WS_HID);
        const float* Sp = (const float*)(ws + WS_S); const float* PVp = (const float*)(ws + WS_PV); const float* PAp = (const float*)(ws + WS_PA); const float* PBp = (const float*)(ws + WS_PB);
        const float* P2p = (const float*)(ws + WS_P2); const float* P3p = (const float*)(ws + WS_P3);
#define BFV(p, i) __uint_as_float(((unsigned)(p)[(i)]) << 16)
        for (size_t i = gt; i < NT; i += gs) {
            float v = 0.f;
            if (DBG_STOP == 0) v = BFV(XN, i) + BFV(WINp, i % (size_t)(DIN * DM)) + BFV(WOUTp, i % (size_t)(DM * DM)) + BFV(W1p, i % (size_t)(DFF * DM)) + BFV(W2p, i % (size_t)(DFF * DM)) + BFV(TMEp, i % (size_t)(64 * 256 * KA)) + BFV(FTp, i % (size_t)(64 * 256 * 256));
            if (DBG_STOP == 1) { const size_t e = i % (size_t)(65536 * 256); v = BFV(SGp, i % (size_t)(M * 1024)) + 0.f * (float)(e & 1); }
            if (DBG_STOP == 2) v = Sp[i % (size_t)(65536 * 128)];
            if (DBG_STOP == 3) { const size_t e = i % (size_t)(65536 * 128), y = i % (size_t)(M * 1024); v = BFV(APp, (e >> 7) * KA + 256 + (e & 127)) + BFV(Yp, (y >> 10) * DM + 1024 + (y & 1023)) + PBp[i % (size_t)(M * 8)]; }
            if (DBG_STOP == 4) { const size_t y = i % (size_t)(M * 1024); v = BFV(Yp, (y >> 10) * DM + (y & 1023)) + PAp[i % (size_t)(M * 64)]; }
            if (DBG_STOP == 5) v = p.out[i] + BFV(H1Bp, i) + P2p[i % (size_t)(M * 32)];
            if (DBG_STOP == 6) v = BFV(HIDp, i) + BFV(HIDp, i + NT) + BFV(HIDp, i + 2 * NT) + BFV(HIDp, i + 3 * NT);
            if (DBG_STOP == 7) v = p.out[i] + P3p[i % (size_t)(M * 32)];
            p.out[i] = v;
        }
    }
#endif
#undef IN
#undef SEAM
}

extern "C" void kernel_launch(void* const* d_in, const int* in_sizes, int n_in, void* d_out, int out_size, void* d_ws, size_t ws_size, hipStream_t stream) {
    static int grid = 0;
    if (grid == 0) {
        if (n_in != 21 || out_size != M * DM || ws_size < WS_END) { fprintf(stderr, "kernel_launch: unexpected shapes (n_in %d, out %d, ws %zu)\n", n_in, out_size, ws_size); grid = -1; return; }
        int dev = 0, cus = 0, per_cu = 0;
        hipGetDevice(&dev); hipDeviceGetAttribute(&cus, hipDeviceAttributeMultiprocessorCount, dev);
        if (hipFuncSetAttribute((const void*)fwd_megakernel, hipFuncAttributeMaxDynamicSharedMemorySize, LDS_BYTES) != hipSuccess) { fprintf(stderr, "kernel_launch: hipFuncSetAttribute failed\n"); grid = -1; return; }
        if (hipOccupancyMaxActiveBlocksPerMultiprocessor(&per_cu, (const void*)fwd_megakernel, NTHR, LDS_BYTES) != hipSuccess || per_cu < 1) { fprintf(stderr, "kernel_launch: occupancy query failed (%d)\n", per_cu); (void)hipGetLastError(); per_cu = 1; }
        grid = cus * per_cu;
        if (grid > 256) grid = 256;
    }
    if (grid < 0) return;
#ifdef DIAG_POISON_WS
    (void)hipMemsetAsync((unsigned char*)d_ws, 0xAA, WS_END, stream);
#endif
    Params p{};
    for (int i = 0; i < 21; ++i) p.in[i] = (const float*)d_in[i];
    p.out = (float*)d_out; p.ws = (unsigned char*)d_ws;
#if MK_MULTI
    for (int ph = 0; ph < 9; ++ph) { p.ph_lo = ph; p.ph_hi = ph + 1; hipLaunchKernelGGL(fwd_megakernel, dim3(grid), dim3(NTHR), LDS_BYTES, stream, p); }
#else
#ifdef DBG_STOP
    p.ph_lo = 0; p.ph_hi = DBG_STOP + 1;
#else
    p.ph_lo = 0; p.ph_hi = 9;
#endif
    void* args[] = {&p};
    hipError_t e = hipLaunchCooperativeKernel((const void*)fwd_megakernel, dim3(grid), dim3(NTHR), args, LDS_BYTES, stream);
    if (e != hipSuccess) fprintf(stderr, "cooperative launch failed: %s (grid %d)\n", hipGetErrorString(e), grid);
#endif
}
```

```cpp
#include <hip/hip_runtime.h>
#include <hip/hip_cooperative_groups.h>
#include <cstdio>
#include <cstdint>
namespace cg = cooperative_groups;

#ifndef MK_MULTI
#define MK_MULTI 0
#endif

#define LAS __attribute__((address_space(3)))
typedef unsigned short bf16_t;
typedef short bf16x8 __attribute__((ext_vector_type(8)));
typedef float f32x4 __attribute__((ext_vector_type(4)));
typedef float f32x2 __attribute__((ext_vector_type(2)));
typedef unsigned u32x4 __attribute__((ext_vector_type(4)));
typedef unsigned u32x2 __attribute__((ext_vector_type(2)));

typedef __bf16 bf16x2_t __attribute__((ext_vector_type(2)));
__device__ __forceinline__ unsigned cvt_pk_bf16(float lo, float hi) { const f32x2 v = {lo, hi}; const bf16x2_t b = __builtin_convertvector(v, bf16x2_t); return __builtin_bit_cast(unsigned, b); }
__device__ __forceinline__ float bf_lo(unsigned w) { return __uint_as_float(w << 16); }
__device__ __forceinline__ float bf_hi(unsigned w) { return __uint_as_float(w & 0xffff0000u); }
__device__ __forceinline__ float gelu_tanh(float x) {
    const float t = x * (1.0f + 0.044715f * x * x);
    const float e = __builtin_amdgcn_exp2f(-2.3022081984f * t);
    return x * __builtin_amdgcn_rcpf(1.0f + e);
}
__device__ __forceinline__ float sigmoid_f(float x) { return __builtin_amdgcn_rcpf(1.0f + __builtin_amdgcn_exp2f(-1.4426950409f * x)); }

namespace pg8 {
constexpr int BM = 256, BK = 64, HALF = 128, HTB = HALF * BK * 2, STAGE_BYTES = 8 * HTB, NXCD = 8, WGM = 8;
__host__ __device__ __forceinline__ int lds_byte(int r, int c) { const int st = (r >> 4) * 2 + (c >> 5), rr = r & 15, cc = c & 31, ob = rr * 64 + cc * 2; return st * 1024 + (ob ^ (((ob >> 9) & 1) << 5)); }
__host__ __device__ __forceinline__ void stage_rc(int b, int& R, int& C) { const int st = b / 1024, sb = b % 1024, swz = sb ^ (((sb >> 9) & 1) << 5); R = (st >> 1) * 16 + swz / 64; C = (st & 1) * 32 + (swz % 64) / 2; }
__host__ __device__ __forceinline__ int perm32(int rho) { const int n = rho >> 4, i = rho & 15; return 8 * (i >> 2) + 4 * n + (i & 3); }

struct Unit { int pm, pn; };
struct Gemm { const bf16_t* A; const bf16_t* Bt; int lda, ldb, K; };

struct StaticOrder {
    int nM, nN, nwg, G, c;
    __device__ void init(int M, int N, int G_, int c_) { nM = M / BM; nN = N / BM; nwg = nM * nN; G = G_; c = c_; }
    __device__ bool next(int i, Unit& u) const {
        const long L = (long)i * G + c; if (L >= nwg) return false;
        int wgid = (int)L; { const int q = nwg / NXCD, r = nwg % NXCD, xcd = wgid % NXCD, off = wgid / NXCD; wgid = (xcd < r ? xcd * (q + 1) : r * (q + 1) + (xcd - r) * q) + off; }
        const int nig = WGM * nN, gid = wgid / nig, fm = gid * WGM, gsz = (nM - fm) < WGM ? (nM - fm) : WGM;
        u.pm = fm + ((wgid % nig) % gsz); u.pn = (wgid % nig) / gsz; return true;
    }
};
struct GroupOrder {
    int G, c;
    __device__ void init(int G_, int c_) { G = G_; c = c_; }
    __device__ bool next(int i, Unit& u) const {
        const int L = i * G + c; if (L >= 256) return false;
        const int Lr = (L & 7) * 32 + (L >> 3); u.pm = Lr; u.pn = Lr >> 2; return true;
    }
};

template <class Epi, class Sched, bool ALIGN_EPI>
__device__ __forceinline__ void gemm_phase(LAS unsigned char* lds, const Gemm g, const Sched& S, const Epi& E) {
    const int tid = threadIdx.x, wid = __builtin_amdgcn_readfirstlane(tid >> 6), lane = tid & 63, wr = wid >> 2, wc = wid & 3, fr = lane & 15, fq = lane >> 4;
    int nt = g.K / BK; asm volatile("" : "+s"(nt));
    unsigned voffA[2], voffB[2];
#pragma unroll
    for (int i = 0; i < 2; ++i) { int R, C; stage_rc(tid * 16 + i * 8192, R, C); const int Rb = Epi::PERM ? ((R & ~31) + perm32(R & 31)) : R;
        voffA[i] = (unsigned)(R * g.lda + C) * 2u; voffB[i] = (unsigned)(Rb * g.ldb + C) * 2u; }
    const size_t kstep = (size_t)(BK * 2);
    const size_t hstepA = (size_t)HALF * g.lda * 2, hstepB = (size_t)HALF * g.ldb * 2;
    const size_t tstepA = 2 * hstepA, tstepB = 2 * hstepB;
    const unsigned ldsw = (unsigned)wid * 1024u;
    const int aoff = lds_byte(wr * 64 + fr, fq * 8), boff = lds_byte(wc * 32 + fr, fq * 8);
#define PG8_SA(b, h) (((b) * 2 + (h)) * HTB)
#define PG8_SB(b, h) ((4 + (b) * 2 + (h)) * HTB)
#define PG8_STAGE(bufoff, gbase, voff) do { _Pragma("unroll") for (int _i = 0; _i < 2; ++_i) \
        __builtin_amdgcn_global_load_lds((const unsigned*)((const char*)(gbase) + (voff)[_i]), (LAS unsigned*)(lds + (bufoff) + ldsw + _i * 8192), 16, 0, 0); } while (0)
#define PG8_LDA(dst, b, h) do { _Pragma("unroll") for (int m = 0; m < 4; ++m) _Pragma("unroll") for (int k = 0; k < 2; ++k) dst[m][k] = *(const LAS bf16x8*)(lds + PG8_SA(b, h) + aoff + m * 2048 + k * 1024); } while (0)
#define PG8_LDB(dst, b, h) do { _Pragma("unroll") for (int n = 0; n < 2; ++n) _Pragma("unroll") for (int k = 0; k < 2; ++k) dst[n][k] = *(const LAS bf16x8*)(lds + PG8_SB(b, h) + boff + n * 2048 + k * 1024); } while (0)
#define PG8_MMA(ai, bj, At, Bt) do { __builtin_amdgcn_s_setprio(1); _Pragma("unroll") for (int m = 0; m < 4; ++m) _Pragma("unroll") for (int n = 0; n < 2; ++n) _Pragma("unroll") for (int k = 0; k < 2; ++k) \
        acc[ai][bj][m][n] = __builtin_amdgcn_mfma_f32_16x16x32_bf16(Bt[n][k], At[m][k], acc[ai][bj][m][n], 0, 0, 0); __builtin_amdgcn_s_setprio(0); } while (0)
#define PG8_WAIT_V(n) asm volatile("s_waitcnt vmcnt(" #n ")" ::: "memory")
#define PG8_WAIT_L(n) asm volatile("s_waitcnt lgkmcnt(" #n ")" ::: "memory")
#define PG8_BAR __builtin_amdgcn_s_barrier()
#define PG8_SCHED __builtin_amdgcn_sched_barrier(0)
    Unit cur, nxt; int ui = 0;
    if (!S.next(0, cur)) return;
    f32x4 acc[2][2][4][2];
#pragma unroll
    for (int a = 0; a < 2; ++a)
#pragma unroll
        for (int b = 0; b < 2; ++b)
#pragma unroll
            for (int m = 0; m < 4; ++m)
#pragma unroll
                for (int n = 0; n < 2; ++n) acc[a][b][m][n] = (f32x4){0.f, 0.f, 0.f, 0.f};
    bf16x8 At[4][2], B0[2][2], B1[2][2];
    const char* cA = (const char*)g.A + (size_t)cur.pm * tstepA; const char* cB = (const char*)g.Bt + (size_t)cur.pn * tstepB;
    PG8_STAGE(PG8_SB(0, 0), cB, voffB); PG8_STAGE(PG8_SB(0, 1), cB + hstepB, voffB); PG8_STAGE(PG8_SA(0, 0), cA, voffA); PG8_STAGE(PG8_SA(0, 1), cA + hstepA, voffA);
    if (wr == 1) PG8_BAR;
    PG8_WAIT_V(2); PG8_BAR;
    PG8_STAGE(PG8_SB(1, 0), cB + kstep, voffB); PG8_STAGE(PG8_SA(1, 0), cA + kstep, voffA); PG8_STAGE(PG8_SB(1, 1), cB + hstepB + kstep, voffB);
    PG8_WAIT_V(6); PG8_BAR;
    for (;;) {
        const bool has_next = S.next(ui + 1, nxt);
        const char* nA = has_next ? (const char*)g.A + (size_t)nxt.pm * tstepA : cA; const char* nB = has_next ? (const char*)g.Bt + (size_t)nxt.pn * tstepB : cB;
#pragma nounroll
        for (int t = 0; t < nt; t += 2) {
            const bool last = (t == nt - 2);
            const char* a1 = cA + (size_t)(t + 1) * kstep;
            const char* a2 = last ? nA : cA + (size_t)(t + 2) * kstep; const char* b2 = last ? nB : cB + (size_t)(t + 2) * kstep;
            const char* a3 = a2 + kstep; const char* b3 = b2 + kstep;
            if constexpr (Epi::HAS_MID) { if (t == (nt >> 1)) E.mid(acc, ui, wr, fr); }
            PG8_LDB(B0, 0, 0); PG8_LDB(B1, 0, 1); PG8_SCHED; PG8_LDA(At, 0, 0); PG8_STAGE(PG8_SA(1, 1), a1 + hstepA, voffA);
            PG8_WAIT_V(8); PG8_WAIT_L(0); PG8_BAR; PG8_MMA(0, 0, At, B0); PG8_MMA(0, 1, At, B1); PG8_BAR; PG8_SCHED;
            PG8_LDA(At, 0, 1); PG8_STAGE(PG8_SB(0, 0), b2, voffB); PG8_STAGE(PG8_SB(0, 1), b2 + hstepB, voffB); PG8_STAGE(PG8_SA(0, 0), a2, voffA);
            PG8_WAIT_V(8); PG8_WAIT_L(0); PG8_BAR; PG8_MMA(1, 0, At, B0); PG8_MMA(1, 1, At, B1); PG8_BAR; PG8_SCHED;
            PG8_LDB(B0, 1, 0); PG8_LDB(B1, 1, 1); PG8_SCHED; PG8_LDA(At, 1, 0); PG8_STAGE(PG8_SA(0, 1), a2 + hstepA, voffA);
            PG8_WAIT_V(8); PG8_WAIT_L(0); PG8_BAR; PG8_MMA(0, 0, At, B0); PG8_MMA(0, 1, At, B1); PG8_BAR; PG8_SCHED;
            PG8_LDA(At, 1, 1); PG8_STAGE(PG8_SB(1, 0), b3, voffB); PG8_STAGE(PG8_SB(1, 1), b3 + hstepB, voffB); PG8_STAGE(PG8_SA(1, 0), a3, voffA);
            PG8_WAIT_V(8); PG8_WAIT_L(0); PG8_BAR; PG8_MMA(1, 0, At, B0); PG8_MMA(1, 1, At, B1); PG8_BAR; PG8_SCHED;
        }
        if constexpr (ALIGN_EPI) { if (wr == 0) PG8_BAR; }
        E(acc, cur, ui, wr, wc, fr, fq);
        if (!has_next) break;
#pragma unroll
        for (int a = 0; a < 2; ++a)
#pragma unroll
            for (int b = 0; b < 2; ++b)
#pragma unroll
                for (int m = 0; m < 4; ++m)
#pragma unroll
                    for (int n = 0; n < 2; ++n) acc[a][b][m][n] = (f32x4){0.f, 0.f, 0.f, 0.f};
        cur = nxt; cA = nA; cB = nB; ++ui;
        if constexpr (ALIGN_EPI) { if (wr == 1) PG8_BAR; }
    }
    PG8_WAIT_V(0);
    if constexpr (!ALIGN_EPI) { if (wr == 0) PG8_BAR; }
    PG8_BAR;
#undef PG8_SA
#undef PG8_SB
#undef PG8_STAGE
#undef PG8_LDA
#undef PG8_LDB
#undef PG8_MMA
#undef PG8_WAIT_V
#undef PG8_WAIT_L
#undef PG8_BAR
#undef PG8_SCHED
}
}
using pg8::Unit;

constexpr int BATCH = 8, SEQ = 2048, DM = 2048, M = BATCH * SEQ;
constexpr int DSSM = 1024, DSGU = 1024, DIN = 4096, DFF = 8192;
constexpr int NG = 64, GS = 16, NS = 64;
constexpr int LC = 16, NCH = SEQ / LC;
constexpr int KA = LC * GS + 2 * NS;
constexpr float EPS = 1e-5f;
constexpr int NWAVES = 8, NTHR = 512;

constexpr size_t MiB = 1u << 20;
constexpr size_t WS_WIN = 1 * MiB, WS_WOUT = 17 * MiB, WS_W1 = 25 * MiB, WS_W2 = 57 * MiB;
constexpr size_t WS_TME = 89 * MiB;
constexpr size_t WS_FT = 101 * MiB;
constexpr size_t WS_A16 = 109 * MiB;
constexpr size_t WS_PV = 110 * MiB;
constexpr size_t WS_PA = 111 * MiB;
constexpr size_t WS_PB = 115 * MiB;
constexpr size_t WS_P2 = 116 * MiB;
constexpr size_t WS_P3 = 118 * MiB;
constexpr size_t WS_H1B = 120 * MiB;
constexpr size_t WS_R1 = 184 * MiB;
constexpr size_t WS_XN = WS_R1;
constexpr size_t WS_S = WS_R1;
constexpr size_t WS_Y = WS_R1 + 64 * MiB;
constexpr size_t WS_AP = WS_R1 + 128 * MiB;
constexpr size_t WS_SG = WS_R1 + 176 * MiB;
constexpr size_t WS_UB = WS_R1 + 208 * MiB;
constexpr size_t WS_VB = WS_R1 + 240 * MiB;
constexpr size_t WS_HID = WS_R1;
constexpr size_t WS_END = WS_R1 + 272 * MiB;

constexpr int RING_BYTES = 131072, TAB_OFF = RING_BYTES, TAB_BYTES = 16384, MISC_OFF = TAB_OFF + TAB_BYTES, LDS_BYTES = MISC_OFF + 256;

struct EpiProj {
    static constexpr bool PERM = true, HAS_MID = false;
    bf16_t *Ap, *SG, *UB, *VB; float* PV;
    template <int SECT> __device__ __forceinline__ void body(const f32x4 (&acc)[2][2][4][2], const Unit& u, int wr, int wc, int fr, int fq) const {
        const int colt = (u.pn & 3) * 256 + wc * 32 + 8 * fq;
        const int row0 = u.pm * 256 + wr * 64 + fr;
#pragma unroll
        for (int ai = 0; ai < 2; ++ai)
#pragma unroll
            for (int m = 0; m < 4; ++m) {
                const int row = row0 + ai * 128 + m * 16; float ss = 0.f;
#pragma unroll
                for (int bj = 0; bj < 2; ++bj) {
                    const int col8 = colt + bj * 128;
                    f32x4 v0 = acc[ai][bj][m][0], v1 = acc[ai][bj][m][1];
                    if (SECT == 1) {
#pragma unroll
                        for (int j = 0; j < 4; ++j) { v0[j] = sigmoid_f(v0[j]); v1[j] = sigmoid_f(v1[j]); }
                    }
                    if (SECT >= 2) {
#pragma unroll
                        for (int j = 0; j < 4; ++j) { v0[j] = gelu_tanh(v0[j]); v1[j] = gelu_tanh(v1[j]); }
                    }
                    if (SECT == 3) ss += (v0[0] * v0[0] + v0[1] * v0[1]) + (v0[2] * v0[2] + v0[3] * v0[3]) + (v1[0] * v1[0] + v1[1] * v1[1]) + (v1[2] * v1[2] + v1[3] * v1[3]);
                    u32x4 w; w.x = cvt_pk_bf16(v0[0], v0[1]); w.y = cvt_pk_bf16(v0[2], v0[3]); w.z = cvt_pk_bf16(v1[0], v1[1]); w.w = cvt_pk_bf16(v1[2], v1[3]);
                    bf16_t* dst;
                    if (SECT == 0) dst = Ap + ((size_t)((col8 >> 4) * 1024 + (row >> 4)) * KA + (row & 15) * 16 + (col8 & 15));
                    else if (SECT == 1) dst = SG + (size_t)row * 1024 + col8;
                    else if (SECT == 2) dst = UB + (size_t)row * 1024 + col8;
                    else dst = VB + (size_t)row * 1024 + col8;
                    *(u32x4*)dst = w;
                }
                if (SECT == 3) { ss += __shfl_xor(ss, 16); ss += __shfl_xor(ss, 32); if (fq == 0) PV[(size_t)row * 16 + (u.pn & 3) * 4 + wc] = ss; }
            }
    }
    __device__ __forceinline__ void operator()(const f32x4 (&acc)[2][2][4][2], const Unit& u, int ui, int wr, int wc, int fr, int fq) const {
        const int sect = u.pn >> 2;
        if (sect == 0) body<0>(acc, u, wr, wc, fr, fq); else if (sect == 1) body<1>(acc, u, wr, wc, fr, fq);
        else if (sect == 2) body<2>(acc, u, wr, wc, fr, fq); else body<3>(acc, u, wr, wc, fr, fq);
    }
};
struct EpiS {
    static constexpr bool PERM = false, HAS_MID = false;
    float* S;
    __device__ __forceinline__ void operator()(const f32x4 (&acc)[2][2][4][2], const Unit& u, int ui, int wr, int wc, int fr, int fq) const {
        const int row0 = u.pm * 256 + wr * 64 + fr, col0 = wc * 32 + 4 * fq;
#pragma unroll
        for (int ai = 0; ai < 2; ++ai)
#pragma unroll
            for (int m = 0; m < 4; ++m) { float* rp = S + (size_t)(row0 + ai * 128 + m * 16) * 128 + col0;
#pragma unroll
                for (int n = 0; n < 2; ++n) *(f32x4*)(rp + n * 16) = acc[ai][0][m][n]; }
    }
};
struct EpiSsm {
    static constexpr bool PERM = true, HAS_MID = false;
    const bf16_t *Ap, *SG; const float* dsk; bf16_t* Y; float* PA;
    __device__ __forceinline__ void operator()(const f32x4 (&acc)[2][2][4][2], const Unit& u, int ui, int wr, int wc, int fr, int fq) const {
        asm volatile("" : "+v"(fr), "+v"(fq));
        const int g = u.pn;
#pragma unroll
        for (int bj = 0; bj < 2; ++bj) {
            const int col8 = bj * 128 + wc * 32 + 8 * fq, t = col8 >> 4, hh = col8 & 15, ch = g * 16 + hh;
            const f32x4 d0 = *(const f32x4*)(dsk + ch), d1 = *(const f32x4*)(dsk + ch + 4);
#pragma unroll
            for (int ai = 0; ai < 2; ++ai)
#pragma unroll
                for (int m = 0; m < 4; ++m) {
                    const int R = u.pm * 256 + ai * 128 + wr * 64 + m * 16 + fr, rg = R & 1023, token = (rg >> 7) * SEQ + (rg & 127) * LC + t;
                    const u32x4 uu = *(const u32x4*)(Ap + (size_t)R * KA + t * 16 + hh);
                    const u32x4 sg = *(const u32x4*)(SG + (size_t)token * 1024 + ch);
                    const f32x4 a0 = acc[ai][bj][m][0], a1 = acc[ai][bj][m][1];
                    float o[8];
                    o[0] = gelu_tanh(a0[0] + d0[0] * bf_lo(uu.x)) * bf_lo(sg.x); o[1] = gelu_tanh(a0[1] + d0[1] * bf_hi(uu.x)) * bf_hi(sg.x);
                    o[2] = gelu_tanh(a0[2] + d0[2] * bf_lo(uu.y)) * bf_lo(sg.y); o[3] = gelu_tanh(a0[3] + d0[3] * bf_hi(uu.y)) * bf_hi(sg.y);
                    o[4] = gelu_tanh(a1[0] + d1[0] * bf_lo(uu.z)) * bf_lo(sg.z); o[5] = gelu_tanh(a1[1] + d1[1] * bf_hi(uu.z)) * bf_hi(sg.z);
                    o[6] = gelu_tanh(a1[2] + d1[2] * bf_lo(uu.w)) * bf_lo(sg.w); o[7] = gelu_tanh(a1[3] + d1[3] * bf_hi(uu.w)) * bf_hi(sg.w);
                    float ss = (o[0] * o[0] + o[1] * o[1]) + (o[2] * o[2] + o[3] * o[3]) + (o[4] * o[4] + o[5] * o[5]) + (o[6] * o[6] + o[7] * o[7]);
                    u32x4 w; w.x = cvt_pk_bf16(o[0], o[1]); w.y = cvt_pk_bf16(o[2], o[3]); w.z = cvt_pk_bf16(o[4], o[5]); w.w = cvt_pk_bf16(o[6], o[7]);
                    *(u32x4*)(Y + (size_t)token * DM + ch) = w;
                    ss += __shfl_xor(ss, 16);
                    if ((fq & 1) == 0) PA[(size_t)token * 64 + g] = ss;
                    asm volatile("" ::: "memory"); __builtin_amdgcn_sched_barrier(0);
                }
        }
    }
};
struct EpiOut {
    static constexpr bool PERM = true, HAS_MID = true;
    const float* x; float* h1; bf16_t* H1B; float* P2; const LAS f32x2* tab;
    __device__ __forceinline__ void mid(f32x4 (&acc)[2][2][4][2], int ui, int wr, int fr) const {
#pragma unroll
        for (int ai = 0; ai < 2; ++ai)
#pragma unroll
            for (int m = 0; m < 4; ++m) { const float s = tab[ui * 256 + ai * 128 + wr * 64 + m * 16 + fr].x;
#pragma unroll
                for (int bj = 0; bj < 2; ++bj)
#pragma unroll
                    for (int n = 0; n < 2; ++n) acc[ai][bj][m][n] *= s; }
    }
    __device__ __forceinline__ void operator()(const f32x4 (&acc)[2][2][4][2], const Unit& u, int ui, int wr, int wc, int fr, int fq) const {
#pragma unroll
        for (int ai = 0; ai < 2; ++ai)
#pragma unroll
            for (int m = 0; m < 4; ++m) {
                const int rl = ai * 128 + wr * 64 + m * 16 + fr, row = u.pm * 256 + rl; const float rb = tab[ui * 256 + rl].y; float ss = 0.f;
#pragma unroll
                for (int bj = 0; bj < 2; ++bj) {
                    const size_t off = (size_t)row * DM + u.pn * 256 + bj * 128 + wc * 32 + 8 * fq;
                    const f32x4 x0 = *(const f32x4*)(x + off), x1 = *(const f32x4*)(x + off + 4);
                    const f32x4 h0 = x0 + acc[ai][bj][m][0] * rb, hv1 = x1 + acc[ai][bj][m][1] * rb;
                    *(f32x4*)(h1 + off) = h0; *(f32x4*)(h1 + off + 4) = hv1;
                    ss += (h0[0] * h0[0] + h0[1] * h0[1]) + (h0[2] * h0[2] + h0[3] * h0[3]) + (hv1[0] * hv1[0] + hv1[1] * hv1[1]) + (hv1[2] * hv1[2] + hv1[3] * hv1[3]);
                    u32x4 w; w.x = cvt_pk_bf16(h0[0], h0[1]); w.y = cvt_pk_bf16(h0[2], h0[3]); w.z = cvt_pk_bf16(hv1[0], hv1[1]); w.w = cvt_pk_bf16(hv1[2], hv1[3]);
                    *(u32x4*)(H1B + off) = w;
                }
                ss += __shfl_xor(ss, 16); ss += __shfl_xor(ss, 32);
                if (fq == 0) P2[(size_t)row * 32 + u.pn * 4 + wc] = ss;
            }
    }
};
struct EpiFF1 {
    static constexpr bool PERM = true, HAS_MID = false;
    bf16_t* HID; const LAS float* tab;
    __device__ __forceinline__ void operator()(const f32x4 (&acc)[2][2][4][2], const Unit& u, int ui, int wr, int wc, int fr, int fq) const {
#pragma unroll
        for (int ai = 0; ai < 2; ++ai)
#pragma unroll
            for (int m = 0; m < 4; ++m) {
                const int rl = ai * 128 + wr * 64 + m * 16 + fr, row = u.pm * 256 + rl; const float r2 = tab[ui * 256 + rl];
#pragma unroll
                for (int bj = 0; bj < 2; ++bj) {
                    f32x4 v0 = acc[ai][bj][m][0] * r2, v1 = acc[ai][bj][m][1] * r2;
#pragma unroll
                    for (int j = 0; j < 4; ++j) { const float a = fmaxf(v0[j], 0.f), b = fmaxf(v1[j], 0.f); v0[j] = a * a; v1[j] = b * b; }
                    u32x4 w; w.x = cvt_pk_bf16(v0[0], v0[1]); w.y = cvt_pk_bf16(v0[2], v0[3]); w.z = cvt_pk_bf16(v1[0], v1[1]); w.w = cvt_pk_bf16(v1[2], v1[3]);
                    *(u32x4*)(HID + (size_t)row * DFF + u.pn * 256 + bj * 128 + wc * 32 + 8 * fq) = w;
                }
            }
    }
};
struct EpiFF2 {
    static constexpr bool PERM = true, HAS_MID = false;
    float* h; float* P3;
    __device__ __forceinline__ void operator()(const f32x4 (&acc)[2][2][4][2], const Unit& u, int ui, int wr, int wc, int fr, int fq) const {
#pragma unroll
        for (int ai = 0; ai < 2; ++ai)
#pragma unroll
            for (int m = 0; m < 4; ++m) {
                const int row = u.pm * 256 + ai * 128 + wr * 64 + m * 16 + fr; float ss = 0.f;
#pragma unroll
                for (int bj = 0; bj < 2; ++bj) {
                    const size_t off = (size_t)row * DM + u.pn * 256 + bj * 128 + wc * 32 + 8 * fq;
                    const f32x4 h0 = *(const f32x4*)(h + off) + acc[ai][bj][m][0], hv1 = *(const f32x4*)(h + off + 4) + acc[ai][bj][m][1];
                    *(f32x4*)(h + off) = h0; *(f32x4*)(h + off + 4) = hv1;
                    ss += (h0[0] * h0[0] + h0[1] * h0[1]) + (h0[2] * h0[2] + h0[3] * h0[3]) + (hv1[0] * hv1[0] + hv1[1] * hv1[1]) + (hv1[2] * hv1[2] + hv1[3] * hv1[3]);
                }
                ss += __shfl_xor(ss, 16); ss += __shfl_xor(ss, 32);
                if (fq == 0) P3[(size_t)row * 32 + u.pn * 4 + wc] = ss;
            }
    }
};

__device__ __forceinline__ float wave_sum(float v) {
#pragma unroll
    for (int o = 1; o < 64; o <<= 1) v += __shfl_xor(v, o);
    return v;
}
__device__ __forceinline__ void p0_transpose_item(const float* W, int K, int N, bf16_t* WT, const float* gain, const float* gain_hi, LAS float* scr, int item, int lane) {
    const int nblk = N / 32, kb = item / nblk, nb = item % nblk, k0 = 64 * kb, n0 = 32 * nb;
    const float* gk = gain ? ((gain_hi && k0 >= 1024) ? gain_hi + (k0 - 1024) : gain + k0) : nullptr;
#pragma unroll 8
    for (int i = 0; i < 32; ++i) { const int kk = 2 * i + (lane >> 5); float v = W[(size_t)(k0 + kk) * N + n0 + (lane & 31)]; if (gk) v *= gk[kk]; scr[kk * 33 + (lane & 31)] = v; }
    asm volatile("s_waitcnt lgkmcnt(0)" ::: "memory");
    const int c = lane & 7;
#pragma unroll
    for (int j = 0; j < 4; ++j) { const int n = (lane >> 3) + 8 * j; const LAS float* s = scr + (8 * c) * 33 + n;
        u32x4 o; o.x = cvt_pk_bf16(s[0 * 33], s[1 * 33]); o.y = cvt_pk_bf16(s[2 * 33], s[3 * 33]); o.z = cvt_pk_bf16(s[4 * 33], s[5 * 33]); o.w = cvt_pk_bf16(s[6 * 33], s[7 * 33]);
        *(u32x4*)(WT + (size_t)(n0 + n) * K + k0 + 8 * c) = o; }
    asm volatile("s_waitcnt lgkmcnt(0)" ::: "memory");
}
__device__ __forceinline__ f32x2 cpow_k(float lre, float lim, float dt, int k) {
    const float mag = expf((float)k * lre * dt);
    const double rev = (double)k * (double)lim * (double)dt * 0.15915494309189535;
    const float fr = (float)(rev - rint(rev));
    return (f32x2){mag * __builtin_amdgcn_cosf(fr), mag * __builtin_amdgcn_sinf(fr)};
}

#define RLX_AGENT __ATOMIC_RELAXED, __HIP_MEMORY_SCOPE_AGENT
#define XB_TMO      128
#define XB_XCNT(j)  (256  + 64 * (j))
#define XB_XSUB(j)  (1280 + 64 * (j))
#define XB_XGEN(j)  (2304 + 64 * (j))
#define XB_TOP      3328
#define XB_TOPGEN   3392
#define XCD_BAR_WORDS 3456
#define XB_SPIN_CAP (1u << 22)
__device__ __forceinline__ unsigned xb_ld(unsigned* p)              { return __hip_atomic_load(p, __ATOMIC_RELAXED, __HIP_MEMORY_SCOPE_AGENT); }
__device__ __forceinline__ unsigned xb_add(unsigned* p, unsigned v) { return __hip_atomic_fetch_add(p, v, __ATOMIC_RELAXED, __HIP_MEMORY_SCOPE_AGENT); }
__device__ __forceinline__ unsigned xb_xcc_id() { return (unsigned)__builtin_amdgcn_s_getreg((3 << 11) | 20) & 0xFu; }
#define XB_SPIN(cond, bar) do { unsigned _sp = 0; while (cond) { __builtin_amdgcn_s_sleep(1); \
    if ((++_sp & 255u) == 0u) { if (xb_ld(&(bar)[XB_TMO])) break; if (_sp > XB_SPIN_CAP) { atomicAdd(&(bar)[XB_TMO], 1u); break; } } } } while (0)
struct XcdBarrier { unsigned* bar; unsigned x; volatile LAS unsigned* st; };
__device__ __forceinline__ XcdBarrier xcd_barrier_post(unsigned* bar, volatile LAS unsigned* st) {
    XcdBarrier b; b.bar = bar; b.x = xb_xcc_id(); b.st = st;
    if (threadIdx.x == 0) (void)xb_add(&bar[XB_XCNT(b.x)], 1u);
    return b;
}
__device__ __forceinline__ void xcd_barrier_complete(unsigned* bar, unsigned x, unsigned& nloc, unsigned& nx) {
    const unsigned G = gridDim.x * gridDim.y * gridDim.z;
    unsigned sum, cnt, mine, sp = 0u;
    for (;;) {
        sum = 0u; cnt = 0u; mine = 0u;
#pragma unroll
        for (unsigned j = 0; j < 16; ++j) { const unsigned c = xb_ld(&bar[XB_XCNT(j)]); sum += c; cnt += (c > 0u) ? 1u : 0u; mine = (j == x) ? c : mine; }
        if (sum == G) break;
        __builtin_amdgcn_s_sleep(1);
        if ((++sp & 255u) == 0u) { if (xb_ld(&bar[XB_TMO])) break; if (sp > XB_SPIN_CAP) { atomicAdd(&bar[XB_TMO], 1u); break; } }
    }
    nloc = mine > 0u ? mine : 1u; nx = cnt > 0u ? cnt : 1u;
}
__device__ __forceinline__ void xcd_barrier(const XcdBarrier& b) {
    asm volatile("s_waitcnt vmcnt(0)" ::: "memory");
    __syncthreads();
    if (threadIdx.x == 0) {
        unsigned* bar = b.bar;
        __builtin_amdgcn_s_waitcnt(0);
        unsigned nloc = b.st[0], nx = b.st[1];
        if (nloc == 0u) { xcd_barrier_complete(bar, b.x, nloc, nx); b.st[0] = nloc; b.st[1] = nx; }
        const unsigned old = xb_add(&bar[XB_XSUB(b.x)], 1u);
        const unsigned gen = old / nloc;
        if (old + 1u == (gen + 1u) * nloc) {
            __builtin_amdgcn_fence(__ATOMIC_RELEASE, "agent");
            asm volatile("s_waitcnt vmcnt(0)" ::: "memory");
            const unsigned og = xb_add(&bar[XB_TOP], 1u);
            const unsigned tg = og / nx;
            if (og + 1u == (tg + 1u) * nx) xb_add(&bar[XB_TOPGEN], 1u);
            else XB_SPIN(xb_ld(&bar[XB_TOPGEN]) == tg, bar);
            __builtin_amdgcn_fence(__ATOMIC_ACQUIRE, "agent");
            xb_add(&bar[XB_XGEN(b.x)], 1u);
            asm volatile("s_waitcnt vmcnt(0)" ::: "memory");
        } else {
            XB_SPIN(xb_ld(&bar[XB_XGEN(b.x)]) == gen, bar);
            __builtin_amdgcn_fence(__ATOMIC_ACQUIRE, "agent");
            asm volatile("s_waitcnt vmcnt(0)" ::: "memory");
        }
    }
    __syncthreads();
}

struct Params { const float* in[21]; float* out; unsigned char* ws; int ph_lo, ph_hi; };

__device__ __forceinline__ void p0_ssm_task(const Params& p, LAS unsigned char* lds, int g, int d, int tid) {
    LAS float* coef = (LAS float*)lds;
    LAS float* pd = coef + 128;
    LAS float* pd1 = pd + 128;
    LAS float* wre = pd1 + 128;
    LAS float* wim = wre + 1024;
    LAS float* cre = wim + 1024;
    LAS float* cim = cre + 1024;
    const float* a_re = p.in[2]; const float* a_im = p.in[3]; const float* log_dt = p.in[4];
    const float* b_re = p.in[5]; const float* b_im = p.in[6]; const float* c_re = p.in[7]; const float* c_im = p.in[8];
    bf16_t* TmE = (bf16_t*)(p.ws + WS_TME) + (size_t)g * 256 * KA;
    bf16_t* Ft = (bf16_t*)(p.ws + WS_FT) + (size_t)g * 256 * 256;
    if (tid < 64) {
        const int n = tid; const float dt = expf(log_dt[g]); const float lre = fminf(a_re[g * 64 + n], -1e-4f), lim = a_im[g * 64 + n];
        const f32x2 ab = cpow_k(lre, lim, dt, 1);
        const float den = lre * lre + lim * lim, nre = ab.x - 1.0f;
        coef[2 * n] = (nre * lre + ab.y * lim) / den; coef[2 * n + 1] = (ab.y * lre - nre * lim) / den;
        const f32x2 q = cpow_k(lre, lim, dt, d), q1 = cpow_k(lre, lim, dt, d + 1);
        pd[2 * n] = q.x; pd[2 * n + 1] = q.y; pd1[2 * n] = q1.x; pd1[2 * n + 1] = q1.y;
        if (d == 0) { const f32x2 q16 = cpow_k(lre, lim, dt, 16); *(f32x2*)((float*)(p.ws + WS_A16) + (size_t)(g * 64 + n) * 2) = q16; }
    }
    __syncthreads();
    for (int idx = tid; idx < 1024; idx += NTHR) {
        const int n = idx >> 4;
        const float br = b_re[(size_t)g * 1024 + idx], bi = b_im[(size_t)g * 1024 + idx], cr = coef[2 * n], ci = coef[2 * n + 1];
        const float bbr = cr * br - ci * bi, bbi = cr * bi + ci * br, pr = pd[2 * n], pi = pd[2 * n + 1];
        wre[idx] = pr * bbr - pi * bbi; wim[idx] = pr * bbi + pi * bbr;
        cre[idx] = c_re[(size_t)g * 1024 + idx]; cim[idx] = c_im[(size_t)g * 1024 + idx];
    }
    __syncthreads();
    if (tid < 256) {
        const int h = tid >> 4, h2 = tid & 15; float s = 0.f;
#pragma unroll 8
        for (int n = 0; n < 64; ++n) s += cre[h * 64 + n] * wre[n * 16 + h2] - cim[h * 64 + n] * wim[n * 16 + h2];
        const bf16_t kb = (bf16_t)(cvt_pk_bf16(s, 0.f) & 0xffffu);
        for (int t = d; t < 16; ++t) TmE[(size_t)(t * 16 + h) * KA + (t - d) * 16 + h2] = kb;
        if (d > 0) for (int t = 0; t < 16 - d; ++t) TmE[(size_t)(t * 16 + h) * KA + (t + d) * 16 + h2] = 0;
    } else {
        const int q = tid - 256;
#pragma unroll
        for (int r = 0; r < 4; ++r) {
            const int idx = q + 256 * r;
            { const int h = idx >> 6, n = idx & 63; const float pr = pd1[2 * n], pi = pd1[2 * n + 1], cr = cre[h * 64 + n], ci = cim[h * 64 + n];
              const unsigned w = cvt_pk_bf16(cr * pr - ci * pi, -(cr * pi + ci * pr));
              bf16_t* rowp = TmE + (size_t)(d * 16 + h) * KA + 256; rowp[n] = (bf16_t)(w & 0xffffu); rowp[64 + n] = (bf16_t)(w >> 16); }
            { const int n = idx >> 4, h2 = idx & 15, col = (15 - d) * 16 + h2; const unsigned w = cvt_pk_bf16(wre[idx], wim[idx]);
              Ft[(size_t)n * 256 + col] = (bf16_t)(w & 0xffffu); Ft[(size_t)(64 + n) * 256 + col] = (bf16_t)(w >> 16);
              Ft[(size_t)(128 + n) * 256 + col] = 0; Ft[(size_t)(192 + n) * 256 + col] = 0; }
        }
    }
    __syncthreads();
}

__device__ __forceinline__ void sgu_unit(const Params& p, LAS unsigned char* lds, int unit, int tid) {
    constexpr int LDT = 136;
    LAS bf16_t* At = (LAS bf16_t*)lds;
    LAS bf16_t* Bt = (LAS bf16_t*)(lds + 128 * LDT * 2);
    LAS float* rvs = (LAS float*)(lds + 2 * 128 * LDT * 2);
    const int h = unit & 7, bnb = unit >> 3, tok0 = bnb * 128;
    const float* PV = (const float*)(p.ws + WS_PV); const bf16_t* VB = (const bf16_t*)(p.ws + WS_VB); const bf16_t* UB = (const bf16_t*)(p.ws + WS_UB);
    bf16_t* Y = (bf16_t*)(p.ws + WS_Y); float* PB = (float*)(p.ws + WS_PB);
    const float* vgain = p.in[10]; const float* sw = p.in[11] + (size_t)h * 128 * 128; const float* sb = p.in[12] + h * 128;
    if (tid < 128) { const f32x4* pp = (const f32x4*)(PV + (size_t)(tok0 + tid) * 16); const f32x4 a = pp[0], b = pp[1], c = pp[2], d = pp[3];
        const float s = ((a[0] + a[1]) + (a[2] + a[3])) + ((b[0] + b[1]) + (b[2] + b[3])) + ((c[0] + c[1]) + (c[2] + c[3])) + ((d[0] + d[1]) + (d[2] + d[3]));
        rvs[tid] = 1.0f / sqrtf(s * (1.0f / 1024.0f) + EPS); }
    __syncthreads();
#pragma unroll
    for (int q = 0; q < 4; ++q) {
        const int pc = tid + NTHR * q, r = pc >> 4, c0 = (pc & 15) * 8;
        {
            const bool on = (c0 >> 6) <= (r >> 6);
            const f32x4 w0 = *(const f32x4*)(sw + r * 128 + c0), w1 = *(const f32x4*)(sw + r * 128 + c0 + 4);
            const f32x4 r0 = *(const LAS f32x4*)(rvs + c0), r1 = *(const LAS f32x4*)(rvs + c0 + 4);
            u32x4 o;
            if (on) { o.x = cvt_pk_bf16(w0[0] * r0[0], w0[1] * r0[1]); o.y = cvt_pk_bf16(w0[2] * r0[2], w0[3] * r0[3]); o.z = cvt_pk_bf16(w1[0] * r1[0], w1[1] * r1[1]); o.w = cvt_pk_bf16(w1[2] * r1[2], w1[3] * r1[3]); }
            else { o = (u32x4){0u, 0u, 0u, 0u}; }
            *(LAS u32x4*)(At + r * LDT + c0) = o;
        }
        {
            const u32x4 vv = *(const u32x4*)(VB + (size_t)(tok0 + r) * 1024 + h * 128 + c0);
            Bt[(c0 + 0) * LDT + r] = (bf16_t)(vv.x & 0xffffu); Bt[(c0 + 1) * LDT + r] = (bf16_t)(vv.x >> 16);
            Bt[(c0 + 2) * LDT + r] = (bf16_t)(vv.y & 0xffffu); Bt[(c0 + 3) * LDT + r] = (bf16_t)(vv.y >> 16);
            Bt[(c0 + 4) * LDT + r] = (bf16_t)(vv.z & 0xffffu); Bt[(c0 + 5) * LDT + r] = (bf16_t)(vv.z >> 16);
            Bt[(c0 + 6) * LDT + r] = (bf16_t)(vv.w & 0xffffu); Bt[(c0 + 7) * LDT + r] = (bf16_t)(vv.w >> 16);
        }
    }
    __syncthreads();
    const int w = tid >> 6, lane = tid & 63, fr = lane & 15, fq = lane >> 4;
    bf16x8 wf[4];
#pragma unroll
    for (int ks = 0; ks < 4; ++ks) wf[ks] = *(const LAS bf16x8*)(At + (16 * w + fr) * LDT + ks * 32 + fq * 8);
    const int i = 16 * w + fr; const size_t tok = (size_t)(tok0 + i); const float bsi = sb[i]; float ss = 0.f;
#pragma unroll
    for (int ct = 0; ct < 8; ++ct) {
        f32x4 acc = (f32x4){0.f, 0.f, 0.f, 0.f};
#pragma unroll
        for (int ks = 0; ks < 4; ++ks) { const bf16x8 vf = *(const LAS bf16x8*)(Bt + (16 * ct + fr) * LDT + ks * 32 + fq * 8); acc = __builtin_amdgcn_mfma_f32_16x16x32_bf16(vf, wf[ks], acc, 0, 0, 0); }
        const int c = 16 * ct + 4 * fq;
        const u32x2 uu = *(const u32x2*)(UB + tok * 1024 + h * 128 + c); const f32x4 vg = *(const f32x4*)(vgain + h * 128 + c);
        const float o0 = bf_lo(uu.x) * (vg[0] * acc[0] + bsi), o1 = bf_hi(uu.x) * (vg[1] * acc[1] + bsi), o2 = bf_lo(uu.y) * (vg[2] * acc[2] + bsi), o3 = bf_hi(uu.y) * (vg[3] * acc[3] + bsi);
        ss += (o0 * o0 + o1 * o1) + (o2 * o2 + o3 * o3);
        u32x2 wv; wv.x = cvt_pk_bf16(o0, o1); wv.y = cvt_pk_bf16(o2, o3);
        *(u32x2*)(Y + tok * DM + DSSM + h * 128 + c) = wv;
    }
    ss += __shfl_xor(ss, 16); ss += __shfl_xor(ss, 32);
    if (fq == 0) PB[tok * 8 + h] = ss;
    __syncthreads();
}

__device__ __forceinline__ void carry_task(const Params& p, int g, int tid) {
    const int b = tid >> 6, n = tid & 63;
    const float* S = (const float*)(p.ws + WS_S); bf16_t* Ap = (bf16_t*)(p.ws + WS_AP);
    const f32x2 a16 = *(const f32x2*)((const float*)(p.ws + WS_A16) + (size_t)(g * 64 + n) * 2);
    float hr = 0.f, hi = 0.f; const size_t row0 = (size_t)g * 1024 + b * 128;
#pragma unroll 8
    for (int c = 0; c < NCH; ++c) {
        const size_t row = row0 + c; const float sr = S[row * 128 + n], si = S[row * 128 + 64 + n];
        const unsigned w = cvt_pk_bf16(hr, hi);
        Ap[row * KA + 256 + n] = (bf16_t)(w & 0xffffu); Ap[row * KA + 320 + n] = (bf16_t)(w >> 16);
        const float nr = a16.x * hr - a16.y * hi + sr, ni = a16.x * hi + a16.y * hr + si; hr = nr; hi = ni;
    }
}

__global__ void __launch_bounds__(NTHR, 2) fwd_megakernel(Params p) {
    extern __shared__ __attribute__((aligned(16))) unsigned char lds_raw[];
    LAS unsigned char* lds = (LAS unsigned char*)lds_raw;
    cg::grid_group grid = cg::this_grid();
    const int tid = threadIdx.x, lane = tid & 63, wave = __builtin_amdgcn_readfirstlane(tid >> 6);
    const int G = gridDim.x, bx = blockIdx.x;
    const int lo = p.ph_lo, hi = p.ph_hi;
    unsigned char* ws = p.ws;
#ifndef PH_MASK
#define PH_MASK 0x1ff
#endif
#define IN(k) (((PH_MASK >> (k)) & 1) && lo <= (k) && (k) < hi)
    volatile LAS unsigned* MISC = (volatile LAS unsigned*)(lds + MISC_OFF);
    if (tid < 64) MISC[tid] = 0u;
    __syncthreads();
    XcdBarrier xbar = xcd_barrier_post((unsigned*)ws, MISC);
#define SEAM(k) do { if (IN(k) && IN((k) + 1)) { if ((k) == 0) grid.sync(); else xcd_barrier(xbar); } } while (0)

    if (IN(0)) {
        for (int t = bx; t < NG * 16; t += G) p0_ssm_task(p, lds, t >> 4, t & 15, tid);
        LAS float* scr = (LAS float*)(lds + wave * 16384);
        const int gw = bx * NWAVES + wave, NGW = G * NWAVES;
        constexpr int I_IN = (DM / 64) * (DIN / 32), I_OUT = (DM / 64) * (DM / 32), I_1 = (DM / 64) * (DFF / 32), I_2 = (DFF / 64) * (DM / 32);
        for (int it = gw; it < I_IN + I_OUT + I_1 + I_2; it += NGW) {
            int r = it;
            if (r < I_IN) { p0_transpose_item(p.in[1], DM, DIN, (bf16_t*)(ws + WS_WIN), nullptr, nullptr, scr, r, lane); continue; } r -= I_IN;
            if (r < I_OUT) { p0_transpose_item(p.in[15], DM, DM, (bf16_t*)(ws + WS_WOUT), p.in[13], p.in[14], scr, r, lane); continue; } r -= I_OUT;
            if (r < I_1) { p0_transpose_item(p.in[18], DM, DFF, (bf16_t*)(ws + WS_W1), p.in[17], nullptr, scr, r, lane); continue; } r -= I_1;
            p0_transpose_item(p.in[19], DFF, DM, (bf16_t*)(ws + WS_W2), nullptr, nullptr, scr, r, lane);
        }
        const float* x = p.in[0]; const float* mg = p.in[16]; bf16_t* XN = (bf16_t*)(ws + WS_XN);
        for (int m = gw; m < M; m += NGW) {
            const f32x4* xr = (const f32x4*)(x + (size_t)m * DM) + lane; f32x4 v[8]; float s = 0.f;
#pragma unroll
            for (int j = 0; j < 8; ++j) { v[j] = xr[64 * j]; s += (v[j][0] * v[j][0] + v[j][1] * v[j][1]) + (v[j][2] * v[j][2] + v[j][3] * v[j][3]); }
            const float r = 1.0f / sqrtf(wave_sum(s) * (1.0f / DM) + EPS);
            u32x2* o = (u32x2*)(XN + (size_t)m * DM) + lane;
#pragma unroll
            for (int j = 0; j < 8; ++j) { const f32x4 gg = *((const f32x4*)mg + 64 * j + lane); u32x2 w; w.x = cvt_pk_bf16(v[j][0] * r * gg[0], v[j][1] * r * gg[1]); w.y = cvt_pk_bf16(v[j][2] * r * gg[2], v[j][3] * r * gg[3]); o[64 * j] = w; }
        }
    }
    SEAM(0);
    if (IN(1)) {
        pg8::Gemm g{(const bf16_t*)(ws + WS_XN), (const bf16_t*)(ws + WS_WIN), DM, DM, DM}; pg8::StaticOrder S; S.init(M, DIN, G, bx);
        EpiProj E{(bf16_t*)(ws + WS_AP), (bf16_t*)(ws + WS_SG), (bf16_t*)(ws + WS_UB), (bf16_t*)(ws + WS_VB), (float*)(ws + WS_PV)};
        pg8::gemm_phase<EpiProj, pg8::StaticOrder, true>(lds, g, S, E);
    }
    SEAM(1);
    if (IN(2)) {
        pg8::Gemm g{(const bf16_t*)(ws + WS_AP), (const bf16_t*)(ws + WS_FT), KA, 256, 256}; pg8::GroupOrder S; S.init(G, bx);
        EpiS E{(float*)(ws + WS_S)};
        pg8::gemm_phase<EpiS, pg8::GroupOrder, true>(lds, g, S, E);
    }
    SEAM(2);
    if (IN(3)) {
        for (int g = bx; g < NG; g += G) carry_task(p, g, tid);
        if (G == 256) {
            if (bx < 64) sgu_unit(p, lds, bx, tid);
            else for (int u = bx; u < 1024; u += 192) sgu_unit(p, lds, u, tid);
        } else {
            for (int u = bx; u < 1024; u += G) sgu_unit(p, lds, u, tid);
        }
    }
    SEAM(3);
    if (IN(4)) {
        pg8::Gemm g{(const bf16_t*)(ws + WS_AP), (const bf16_t*)(ws + WS_TME), KA, KA, KA}; pg8::GroupOrder S; S.init(G, bx);
        EpiSsm E{(const bf16_t*)(ws + WS_AP), (const bf16_t*)(ws + WS_SG), p.in[9], (bf16_t*)(ws + WS_Y), (float*)(ws + WS_PA)};
        pg8::gemm_phase<EpiSsm, pg8::GroupOrder, true>(lds, g, S, E);
    }
    SEAM(4);
    if (IN(5)) {
        pg8::StaticOrder S; S.init(M, DM, G, bx);
        LAS f32x2* tab = (LAS f32x2*)(lds + TAB_OFF);
        const float* PA = (const float*)(ws + WS_PA); const float* PB = (const float*)(ws + WS_PB);
        for (int idx = tid; idx < TAB_BYTES / 8; idx += NTHR) {
            Unit u; if (!S.next(idx >> 8, u)) break;
            const int row = u.pm * 256 + (idx & 255); const f32x4* pa = (const f32x4*)(PA + (size_t)row * 64); float sa = 0.f;
#pragma unroll
            for (int j = 0; j < 16; ++j) { const f32x4 v = pa[j]; sa += (v[0] + v[1]) + (v[2] + v[3]); }
            const f32x4* pb = (const f32x4*)(PB + (size_t)row * 8); const f32x4 b0 = pb[0], b1 = pb[1]; const float sbb = ((b0[0] + b0[1]) + (b0[2] + b0[3])) + ((b1[0] + b1[1]) + (b1[2] + b1[3]));
            const float ra = 1.0f / sqrtf(sa * (1.0f / 1024.0f) + EPS), rb = 1.0f / sqrtf(sbb * (1.0f / 1024.0f) + EPS);
            tab[idx] = (f32x2){ra / rb, rb};
        }
        __syncthreads();
        pg8::Gemm g{(const bf16_t*)(ws + WS_Y), (const bf16_t*)(ws + WS_WOUT), DM, DM, DM};
        EpiOut E{p.in[0], p.out, (bf16_t*)(ws + WS_H1B), (float*)(ws + WS_P2), tab};
        pg8::gemm_phase<EpiOut, pg8::StaticOrder, true>(lds, g, S, E);
    }
    SEAM(5);
    if (IN(6)) {
        pg8::StaticOrder S; S.init(M, DFF, G, bx);
        LAS float* tab = (LAS float*)(lds + TAB_OFF);
        const float* P2 = (const float*)(ws + WS_P2);
        for (int idx = tid; idx < TAB_BYTES / 4; idx += NTHR) {
            Unit u; if (!S.next(idx >> 8, u)) break;
            const int row = u.pm * 256 + (idx & 255); const f32x4* pp = (const f32x4*)(P2 + (size_t)row * 32); float s = 0.f;
#pragma unroll
            for (int j = 0; j < 8; ++j) { const f32x4 v = pp[j]; s += (v[0] + v[1]) + (v[2] + v[3]); }
            tab[idx] = 1.0f / sqrtf(s * (1.0f / DM) + EPS);
        }
        __syncthreads();
        pg8::Gemm g{(const bf16_t*)(ws + WS_H1B), (const bf16_t*)(ws + WS_W1), DM, DM, DM};
        EpiFF1 E{(bf16_t*)(ws + WS_HID), tab};
        pg8::gemm_phase<EpiFF1, pg8::StaticOrder, true>(lds, g, S, E);
    }
    SEAM(6);
    if (IN(7)) {
        pg8::StaticOrder S; S.init(M, DM, G, bx);
        pg8::Gemm g{(const bf16_t*)(ws + WS_HID), (const bf16_t*)(ws + WS_W2), DFF, DFF, DFF};
        EpiFF2 E{p.out, (float*)(ws + WS_P3)};
        pg8::gemm_phase<EpiFF2, pg8::StaticOrder, true>(lds, g, S, E);
    }
    SEAM(7);
    if (IN(8)) {
        const int gw = bx * NWAVES + wave, NGW = G * NWAVES; const float* P3 = (const float*)(ws + WS_P3); const float* fg = p.in[20];
        for (int m = gw; m < M; m += NGW) {
            const float ps = (lane < 32) ? P3[(size_t)m * 32 + lane] : 0.f;
            const float r = 1.0f / sqrtf(wave_sum(ps) * (1.0f / DM) + EPS);
            f32x4* xr = (f32x4*)(p.out + (size_t)m * DM) + lane;
#pragma unroll
            for (int j = 0; j < 8; ++j) { const f32x4 gg = *((const f32x4*)fg + 64 * j + lane); f32x4 v = xr[64 * j]; v = v * r * gg; xr[64 * j] = v; }
        }
    }
#ifdef DBG_STOP
    grid.sync();
    {
        const size_t NT = (size_t)M * DM; const size_t gt = (size_t)bx * NTHR + tid, gs = (size_t)G * NTHR;
        const bf16_t* XN = (const bf16_t*)(ws + WS_XN); const bf16_t* WINp = (const bf16_t*)(ws + WS_WIN); const bf16_t* WOUTp = (const bf16_t*)(ws + WS_WOUT);
        const bf16_t* W1p = (const bf16_t*)(ws + WS_W1); const bf16_t* W2p = (const bf16_t*)(ws + WS_W2); const bf16_t* TMEp = (const bf16_t*)(ws + WS_TME); const bf16_t* FTp = (const bf16_t*)(ws + WS_FT);
        const bf16_t* SGp = (const bf16_t*)(ws + WS_SG); const bf16_t* UBp = (const bf16_t*)(ws + WS_UB); const bf16_t* VBp = (const bf16_t*)(ws + WS_VB); const bf16_t* APp = (const bf16_t*)(ws + WS_AP);
        const bf16_t* Yp = (const bf16_t*)(ws + WS_Y); const bf16_t* H1Bp = (const bf16_t*)(ws + WS_H1B); const bf16_t* HIDp = (const bf16_t*)(ws + WS_HID);
        const float* Sp = (const float*)(ws + WS_S); const float* PVp = (const float*)(ws + WS_PV); const float* PAp = (const float*)(ws + WS_PA); const float* PBp = (const float*)(ws + WS_PB);
        const float* P2p = (const float*)(ws + WS_P2); const float* P3p = (const float*)(ws + WS_P3);
#define BFV(p, i) __uint_as_float(((unsigned)(p)[(i)]) << 16)
        for (size_t i = gt; i < NT; i += gs) {
            float v = 0.f;
            if (DBG_STOP == 0) v = BFV(XN, i) + BFV(WINp, i % (size_t)(DIN * DM)) + BFV(WOUTp, i % (size_t)(DM * DM)) + BFV(W1p, i % (size_t)(DFF * DM)) + BFV(W2p, i % (size_t)(DFF * DM)) + BFV(TMEp, i % (size_t)(64 * 256 * KA)) + BFV(FTp, i % (size_t)(64 * 256 * 256));
            if (DBG_STOP == 1) { const size_t e = i % (size_t)(65536 * 256); v = BFV(SGp, i % (size_t)(M * 1024)) + 0.f * (float)(e & 1); }
            if (DBG_STOP == 2) v = Sp[i % (size_t)(65536 * 128)];
            if (DBG_STOP == 3) { const size_t e = i % (size_t)(65536 * 128), y = i % (size_t)(M * 1024); v = BFV(APp, (e >> 7) * KA + 256 + (e & 127)) + BFV(Yp, (y >> 10) * DM + 1024 + (y & 1023)) + PBp[i % (size_t)(M * 8)]; }
            if (DBG_STOP == 4) { const size_t y = i % (size_t)(M * 1024); v = BFV(Yp, (y >> 10) * DM + (y & 1023)) + PAp[i % (size_t)(M * 64)]; }
            if (DBG_STOP == 5) v = p.out[i] + BFV(H1Bp, i) + P2p[i % (size_t)(M * 32)];
            if (DBG_STOP == 6) v = BFV(HIDp, i) + BFV(HIDp, i + NT) + BFV(HIDp, i + 2 * NT) + BFV(HIDp, i + 3 * NT);
            if (DBG_STOP == 7) v = p.out[i] + P3p[i % (size_t)(M * 32)];
            p.out[i] = v;
        }
    }
#endif
#undef IN
#undef SEAM
}

extern "C" void kernel_launch(void* const* d_in, const int* in_sizes, int n_in, void* d_out, int out_size, void* d_ws, size_t ws_size, hipStream_t stream) {
    static int grid = 0;
    if (grid == 0) {
        if (n_in != 21 || out_size != M * DM || ws_size < WS_END) { fprintf(stderr, "kernel_launch: unexpected shapes (n_in %d, out %d, ws %zu)\n", n_in, out_size, ws_size); grid = -1; return; }
        int dev = 0, cus = 0, per_cu = 0;
        hipGetDevice(&dev); hipDeviceGetAttribute(&cus, hipDeviceAttributeMultiprocessorCount, dev);
        if (hipFuncSetAttribute((const void*)fwd_megakernel, hipFuncAttributeMaxDynamicSharedMemorySize, LDS_BYTES) != hipSuccess) { fprintf(stderr, "kernel_launch: hipFuncSetAttribute failed\n"); grid = -1; return; }
        if (hipOccupancyMaxActiveBlocksPerMultiprocessor(&per_cu, (const void*)fwd_megakernel, NTHR, LDS_BYTES) != hipSuccess || per_cu < 1) { fprintf(stderr, "kernel_launch: occupancy query failed (%d)\n", per_cu); (void)hipGetLastError(); per_cu = 1; }
        grid = cus * per_cu;
        if (grid > 256) grid = 256;
    }
    if (grid < 0) return;
#ifdef DIAG_POISON_WS
    (void)hipMemsetAsync((unsigned char*)d_ws, 0xAA, WS_END, stream);
#endif
    Params p{};
    for (int i = 0; i < 21; ++i) p.in[i] = (const float*)d_in[i];
    p.out = (float*)d_out; p.ws = (unsigned char*)d_ws;
#if MK_MULTI
    for (int ph = 0; ph < 9; ++ph) { p.ph_lo = ph; p.ph_hi = ph + 1; hipLaunchKernelGGL(fwd_megakernel, dim3(grid), dim3(NTHR), LDS_BYTES, stream, p); }
#else
#ifdef DBG_STOP
    p.ph_lo = 0; p.ph_hi = DBG_STOP + 1;
#else
    p.ph_lo = 0; p.ph_hi = 9;
#endif
    (void)hipMemsetAsync(d_ws, 0, XCD_BAR_WORDS * 4, stream);
    void* args[] = {&p};
    hipError_t e = hipLaunchCooperativeKernel((const void*)fwd_megakernel, dim3(grid), dim3(NTHR), args, LDS_BYTES, stream);
    if (e != hipSuccess) fprintf(stderr, "cooperative launch failed: %s (grid %d)\n", hipGetErrorString(e), grid);
#endif
}
```

```cpp
#include <hip/hip_runtime.h>
#include <hip/hip_cooperative_groups.h>
#include <cstdio>
#include <cstdint>
namespace cg = cooperative_groups;

#ifndef MK_MULTI
#define MK_MULTI 0
#endif

#define LAS __attribute__((address_space(3)))
typedef unsigned short bf16_t;
typedef short bf16x8 __attribute__((ext_vector_type(8)));
typedef float f32x4 __attribute__((ext_vector_type(4)));
typedef float f32x2 __attribute__((ext_vector_type(2)));
typedef unsigned u32x4 __attribute__((ext_vector_type(4)));
typedef unsigned u32x2 __attribute__((ext_vector_type(2)));

typedef __bf16 bf16x2_t __attribute__((ext_vector_type(2)));
__device__ __forceinline__ unsigned cvt_pk_bf16(float lo, float hi) { const f32x2 v = {lo, hi}; const bf16x2_t b = __builtin_convertvector(v, bf16x2_t); return __builtin_bit_cast(unsigned, b); }
__device__ __forceinline__ float bf_lo(unsigned w) { return __uint_as_float(w << 16); }
__device__ __forceinline__ float bf_hi(unsigned w) { return __uint_as_float(w & 0xffff0000u); }
__device__ __forceinline__ float gelu_tanh(float x) {
    const float t = x * (1.0f + 0.044715f * x * x);
    const float e = __builtin_amdgcn_exp2f(-2.3022081984f * t);
    return x * __builtin_amdgcn_rcpf(1.0f + e);
}
__device__ __forceinline__ float sigmoid_f(float x) { return __builtin_amdgcn_rcpf(1.0f + __builtin_amdgcn_exp2f(-1.4426950409f * x)); }

namespace pg8 {
constexpr int BM = 256, BK = 64, HALF = 128, HTB = HALF * BK * 2, STAGE_BYTES = 8 * HTB, NXCD = 8, WGM = 8;
__host__ __device__ __forceinline__ int lds_byte(int r, int c) { const int st = (r >> 4) * 2 + (c >> 5), rr = r & 15, cc = c & 31, ob = rr * 64 + cc * 2; return st * 1024 + (ob ^ (((ob >> 9) & 1) << 5)); }
__host__ __device__ __forceinline__ void stage_rc(int b, int& R, int& C) { const int st = b / 1024, sb = b % 1024, swz = sb ^ (((sb >> 9) & 1) << 5); R = (st >> 1) * 16 + swz / 64; C = (st & 1) * 32 + (swz % 64) / 2; }
__host__ __device__ __forceinline__ int perm32(int rho) { const int n = rho >> 4, i = rho & 15; return 8 * (i >> 2) + 4 * n + (i & 3); }

struct Unit { int pm, pn; };
struct Gemm { const bf16_t* A; const bf16_t* Bt; int lda, ldb, K; };

struct StaticOrder {
    int nM, nN, nwg, G, c;
    __device__ void init(int M, int N, int G_, int c_) { nM = M / BM; nN = N / BM; nwg = nM * nN; G = G_; c = c_; }
    __device__ bool next(int i, Unit& u) const {
        const long L = (long)i * G + c; if (L >= nwg) return false;
        int wgid = (int)L; { const int q = nwg / NXCD, r = nwg % NXCD, xcd = wgid % NXCD, off = wgid / NXCD; wgid = (xcd < r ? xcd * (q + 1) : r * (q + 1) + (xcd - r) * q) + off; }
        const int nig = WGM * nN, gid = wgid / nig, fm = gid * WGM, gsz = (nM - fm) < WGM ? (nM - fm) : WGM;
        u.pm = fm + ((wgid % nig) % gsz); u.pn = (wgid % nig) / gsz; return true;
    }
};
struct GroupOrder {
    int G, c;
    __device__ void init(int G_, int c_) { G = G_; c = c_; }
    __device__ bool next(int i, Unit& u) const {
        const int L = i * G + c; if (L >= 256) return false;
        const int Lr = (L & 7) * 32 + (L >> 3); u.pm = Lr; u.pn = Lr >> 2; return true;
    }
};

struct OneUnit { int pm, pn; __device__ bool next(int i, Unit& u) const { if (i != 0) return false; u.pm = pm; u.pn = pn; return true; } };

template <class Epi, class Sched, bool ALIGN_EPI>
__device__ __forceinline__ void gemm_phase(LAS unsigned char* lds, const Gemm g, const Sched& S, const Epi& E) {
    const int tid = threadIdx.x, wid = __builtin_amdgcn_readfirstlane(tid >> 6), lane = tid & 63, wr = wid >> 2, wc = wid & 3, fr = lane & 15, fq = lane >> 4;
    int nt = g.K / BK; asm volatile("" : "+s"(nt));
    unsigned voffA[2], voffB[2];
#pragma unroll
    for (int i = 0; i < 2; ++i) { int R, C; stage_rc(tid * 16 + i * 8192, R, C); const int Rb = Epi::PERM ? ((R & ~31) + perm32(R & 31)) : R;
        voffA[i] = (unsigned)(R * g.lda + C) * 2u; voffB[i] = (unsigned)(Rb * g.ldb + C) * 2u; }
    const size_t kstep = (size_t)(BK * 2);
    const size_t hstepA = (size_t)HALF * g.lda * 2, hstepB = (size_t)HALF * g.ldb * 2;
    const size_t tstepA = 2 * hstepA, tstepB = 2 * hstepB;
    const unsigned ldsw = (unsigned)wid * 1024u;
    const int aoff = lds_byte(wr * 64 + fr, fq * 8), boff = lds_byte(wc * 32 + fr, fq * 8);
#define PG8_SA(b, h) (((b) * 2 + (h)) * HTB)
#define PG8_SB(b, h) ((4 + (b) * 2 + (h)) * HTB)
#define PG8_STAGE(bufoff, gbase, voff) do { _Pragma("unroll") for (int _i = 0; _i < 2; ++_i) \
        __builtin_amdgcn_global_load_lds((const unsigned*)((const char*)(gbase) + (voff)[_i]), (LAS unsigned*)(lds + (bufoff) + ldsw + _i * 8192), 16, 0, 0); } while (0)
#define PG8_LDA(dst, b, h) do { _Pragma("unroll") for (int m = 0; m < 4; ++m) _Pragma("unroll") for (int k = 0; k < 2; ++k) dst[m][k] = *(const LAS bf16x8*)(lds + PG8_SA(b, h) + aoff + m * 2048 + k * 1024); } while (0)
#define PG8_LDB(dst, b, h) do { _Pragma("unroll") for (int n = 0; n < 2; ++n) _Pragma("unroll") for (int k = 0; k < 2; ++k) dst[n][k] = *(const LAS bf16x8*)(lds + PG8_SB(b, h) + boff + n * 2048 + k * 1024); } while (0)
#define PG8_MMA(ai, bj, At, Bt) do { __builtin_amdgcn_s_setprio(1); _Pragma("unroll") for (int m = 0; m < 4; ++m) _Pragma("unroll") for (int n = 0; n < 2; ++n) _Pragma("unroll") for (int k = 0; k < 2; ++k) \
        acc[ai][bj][m][n] = __builtin_amdgcn_mfma_f32_16x16x32_bf16(Bt[n][k], At[m][k], acc[ai][bj][m][n], 0, 0, 0); __builtin_amdgcn_s_setprio(0); } while (0)
#define PG8_WAIT_V(n) asm volatile("s_waitcnt vmcnt(" #n ")" ::: "memory")
#define PG8_WAIT_L(n) asm volatile("s_waitcnt lgkmcnt(" #n ")" ::: "memory")
#define PG8_BAR __builtin_amdgcn_s_barrier()
#define PG8_SCHED __builtin_amdgcn_sched_barrier(0)
    Unit cur, nxt; int ui = 0;
    if (!S.next(0, cur)) return;
    f32x4 acc[2][2][4][2];
#pragma unroll
    for (int a = 0; a < 2; ++a)
#pragma unroll
        for (int b = 0; b < 2; ++b)
#pragma unroll
            for (int m = 0; m < 4; ++m)
#pragma unroll
                for (int n = 0; n < 2; ++n) acc[a][b][m][n] = (f32x4){0.f, 0.f, 0.f, 0.f};
    bf16x8 At[4][2], B0[2][2], B1[2][2];
    const char* cA = (const char*)g.A + (size_t)cur.pm * tstepA; const char* cB = (const char*)g.Bt + (size_t)cur.pn * tstepB;
    PG8_STAGE(PG8_SB(0, 0), cB, voffB); PG8_STAGE(PG8_SB(0, 1), cB + hstepB, voffB); PG8_STAGE(PG8_SA(0, 0), cA, voffA); PG8_STAGE(PG8_SA(0, 1), cA + hstepA, voffA);
    if (wr == 1) PG8_BAR;
    PG8_WAIT_V(2); PG8_BAR;
    PG8_STAGE(PG8_SB(1, 0), cB + kstep, voffB); PG8_STAGE(PG8_SA(1, 0), cA + kstep, voffA); PG8_STAGE(PG8_SB(1, 1), cB + hstepB + kstep, voffB);
    PG8_WAIT_V(6); PG8_BAR;
    for (;;) {
        const bool has_next = S.next(ui + 1, nxt);
        const char* nA = has_next ? (const char*)g.A + (size_t)nxt.pm * tstepA : cA; const char* nB = has_next ? (const char*)g.Bt + (size_t)nxt.pn * tstepB : cB;
#pragma nounroll
        for (int t = 0; t < nt; t += 2) {
            const bool last = (t == nt - 2);
            const char* a1 = cA + (size_t)(t + 1) * kstep;
            const char* a2 = last ? nA : cA + (size_t)(t + 2) * kstep; const char* b2 = last ? nB : cB + (size_t)(t + 2) * kstep;
            const char* a3 = a2 + kstep; const char* b3 = b2 + kstep;
            if constexpr (Epi::HAS_MID) { if (t == (nt >> 1)) E.mid(acc, ui, wr, fr); }
            PG8_LDB(B0, 0, 0); PG8_LDB(B1, 0, 1); PG8_SCHED; PG8_LDA(At, 0, 0); PG8_STAGE(PG8_SA(1, 1), a1 + hstepA, voffA);
            PG8_WAIT_V(8); PG8_WAIT_L(0); PG8_BAR; PG8_MMA(0, 0, At, B0); PG8_MMA(0, 1, At, B1); PG8_BAR; PG8_SCHED;
            PG8_LDA(At, 0, 1); PG8_STAGE(PG8_SB(0, 0), b2, voffB); PG8_STAGE(PG8_SB(0, 1), b2 + hstepB, voffB); PG8_STAGE(PG8_SA(0, 0), a2, voffA);
            PG8_WAIT_V(8); PG8_WAIT_L(0); PG8_BAR; PG8_MMA(1, 0, At, B0); PG8_MMA(1, 1, At, B1); PG8_BAR; PG8_SCHED;
            PG8_LDB(B0, 1, 0); PG8_LDB(B1, 1, 1); PG8_SCHED; PG8_LDA(At, 1, 0); PG8_STAGE(PG8_SA(0, 1), a2 + hstepA, voffA);
            PG8_WAIT_V(8); PG8_WAIT_L(0); PG8_BAR; PG8_MMA(0, 0, At, B0); PG8_MMA(0, 1, At, B1); PG8_BAR; PG8_SCHED;
            PG8_LDA(At, 1, 1); PG8_STAGE(PG8_SB(1, 0), b3, voffB); PG8_STAGE(PG8_SB(1, 1), b3 + hstepB, voffB); PG8_STAGE(PG8_SA(1, 0), a3, voffA);
            PG8_WAIT_V(8); PG8_WAIT_L(0); PG8_BAR; PG8_MMA(1, 0, At, B0); PG8_MMA(1, 1, At, B1); PG8_BAR; PG8_SCHED;
        }
        if constexpr (ALIGN_EPI) { if (wr == 0) PG8_BAR; }
        if constexpr (!Epi::AFTER_DRAIN) E(acc, cur, ui, wr, wc, fr, fq);
        if (!has_next) break;
#pragma unroll
        for (int a = 0; a < 2; ++a)
#pragma unroll
            for (int b = 0; b < 2; ++b)
#pragma unroll
                for (int m = 0; m < 4; ++m)
#pragma unroll
                    for (int n = 0; n < 2; ++n) acc[a][b][m][n] = (f32x4){0.f, 0.f, 0.f, 0.f};
        cur = nxt; cA = nA; cB = nB; ++ui;
        if constexpr (ALIGN_EPI) { if (wr == 1) PG8_BAR; }
    }
    PG8_WAIT_V(0);
    if constexpr (!ALIGN_EPI) { if (wr == 0) PG8_BAR; }
    PG8_BAR;
    if constexpr (Epi::AFTER_DRAIN) E.after(acc, cur, wr, wc, fr, fq, lds);
#undef PG8_SA
#undef PG8_SB
#undef PG8_STAGE
#undef PG8_LDA
#undef PG8_LDB
#undef PG8_MMA
#undef PG8_WAIT_V
#undef PG8_WAIT_L
#undef PG8_BAR
#undef PG8_SCHED
}
}
using pg8::Unit;

constexpr int BATCH = 8, SEQ = 2048, DM = 2048, M = BATCH * SEQ;
constexpr int DSSM = 1024, DSGU = 1024, DIN = 4096, DFF = 8192;
constexpr int NG = 64, GS = 16, NS = 64;
constexpr int LC = 16, NCH = SEQ / LC;
constexpr int KA = LC * GS + 2 * NS;
constexpr float EPS = 1e-5f;
constexpr int NWAVES = 8, NTHR = 512;

constexpr size_t MiB = 1u << 20;
constexpr size_t WS_WIN = 1 * MiB, WS_WOUT = 17 * MiB, WS_W1 = 25 * MiB, WS_W2 = 57 * MiB;
constexpr size_t WS_TME = 89 * MiB;
constexpr size_t WS_FT = 101 * MiB;
constexpr size_t WS_A16 = 109 * MiB;
constexpr size_t WS_PV = 110 * MiB;
constexpr size_t WS_PA = 111 * MiB;
constexpr size_t WS_PB = 115 * MiB;
constexpr size_t WS_P2 = 116 * MiB;
constexpr size_t WS_P3 = 118 * MiB;
constexpr size_t WS_H1B = 120 * MiB;
constexpr size_t WS_R1 = 184 * MiB;
constexpr size_t WS_XN = WS_R1;
constexpr size_t WS_S = WS_R1;
constexpr size_t WS_Y = WS_R1 + 64 * MiB;
constexpr size_t WS_AP = WS_R1 + 128 * MiB;
constexpr size_t WS_SG = WS_R1 + 176 * MiB;
constexpr size_t WS_UB = WS_R1 + 208 * MiB;
constexpr size_t WS_VB = WS_R1 + 240 * MiB;
constexpr size_t WS_HID = WS_R1;
constexpr size_t WS_END = WS_R1 + 272 * MiB;

constexpr int RING_BYTES = 131072, TAB_OFF = RING_BYTES, TAB_BYTES = 16384, MISC_OFF = TAB_OFF + TAB_BYTES, LDS_BYTES = MISC_OFF + 256;

struct EpiProj {
    static constexpr bool PERM = true, HAS_MID = false, AFTER_DRAIN = false;
    bf16_t *Ap, *SG, *UB, *VB; float* PV;
    template <int SECT> __device__ __forceinline__ void body(const f32x4 (&acc)[2][2][4][2], const Unit& u, int wr, int wc, int fr, int fq) const {
        const int colt = (u.pn & 3) * 256 + wc * 32 + 8 * fq;
        const int row0 = u.pm * 256 + wr * 64 + fr;
#pragma unroll
        for (int ai = 0; ai < 2; ++ai)
#pragma unroll
            for (int m = 0; m < 4; ++m) {
                const int row = row0 + ai * 128 + m * 16; float ss = 0.f;
#pragma unroll
                for (int bj = 0; bj < 2; ++bj) {
                    const int col8 = colt + bj * 128;
                    f32x4 v0 = acc[ai][bj][m][0], v1 = acc[ai][bj][m][1];
                    if (SECT == 1) {
#pragma unroll
                        for (int j = 0; j < 4; ++j) { v0[j] = sigmoid_f(v0[j]); v1[j] = sigmoid_f(v1[j]); }
                    }
                    if (SECT >= 2) {
#pragma unroll
                        for (int j = 0; j < 4; ++j) { v0[j] = gelu_tanh(v0[j]); v1[j] = gelu_tanh(v1[j]); }
                    }
                    if (SECT == 3) ss += (v0[0] * v0[0] + v0[1] * v0[1]) + (v0[2] * v0[2] + v0[3] * v0[3]) + (v1[0] * v1[0] + v1[1] * v1[1]) + (v1[2] * v1[2] + v1[3] * v1[3]);
                    u32x4 w; w.x = cvt_pk_bf16(v0[0], v0[1]); w.y = cvt_pk_bf16(v0[2], v0[3]); w.z = cvt_pk_bf16(v1[0], v1[1]); w.w = cvt_pk_bf16(v1[2], v1[3]);
                    bf16_t* dst;
                    if (SECT == 0) dst = Ap + ((size_t)((col8 >> 4) * 1024 + (row >> 4)) * KA + (row & 15) * 16 + (col8 & 15));
                    else if (SECT == 1) dst = SG + (size_t)row * 1024 + col8;
                    else if (SECT == 2) dst = UB + (size_t)row * 1024 + col8;
                    else dst = VB + (size_t)row * 1024 + col8;
                    *(u32x4*)dst = w;
                }
                if (SECT == 3) { ss += __shfl_xor(ss, 16); ss += __shfl_xor(ss, 32); if (fq == 0) PV[(size_t)row * 16 + (u.pn & 3) * 4 + wc] = ss; }
            }
    }
    __device__ __forceinline__ void operator()(const f32x4 (&acc)[2][2][4][2], const Unit& u, int ui, int wr, int wc, int fr, int fq) const {
        const int sect = u.pn >> 2;
        if (sect == 0) body<0>(acc, u, wr, wc, fr, fq); else if (sect == 1) body<1>(acc, u, wr, wc, fr, fq);
        else if (sect == 2) body<2>(acc, u, wr, wc, fr, fq); else body<3>(acc, u, wr, wc, fr, fq);
    }
};
struct EpiS {
    static constexpr bool PERM = false, HAS_MID = false, AFTER_DRAIN = true;
    __device__ __forceinline__ void operator()(const f32x4 (&acc)[2][2][4][2], const Unit& u, int ui, int wr, int wc, int fr, int fq) const {}
    __device__ __forceinline__ void after(const f32x4 (&acc)[2][2][4][2], const Unit& u, int wr, int wc, int fr, int fq, LAS unsigned char* lds) const {
        LAS float* S = (LAS float*)lds; const int row0 = wr * 64 + fr, col0 = wc * 32 + 4 * fq;
#pragma unroll
        for (int ai = 0; ai < 2; ++ai)
#pragma unroll
            for (int m = 0; m < 4; ++m) { LAS float* rp = S + (row0 + ai * 128 + m * 16) * 132 + col0;
#pragma unroll
                for (int n = 0; n < 2; ++n) *(LAS f32x4*)(rp + n * 16) = acc[ai][0][m][n]; }
    }
};
struct EpiSsm {
    static constexpr bool PERM = true, HAS_MID = false, AFTER_DRAIN = false;
    const bf16_t *Ap, *SG; const float* dsk; bf16_t* Y; float* PA;
    __device__ __forceinline__ void operator()(const f32x4 (&acc)[2][2][4][2], const Unit& u, int ui, int wr, int wc, int fr, int fq) const {
        asm volatile("" : "+v"(fr), "+v"(fq));
        const int g = u.pn;
#pragma unroll
        for (int bj = 0; bj < 2; ++bj) {
            const int col8 = bj * 128 + wc * 32 + 8 * fq, t = col8 >> 4, hh = col8 & 15, ch = g * 16 + hh;
            const f32x4 d0 = *(const f32x4*)(dsk + ch), d1 = *(const f32x4*)(dsk + ch + 4);
#pragma unroll
            for (int ai = 0; ai < 2; ++ai)
#pragma unroll
                for (int m = 0; m < 4; ++m) {
                    const int R = u.pm * 256 + ai * 128 + wr * 64 + m * 16 + fr, rg = R & 1023, token = (rg >> 7) * SEQ + (rg & 127) * LC + t;
                    const u32x4 uu = *(const u32x4*)(Ap + (size_t)R * KA + t * 16 + hh);
                    const u32x4 sg = *(const u32x4*)(SG + (size_t)token * 1024 + ch);
                    const f32x4 a0 = acc[ai][bj][m][0], a1 = acc[ai][bj][m][1];
                    float o[8];
                    o[0] = gelu_tanh(a0[0] + d0[0] * bf_lo(uu.x)) * bf_lo(sg.x); o[1] = gelu_tanh(a0[1] + d0[1] * bf_hi(uu.x)) * bf_hi(sg.x);
                    o[2] = gelu_tanh(a0[2] + d0[2] * bf_lo(uu.y)) * bf_lo(sg.y); o[3] = gelu_tanh(a0[3] + d0[3] * bf_hi(uu.y)) * bf_hi(sg.y);
                    o[4] = gelu_tanh(a1[0] + d1[0] * bf_lo(uu.z)) * bf_lo(sg.z); o[5] = gelu_tanh(a1[1] + d1[1] * bf_hi(uu.z)) * bf_hi(sg.z);
                    o[6] = gelu_tanh(a1[2] + d1[2] * bf_lo(uu.w)) * bf_lo(sg.w); o[7] = gelu_tanh(a1[3] + d1[3] * bf_hi(uu.w)) * bf_hi(sg.w);
                    float ss = (o[0] * o[0] + o[1] * o[1]) + (o[2] * o[2] + o[3] * o[3]) + (o[4] * o[4] + o[5] * o[5]) + (o[6] * o[6] + o[7] * o[7]);
                    u32x4 w; w.x = cvt_pk_bf16(o[0], o[1]); w.y = cvt_pk_bf16(o[2], o[3]); w.z = cvt_pk_bf16(o[4], o[5]); w.w = cvt_pk_bf16(o[6], o[7]);
                    *(u32x4*)(Y + (size_t)token * DM + ch) = w;
                    ss += __shfl_xor(ss, 16);
                    if ((fq & 1) == 0) PA[(size_t)token * 64 + g] = ss;
                    asm volatile("" ::: "memory"); __builtin_amdgcn_sched_barrier(0);
                }
        }
    }
};
struct EpiOut {
    static constexpr bool PERM = true, HAS_MID = true, AFTER_DRAIN = false;
    const float* x; bf16_t* H1B; float* P2; const LAS f32x2* tab;
    __device__ __forceinline__ void mid(f32x4 (&acc)[2][2][4][2], int ui, int wr, int fr) const {
#pragma unroll
        for (int ai = 0; ai < 2; ++ai)
#pragma unroll
            for (int m = 0; m < 4; ++m) { const float s = tab[ui * 256 + ai * 128 + wr * 64 + m * 16 + fr].x;
#pragma unroll
                for (int bj = 0; bj < 2; ++bj)
#pragma unroll
                    for (int n = 0; n < 2; ++n) acc[ai][bj][m][n] *= s; }
    }
    __device__ __forceinline__ void operator()(const f32x4 (&acc)[2][2][4][2], const Unit& u, int ui, int wr, int wc, int fr, int fq) const {
#pragma unroll
        for (int ai = 0; ai < 2; ++ai)
#pragma unroll
            for (int m = 0; m < 4; ++m) {
                const int rl = ai * 128 + wr * 64 + m * 16 + fr, row = u.pm * 256 + rl; const float rb = tab[ui * 256 + rl].y; float ss = 0.f;
#pragma unroll
                for (int bj = 0; bj < 2; ++bj) {
                    const size_t off = (size_t)row * DM + u.pn * 256 + bj * 128 + wc * 32 + 8 * fq;
                    const f32x4 x0 = *(const f32x4*)(x + off), x1 = *(const f32x4*)(x + off + 4);
                    const f32x4 h0 = x0 + acc[ai][bj][m][0] * rb, hv1 = x1 + acc[ai][bj][m][1] * rb;
                    ss += (h0[0] * h0[0] + h0[1] * h0[1]) + (h0[2] * h0[2] + h0[3] * h0[3]) + (hv1[0] * hv1[0] + hv1[1] * hv1[1]) + (hv1[2] * hv1[2] + hv1[3] * hv1[3]);
                    u32x4 w; w.x = cvt_pk_bf16(h0[0], h0[1]); w.y = cvt_pk_bf16(h0[2], h0[3]); w.z = cvt_pk_bf16(hv1[0], hv1[1]); w.w = cvt_pk_bf16(hv1[2], hv1[3]);
                    *(u32x4*)(H1B + off) = w;
                }
                ss += __shfl_xor(ss, 16); ss += __shfl_xor(ss, 32);
                if (fq == 0) P2[(size_t)row * 32 + u.pn * 4 + wc] = ss;
            }
    }
};
struct EpiFF1 {
    static constexpr bool PERM = true, HAS_MID = false, AFTER_DRAIN = false;
    bf16_t* HID; const LAS float* tab;
    __device__ __forceinline__ void operator()(const f32x4 (&acc)[2][2][4][2], const Unit& u, int ui, int wr, int wc, int fr, int fq) const {
#pragma unroll
        for (int ai = 0; ai < 2; ++ai)
#pragma unroll
            for (int m = 0; m < 4; ++m) {
                const int rl = ai * 128 + wr * 64 + m * 16 + fr, row = u.pm * 256 + rl; const float r2 = tab[ui * 256 + rl];
#pragma unroll
                for (int bj = 0; bj < 2; ++bj) {
                    f32x4 v0 = acc[ai][bj][m][0] * r2, v1 = acc[ai][bj][m][1] * r2;
#pragma unroll
                    for (int j = 0; j < 4; ++j) { const float a = fmaxf(v0[j], 0.f), b = fmaxf(v1[j], 0.f); v0[j] = a * a; v1[j] = b * b; }
                    u32x4 w; w.x = cvt_pk_bf16(v0[0], v0[1]); w.y = cvt_pk_bf16(v0[2], v0[3]); w.z = cvt_pk_bf16(v1[0], v1[1]); w.w = cvt_pk_bf16(v1[2], v1[3]);
                    *(u32x4*)(HID + (size_t)row * DFF + u.pn * 256 + bj * 128 + wc * 32 + 8 * fq) = w;
                }
            }
    }
};
struct EpiFF2 {
    static constexpr bool PERM = true, HAS_MID = false, AFTER_DRAIN = false;
    bf16_t* h; float* P3;
    __device__ __forceinline__ void operator()(const f32x4 (&acc)[2][2][4][2], const Unit& u, int ui, int wr, int wc, int fr, int fq) const {
#pragma unroll
        for (int ai = 0; ai < 2; ++ai)
#pragma unroll
            for (int m = 0; m < 4; ++m) {
                const int row = u.pm * 256 + ai * 128 + wr * 64 + m * 16 + fr; float ss = 0.f;
#pragma unroll
                for (int bj = 0; bj < 2; ++bj) {
                    const size_t off = (size_t)row * DM + u.pn * 256 + bj * 128 + wc * 32 + 8 * fq;
                    const u32x4 hb = *(const u32x4*)(h + off); const f32x4 a0 = acc[ai][bj][m][0], a1 = acc[ai][bj][m][1];
                    const float o0 = bf_lo(hb.x) + a0[0], o1 = bf_hi(hb.x) + a0[1], o2 = bf_lo(hb.y) + a0[2], o3 = bf_hi(hb.y) + a0[3];
                    const float o4 = bf_lo(hb.z) + a1[0], o5 = bf_hi(hb.z) + a1[1], o6 = bf_lo(hb.w) + a1[2], o7 = bf_hi(hb.w) + a1[3];
                    ss += (o0 * o0 + o1 * o1) + (o2 * o2 + o3 * o3) + (o4 * o4 + o5 * o5) + (o6 * o6 + o7 * o7);
                    u32x4 w; w.x = cvt_pk_bf16(o0, o1); w.y = cvt_pk_bf16(o2, o3); w.z = cvt_pk_bf16(o4, o5); w.w = cvt_pk_bf16(o6, o7);
                    *(u32x4*)(h + off) = w;
                }
                ss += __shfl_xor(ss, 16); ss += __shfl_xor(ss, 32);
                if (fq == 0) P3[(size_t)row * 32 + u.pn * 4 + wc] = ss;
            }
    }
};

__device__ __forceinline__ float wave_sum(float v) {
#pragma unroll
    for (int o = 1; o < 64; o <<= 1) v += __shfl_xor(v, o);
    return v;
}
__device__ __forceinline__ void p0_transpose_item(const float* W, int K, int N, bf16_t* WT, const float* gain, const float* gain_hi, LAS float* scr, int item, int lane) {
    const int nblk = N / 32, kb = item / nblk, nb = item % nblk, k0 = 64 * kb, n0 = 32 * nb;
    const float* gk = gain ? ((gain_hi && k0 >= 1024) ? gain_hi + (k0 - 1024) : gain + k0) : nullptr;
    float wv[32];
#pragma unroll
    for (int i = 0; i < 32; ++i) wv[i] = W[(size_t)(k0 + 2 * i + (lane >> 5)) * N + n0 + (lane & 31)];
#pragma unroll
    for (int i = 0; i < 32; ++i) { const int kk = 2 * i + (lane >> 5); float v = wv[i]; if (gk) v *= gk[kk]; scr[kk * 33 + (lane & 31)] = v; }
    asm volatile("s_waitcnt lgkmcnt(0)" ::: "memory");
    const int c = lane & 7;
#pragma unroll
    for (int j = 0; j < 4; ++j) { const int n = (lane >> 3) + 8 * j; const LAS float* s = scr + (8 * c) * 33 + n;
        u32x4 o; o.x = cvt_pk_bf16(s[0 * 33], s[1 * 33]); o.y = cvt_pk_bf16(s[2 * 33], s[3 * 33]); o.z = cvt_pk_bf16(s[4 * 33], s[5 * 33]); o.w = cvt_pk_bf16(s[6 * 33], s[7 * 33]);
        *(u32x4*)(WT + (size_t)(n0 + n) * K + k0 + 8 * c) = o; }
    asm volatile("s_waitcnt lgkmcnt(0)" ::: "memory");
}
__device__ __forceinline__ f32x2 cpow_k(float lre, float lim, float dt, int k) {
    const float mag = expf((float)k * lre * dt);
    const double rev = (double)k * (double)lim * (double)dt * 0.15915494309189535;
    const float fr = (float)(rev - rint(rev));
    return (f32x2){mag * __builtin_amdgcn_cosf(fr), mag * __builtin_amdgcn_sinf(fr)};
}

#define RLX_AGENT __ATOMIC_RELAXED, __HIP_MEMORY_SCOPE_AGENT
#define XB_TMO      128
#define XB_XCNT(j)  (256  + 64 * (j))
#define XB_XSUB(j)  (1280 + 64 * (j))
#define XB_XGEN(j)  (2304 + 64 * (j))
#define XB_TOP      3328
#define XB_TOPGEN   3392
#define XCD_BAR_WORDS 3456
#define XB_SPIN_CAP (1u << 22)
__device__ __forceinline__ unsigned xb_ld(unsigned* p)              { return __hip_atomic_load(p, __ATOMIC_RELAXED, __HIP_MEMORY_SCOPE_AGENT); }
__device__ __forceinline__ unsigned xb_add(unsigned* p, unsigned v) { return __hip_atomic_fetch_add(p, v, __ATOMIC_RELAXED, __HIP_MEMORY_SCOPE_AGENT); }
__device__ __forceinline__ unsigned xb_xcc_id() { return (unsigned)__builtin_amdgcn_s_getreg((3 << 11) | 20) & 0xFu; }
#define XB_SPIN(cond, bar) do { unsigned _sp = 0; while (cond) { __builtin_amdgcn_s_sleep(1); \
    if ((++_sp & 255u) == 0u) { if (xb_ld(&(bar)[XB_TMO])) break; if (_sp > XB_SPIN_CAP) { atomicAdd(&(bar)[XB_TMO], 1u); break; } } } } while (0)
struct XcdBarrier { unsigned* bar; unsigned x; volatile LAS unsigned* st; };
__device__ __forceinline__ XcdBarrier xcd_barrier_post(unsigned* bar, volatile LAS unsigned* st) {
    XcdBarrier b; b.bar = bar; b.x = xb_xcc_id(); b.st = st;
    if (threadIdx.x == 0) (void)xb_add(&bar[XB_XCNT(b.x)], 1u);
    return b;
}
__device__ __forceinline__ void xcd_barrier_complete(unsigned* bar, unsigned x, unsigned& nloc, unsigned& nx) {
    const unsigned G = gridDim.x * gridDim.y * gridDim.z;
    unsigned sum, cnt, mine, sp = 0u;
    for (;;) {
        sum = 0u; cnt = 0u; mine = 0u;
#pragma unroll
        for (unsigned j = 0; j < 16; ++j) { const unsigned c = xb_ld(&bar[XB_XCNT(j)]); sum += c; cnt += (c > 0u) ? 1u : 0u; mine = (j == x) ? c : mine; }
        if (sum == G) break;
        __builtin_amdgcn_s_sleep(1);
        if ((++sp & 255u) == 0u) { if (xb_ld(&bar[XB_TMO])) break; if (sp > XB_SPIN_CAP) { atomicAdd(&bar[XB_TMO], 1u); break; } }
    }
    nloc = mine > 0u ? mine : 1u; nx = cnt > 0u ? cnt : 1u;
}
__device__ __forceinline__ void xcd_barrier(const XcdBarrier& b) {
    asm volatile("s_waitcnt vmcnt(0)" ::: "memory");
    __syncthreads();
    if (threadIdx.x == 0) {
        unsigned* bar = b.bar;
        __builtin_amdgcn_s_waitcnt(0);
        unsigned nloc = b.st[0], nx = b.st[1];
        if (nloc == 0u) { xcd_barrier_complete(bar, b.x, nloc, nx); b.st[0] = nloc; b.st[1] = nx; }
        const unsigned old = xb_add(&bar[XB_XSUB(b.x)], 1u);
        const unsigned gen = old / nloc;
        if (old + 1u == (gen + 1u) * nloc) {
            __builtin_amdgcn_fence(__ATOMIC_RELEASE, "agent");
            asm volatile("s_waitcnt vmcnt(0)" ::: "memory");
            const unsigned og = xb_add(&bar[XB_TOP], 1u);
            const unsigned tg = og / nx;
            if (og + 1u == (tg + 1u) * nx) xb_add(&bar[XB_TOPGEN], 1u);
            else XB_SPIN(xb_ld(&bar[XB_TOPGEN]) == tg, bar);
            __builtin_amdgcn_fence(__ATOMIC_ACQUIRE, "agent");
            xb_add(&bar[XB_XGEN(b.x)], 1u);
            asm volatile("s_waitcnt vmcnt(0)" ::: "memory");
        } else {
            XB_SPIN(xb_ld(&bar[XB_XGEN(b.x)]) == gen, bar);
            __builtin_amdgcn_fence(__ATOMIC_ACQUIRE, "agent");
            asm volatile("s_waitcnt vmcnt(0)" ::: "memory");
        }
    }
    __syncthreads();
}

struct Params { const float* in[21]; float* out; unsigned char* ws; int ph_lo, ph_hi; };

__device__ __forceinline__ void p0_ssm_task(const Params& p, LAS unsigned char* lds, int g, int d, int tid) {
    LAS float* coef = (LAS float*)lds;
    LAS float* pd = coef + 128;
    LAS float* pd1 = pd + 128;
    LAS float* wre = pd1 + 128;
    LAS float* wim = wre + 1024;
    LAS float* cre = wim + 1024;
    LAS float* cim = cre + 1024;
    const float* a_re = p.in[2]; const float* a_im = p.in[3]; const float* log_dt = p.in[4];
    const float* b_re = p.in[5]; const float* b_im = p.in[6]; const float* c_re = p.in[7]; const float* c_im = p.in[8];
    bf16_t* TmE = (bf16_t*)(p.ws + WS_TME) + (size_t)g * 256 * KA;
    bf16_t* Ft = (bf16_t*)(p.ws + WS_FT) + (size_t)g * 256 * 256;
    if (tid < 64) {
        const int n = tid; const float dt = expf(log_dt[g]); const float lre = fminf(a_re[g * 64 + n], -1e-4f), lim = a_im[g * 64 + n];
        const f32x2 ab = cpow_k(lre, lim, dt, 1);
        const float den = lre * lre + lim * lim, nre = ab.x - 1.0f;
        coef[2 * n] = (nre * lre + ab.y * lim) / den; coef[2 * n + 1] = (ab.y * lre - nre * lim) / den;
        const f32x2 q = cpow_k(lre, lim, dt, d), q1 = cpow_k(lre, lim, dt, d + 1);
        pd[2 * n] = q.x; pd[2 * n + 1] = q.y; pd1[2 * n] = q1.x; pd1[2 * n + 1] = q1.y;
        if (d == 0) { const f32x2 q16 = cpow_k(lre, lim, dt, 16); *(f32x2*)((float*)(p.ws + WS_A16) + (size_t)(g * 64 + n) * 2) = q16; }
    }
    __syncthreads();
    for (int idx = tid; idx < 1024; idx += NTHR) {
        const int n = idx >> 4;
        const float br = b_re[(size_t)g * 1024 + idx], bi = b_im[(size_t)g * 1024 + idx], cr = coef[2 * n], ci = coef[2 * n + 1];
        const float bbr = cr * br - ci * bi, bbi = cr * bi + ci * br, pr = pd[2 * n], pi = pd[2 * n + 1];
        wre[idx] = pr * bbr - pi * bbi; wim[idx] = pr * bbi + pi * bbr;
        cre[idx] = c_re[(size_t)g * 1024 + idx]; cim[idx] = c_im[(size_t)g * 1024 + idx];
    }
    __syncthreads();
    if (tid < 256) {
        const int h = tid >> 4, h2 = tid & 15; float s = 0.f;
#pragma unroll 8
        for (int n = 0; n < 64; ++n) s += cre[h * 64 + n] * wre[n * 16 + h2] - cim[h * 64 + n] * wim[n * 16 + h2];
        const bf16_t kb = (bf16_t)(cvt_pk_bf16(s, 0.f) & 0xffffu);
        for (int t = d; t < 16; ++t) TmE[(size_t)(t * 16 + h) * KA + (t - d) * 16 + h2] = kb;
        if (d > 0) for (int t = 0; t < 16 - d; ++t) TmE[(size_t)(t * 16 + h) * KA + (t + d) * 16 + h2] = 0;
    } else {
        const int q = tid - 256;
#pragma unroll
        for (int r = 0; r < 4; ++r) {
            const int idx = q + 256 * r;
            { const int h = idx >> 6, n = idx & 63; const float pr = pd1[2 * n], pi = pd1[2 * n + 1], cr = cre[h * 64 + n], ci = cim[h * 64 + n];
              const unsigned w = cvt_pk_bf16(cr * pr - ci * pi, -(cr * pi + ci * pr));
              bf16_t* rowp = TmE + (size_t)(d * 16 + h) * KA + 256; rowp[n] = (bf16_t)(w & 0xffffu); rowp[64 + n] = (bf16_t)(w >> 16); }
            { const int n = idx >> 4, h2 = idx & 15, col = (15 - d) * 16 + h2; const unsigned w = cvt_pk_bf16(wre[idx], wim[idx]);
              Ft[(size_t)n * 256 + col] = (bf16_t)(w & 0xffffu); Ft[(size_t)(64 + n) * 256 + col] = (bf16_t)(w >> 16);
              Ft[(size_t)(128 + n) * 256 + col] = 0; Ft[(size_t)(192 + n) * 256 + col] = 0; }
        }
    }
    __syncthreads();
}

__device__ __forceinline__ void sgu_unit(const Params& p, LAS unsigned char* lds, int unit, int tid) {
    constexpr int LDT = 136;
    LAS bf16_t* At = (LAS bf16_t*)lds;
    LAS bf16_t* Bt = (LAS bf16_t*)(lds + 128 * LDT * 2);
    LAS float* rvs = (LAS float*)(lds + 2 * 128 * LDT * 2);
    const int h = unit & 7, bnb = unit >> 3, tok0 = bnb * 128;
    const float* PV = (const float*)(p.ws + WS_PV); const bf16_t* VB = (const bf16_t*)(p.ws + WS_VB); const bf16_t* UB = (const bf16_t*)(p.ws + WS_UB);
    bf16_t* Y = (bf16_t*)(p.ws + WS_Y); float* PB = (float*)(p.ws + WS_PB);
    const float* vgain = p.in[10]; const float* sw = p.in[11] + (size_t)h * 128 * 128; const float* sb = p.in[12] + h * 128;
    if (tid < 128) { const f32x4* pp = (const f32x4*)(PV + (size_t)(tok0 + tid) * 16); const f32x4 a = pp[0], b = pp[1], c = pp[2], d = pp[3];
        const float s = ((a[0] + a[1]) + (a[2] + a[3])) + ((b[0] + b[1]) + (b[2] + b[3])) + ((c[0] + c[1]) + (c[2] + c[3])) + ((d[0] + d[1]) + (d[2] + d[3]));
        rvs[tid] = 1.0f / sqrtf(s * (1.0f / 1024.0f) + EPS); }
    __syncthreads();
#pragma unroll
    for (int q = 0; q < 4; ++q) {
        const int pc = tid + NTHR * q, r = pc >> 4, c0 = (pc & 15) * 8;
        {
            const bool on = (c0 >> 6) <= (r >> 6);
            const f32x4 w0 = *(const f32x4*)(sw + r * 128 + c0), w1 = *(const f32x4*)(sw + r * 128 + c0 + 4);
            const f32x4 r0 = *(const LAS f32x4*)(rvs + c0), r1 = *(const LAS f32x4*)(rvs + c0 + 4);
            u32x4 o;
            if (on) { o.x = cvt_pk_bf16(w0[0] * r0[0], w0[1] * r0[1]); o.y = cvt_pk_bf16(w0[2] * r0[2], w0[3] * r0[3]); o.z = cvt_pk_bf16(w1[0] * r1[0], w1[1] * r1[1]); o.w = cvt_pk_bf16(w1[2] * r1[2], w1[3] * r1[3]); }
            else { o = (u32x4){0u, 0u, 0u, 0u}; }
            *(LAS u32x4*)(At + r * LDT + c0) = o;
        }
        {
            const u32x4 vv = *(const u32x4*)(VB + (size_t)(tok0 + r) * 1024 + h * 128 + c0);
            Bt[(c0 + 0) * LDT + r] = (bf16_t)(vv.x & 0xffffu); Bt[(c0 + 1) * LDT + r] = (bf16_t)(vv.x >> 16);
            Bt[(c0 + 2) * LDT + r] = (bf16_t)(vv.y & 0xffffu); Bt[(c0 + 3) * LDT + r] = (bf16_t)(vv.y >> 16);
            Bt[(c0 + 4) * LDT + r] = (bf16_t)(vv.z & 0xffffu); Bt[(c0 + 5) * LDT + r] = (bf16_t)(vv.z >> 16);
            Bt[(c0 + 6) * LDT + r] = (bf16_t)(vv.w & 0xffffu); Bt[(c0 + 7) * LDT + r] = (bf16_t)(vv.w >> 16);
        }
    }
    __syncthreads();
    const int w = tid >> 6, lane = tid & 63, fr = lane & 15, fq = lane >> 4;
    bf16x8 wf[4];
#pragma unroll
    for (int ks = 0; ks < 4; ++ks) wf[ks] = *(const LAS bf16x8*)(At + (16 * w + fr) * LDT + ks * 32 + fq * 8);
    const int i = 16 * w + fr; const size_t tok = (size_t)(tok0 + i); const float bsi = sb[i]; float ss = 0.f;
#pragma unroll
    for (int ct = 0; ct < 8; ++ct) {
        f32x4 acc = (f32x4){0.f, 0.f, 0.f, 0.f};
#pragma unroll
        for (int ks = 0; ks < 4; ++ks) { const bf16x8 vf = *(const LAS bf16x8*)(Bt + (16 * ct + fr) * LDT + ks * 32 + fq * 8); acc = __builtin_amdgcn_mfma_f32_16x16x32_bf16(vf, wf[ks], acc, 0, 0, 0); }
        const int c = 16 * ct + 4 * fq;
        const u32x2 uu = *(const u32x2*)(UB + tok * 1024 + h * 128 + c); const f32x4 vg = *(const f32x4*)(vgain + h * 128 + c);
        const float o0 = bf_lo(uu.x) * (vg[0] * acc[0] + bsi), o1 = bf_hi(uu.x) * (vg[1] * acc[1] + bsi), o2 = bf_lo(uu.y) * (vg[2] * acc[2] + bsi), o3 = bf_hi(uu.y) * (vg[3] * acc[3] + bsi);
        ss += (o0 * o0 + o1 * o1) + (o2 * o2 + o3 * o3);
        u32x2 wv; wv.x = cvt_pk_bf16(o0, o1); wv.y = cvt_pk_bf16(o2, o3);
        *(u32x2*)(Y + tok * DM + DSSM + h * 128 + c) = wv;
    }
    ss += __shfl_xor(ss, 16); ss += __shfl_xor(ss, 32);
    if (fq == 0) PB[tok * 8 + h] = ss;
    __syncthreads();
}

__device__ __forceinline__ void carry_task(const Params& p, int g, int tid) {
    const int b = tid >> 6, n = tid & 63;
    const float* S = (const float*)(p.ws + WS_S); bf16_t* Ap = (bf16_t*)(p.ws + WS_AP);
    const f32x2 a16 = *(const f32x2*)((const float*)(p.ws + WS_A16) + (size_t)(g * 64 + n) * 2);
    float hr = 0.f, hi = 0.f; const size_t row0 = (size_t)g * 1024 + b * 128;
#pragma unroll 8
    for (int c = 0; c < NCH; ++c) {
        const size_t row = row0 + c; const float sr = S[row * 128 + n], si = S[row * 128 + 64 + n];
        const unsigned w = cvt_pk_bf16(hr, hi);
        Ap[row * KA + 256 + n] = (bf16_t)(w & 0xffffu); Ap[row * KA + 320 + n] = (bf16_t)(w >> 16);
        const float nr = a16.x * hr - a16.y * hi + sr, ni = a16.x * hi + a16.y * hr + si; hr = nr; hi = ni;
    }
}

__global__ void __launch_bounds__(NTHR, 2) fwd_megakernel(Params p) {
    extern __shared__ __attribute__((aligned(16))) unsigned char lds_raw[];
    LAS unsigned char* lds = (LAS unsigned char*)lds_raw;
    cg::grid_group grid = cg::this_grid();
    const int tid = threadIdx.x, lane = tid & 63, wave = __builtin_amdgcn_readfirstlane(tid >> 6);
    const int G = gridDim.x, bx = blockIdx.x;
    const int lo = p.ph_lo, hi = p.ph_hi;
    unsigned char* ws = p.ws;
#ifndef PH_MASK
#define PH_MASK 0x7f
#endif
#define IN(k) (((PH_MASK >> (k)) & 1) && lo <= (k) && (k) < hi)
    volatile LAS unsigned* MISC = (volatile LAS unsigned*)(lds + MISC_OFF);
    if (tid < 64) MISC[tid] = 0u;
    __syncthreads();
    XcdBarrier xbar = xcd_barrier_post((unsigned*)ws, MISC);
#define SEAM(k) do { if (IN(k) && IN((k) + 1)) { if ((k) == 0) grid.sync(); else xcd_barrier(xbar); } } while (0)

    if (IN(0)) {
        for (int t = bx; t < NG * 16; t += G) p0_ssm_task(p, lds, t >> 4, t & 15, tid);
        LAS float* scr = (LAS float*)(lds + wave * 16384);
        const int gw = bx * NWAVES + wave, NGW = G * NWAVES;
        constexpr int I_IN = (DM / 64) * (DIN / 32), I_OUT = (DM / 64) * (DM / 32), I_1 = (DM / 64) * (DFF / 32), I_2 = (DFF / 64) * (DM / 32);
        for (int it = gw; it < I_IN + I_OUT + I_1 + I_2; it += NGW) {
            int r = it;
            if (r < I_IN) { p0_transpose_item(p.in[1], DM, DIN, (bf16_t*)(ws + WS_WIN), nullptr, nullptr, scr, r, lane); continue; } r -= I_IN;
            if (r < I_OUT) { p0_transpose_item(p.in[15], DM, DM, (bf16_t*)(ws + WS_WOUT), p.in[13], p.in[14], scr, r, lane); continue; } r -= I_OUT;
            if (r < I_1) { p0_transpose_item(p.in[18], DM, DFF, (bf16_t*)(ws + WS_W1), p.in[17], nullptr, scr, r, lane); continue; } r -= I_1;
            p0_transpose_item(p.in[19], DFF, DM, (bf16_t*)(ws + WS_W2), nullptr, nullptr, scr, r, lane);
        }
        const float* x = p.in[0]; const float* mg = p.in[16]; bf16_t* XN = (bf16_t*)(ws + WS_XN);
        for (int m = gw; m < M; m += NGW) {
            const f32x4* xr = (const f32x4*)(x + (size_t)m * DM) + lane; f32x4 v[8]; float s = 0.f;
#pragma unroll
            for (int j = 0; j < 8; ++j) { v[j] = xr[64 * j]; s += (v[j][0] * v[j][0] + v[j][1] * v[j][1]) + (v[j][2] * v[j][2] + v[j][3] * v[j][3]); }
            const float r = 1.0f / sqrtf(wave_sum(s) * (1.0f / DM) + EPS);
            u32x2* o = (u32x2*)(XN + (size_t)m * DM) + lane;
#pragma unroll
            for (int j = 0; j < 8; ++j) { const f32x4 gg = *((const f32x4*)mg + 64 * j + lane); u32x2 w; w.x = cvt_pk_bf16(v[j][0] * r * gg[0], v[j][1] * r * gg[1]); w.y = cvt_pk_bf16(v[j][2] * r * gg[2], v[j][3] * r * gg[3]); o[64 * j] = w; }
        }
    }
    SEAM(0);
    if (IN(1)) {
        pg8::Gemm g{(const bf16_t*)(ws + WS_XN), (const bf16_t*)(ws + WS_WIN), DM, DM, DM}; pg8::StaticOrder S; S.init(M, DIN, G, bx);
        EpiProj E{(bf16_t*)(ws + WS_AP), (bf16_t*)(ws + WS_SG), (bf16_t*)(ws + WS_UB), (bf16_t*)(ws + WS_VB), (float*)(ws + WS_PV)};
        pg8::gemm_phase<EpiProj, pg8::StaticOrder, true>(lds, g, S, E);
    }
    SEAM(1);
    if (IN(2)) {
        pg8::GroupOrder GO; GO.init(G, bx);
        for (int i = 0;; ++i) {
            Unit u; if (!GO.next(i, u)) break;
            pg8::OneUnit S1{u.pm, u.pn};
            { pg8::Gemm g{(const bf16_t*)(ws + WS_AP), (const bf16_t*)(ws + WS_FT), KA, 256, 256}; EpiS E{};
              pg8::gemm_phase<EpiS, pg8::OneUnit, false>(lds, g, S1, E); }
            __syncthreads();
            if (tid < 128) {
                const int b2 = tid >> 6, n = tid & 63; const LAS float* S = (const LAS float*)lds + (b2 * 128) * 132 + n;
                bf16_t* hp = (bf16_t*)(ws + WS_AP) + ((size_t)u.pm * 256 + b2 * 128) * KA + 256 + n;
                const f32x2 a16 = *(const f32x2*)((const float*)(ws + WS_A16) + (size_t)(u.pn * 64 + n) * 2);
                float hr = 0.f, hi = 0.f;
#pragma unroll 8
                for (int c = 0; c < NCH; ++c) {
                    const float sr = S[c * 132], si = S[c * 132 + 64];
                    const unsigned w = cvt_pk_bf16(hr, hi);
                    hp[(size_t)c * KA] = (bf16_t)(w & 0xffffu); hp[(size_t)c * KA + 64] = (bf16_t)(w >> 16);
                    const float nr = a16.x * hr - a16.y * hi + sr, ni = a16.x * hi + a16.y * hr + si; hr = nr; hi = ni;
                }
            }
            asm volatile("s_waitcnt vmcnt(0)" ::: "memory");
            __syncthreads();
            { pg8::Gemm g{(const bf16_t*)(ws + WS_AP), (const bf16_t*)(ws + WS_TME), KA, KA, KA};
              EpiSsm E{(const bf16_t*)(ws + WS_AP), (const bf16_t*)(ws + WS_SG), p.in[9], (bf16_t*)(ws + WS_Y), (float*)(ws + WS_PA)};
              pg8::gemm_phase<EpiSsm, pg8::OneUnit, true>(lds, g, S1, E); }
        }
        for (int uu = bx; uu < 1024; uu += G) sgu_unit(p, lds, uu, tid);
    }
    SEAM(2);
    if (IN(3)) {
        pg8::StaticOrder S; S.init(M, DM, G, bx);
        LAS f32x2* tab = (LAS f32x2*)(lds + TAB_OFF);
        const float* PA = (const float*)(ws + WS_PA); const float* PB = (const float*)(ws + WS_PB);
        for (int idx = tid; idx < TAB_BYTES / 8; idx += NTHR) {
            Unit u; if (!S.next(idx >> 8, u)) break;
            const int row = u.pm * 256 + (idx & 255); const f32x4* pa = (const f32x4*)(PA + (size_t)row * 64); float sa = 0.f;
#pragma unroll
            for (int j = 0; j < 16; ++j) { const f32x4 v = pa[j]; sa += (v[0] + v[1]) + (v[2] + v[3]); }
            const f32x4* pb = (const f32x4*)(PB + (size_t)row * 8); const f32x4 b0 = pb[0], b1 = pb[1]; const float sbb = ((b0[0] + b0[1]) + (b0[2] + b0[3])) + ((b1[0] + b1[1]) + (b1[2] + b1[3]));
            const float ra = 1.0f / sqrtf(sa * (1.0f / 1024.0f) + EPS), rb = 1.0f / sqrtf(sbb * (1.0f / 1024.0f) + EPS);
            tab[idx] = (f32x2){ra / rb, rb};
        }
        __syncthreads();
        pg8::Gemm g{(const bf16_t*)(ws + WS_Y), (const bf16_t*)(ws + WS_WOUT), DM, DM, DM};
        EpiOut E{p.in[0], (bf16_t*)(ws + WS_H1B), (float*)(ws + WS_P2), tab};
        pg8::gemm_phase<EpiOut, pg8::StaticOrder, true>(lds, g, S, E);
    }
    SEAM(3);
    if (IN(4)) {
        pg8::StaticOrder S; S.init(M, DFF, G, bx);
        LAS float* tab = (LAS float*)(lds + TAB_OFF);
        const float* P2 = (const float*)(ws + WS_P2);
        for (int idx = tid; idx < TAB_BYTES / 4; idx += NTHR) {
            Unit u; if (!S.next(idx >> 8, u)) break;
            const int row = u.pm * 256 + (idx & 255); const f32x4* pp = (const f32x4*)(P2 + (size_t)row * 32); float s = 0.f;
#pragma unroll
            for (int j = 0; j < 8; ++j) { const f32x4 v = pp[j]; s += (v[0] + v[1]) + (v[2] + v[3]); }
            tab[idx] = 1.0f / sqrtf(s * (1.0f / DM) + EPS);
        }
        __syncthreads();
        pg8::Gemm g{(const bf16_t*)(ws + WS_H1B), (const bf16_t*)(ws + WS_W1), DM, DM, DM};
        EpiFF1 E{(bf16_t*)(ws + WS_HID), tab};
        pg8::gemm_phase<EpiFF1, pg8::StaticOrder, true>(lds, g, S, E);
    }
    SEAM(4);
    if (IN(5)) {
        pg8::StaticOrder S; S.init(M, DM, G, bx);
        pg8::Gemm g{(const bf16_t*)(ws + WS_HID), (const bf16_t*)(ws + WS_W2), DFF, DFF, DFF};
        EpiFF2 E{(bf16_t*)(ws + WS_H1B), (float*)(ws + WS_P3)};
        pg8::gemm_phase<EpiFF2, pg8::StaticOrder, true>(lds, g, S, E);
    }
    SEAM(5);
    if (IN(6)) {
        const int gw = bx * NWAVES + wave, NGW = G * NWAVES; const float* P3 = (const float*)(ws + WS_P3); const float* fg = p.in[20]; const bf16_t* H2 = (const bf16_t*)(ws + WS_H1B);
        for (int m = gw; m < M; m += NGW) {
            const float ps = (lane < 32) ? P3[(size_t)m * 32 + lane] : 0.f;
            const u32x4* hr = (const u32x4*)(H2 + (size_t)m * DM) + lane; u32x4 hv[4];
#pragma unroll
            for (int j = 0; j < 4; ++j) hv[j] = hr[64 * j];
            const float r = 1.0f / sqrtf(wave_sum(ps) * (1.0f / DM) + EPS);
            f32x4* orow = (f32x4*)(p.out + (size_t)m * DM) + 2 * lane;
#pragma unroll
            for (int j = 0; j < 4; ++j) { const f32x4 g0 = *((const f32x4*)fg + 128 * j + 2 * lane), g1 = *((const f32x4*)fg + 128 * j + 2 * lane + 1);
                f32x4 o0 = {bf_lo(hv[j].x), bf_hi(hv[j].x), bf_lo(hv[j].y), bf_hi(hv[j].y)}, o1 = {bf_lo(hv[j].z), bf_hi(hv[j].z), bf_lo(hv[j].w), bf_hi(hv[j].w)};
                orow[128 * j] = o0 * r * g0; orow[128 * j + 1] = o1 * r * g1; }
        }
    }
#ifdef DBG_STOP
    grid.sync();
    {
        const size_t NT = (size_t)M * DM; const size_t gt = (size_t)bx * NTHR + tid, gs = (size_t)G * NTHR;
        const bf16_t* XN = (const bf16_t*)(ws + WS_XN); const bf16_t* WINp = (const bf16_t*)(ws + WS_WIN); const bf16_t* WOUTp = (const bf16_t*)(ws + WS_WOUT);
        const bf16_t* W1p = (const bf16_t*)(ws + WS_W1); const bf16_t* W2p = (const bf16_t*)(ws + WS_W2); const bf16_t* TMEp = (const bf16_t*)(ws + WS_TME); const bf16_t* FTp = (const bf16_t*)(ws + WS_FT);
        const bf16_t* SGp = (const bf16_t*)(ws + WS_SG); const bf16_t* UBp = (const bf16_t*)(ws + WS_UB); const bf16_t* VBp = (const bf16_t*)(ws + WS_VB); const bf16_t* APp = (const bf16_t*)(ws + WS_AP);
        const bf16_t* Yp = (const bf16_t*)(ws + WS_Y); const bf16_t* H1Bp = (const bf16_t*)(ws + WS_H1B); const bf16_t* HIDp = (const bf16_t*)(ws + WS_HID);
        const float* Sp = (const float*)(ws + WS_S); const float* PVp = (const float*)(ws + WS_PV); const float* PAp = (const float*)(ws + WS_PA); const float* PBp = (const float*)(ws + WS_PB);
        const float* P2p = (const float*)(ws + WS_P2); const float* P3p = (const float*)(ws + WS_P3);
#define BFV(p, i) __uint_as_float(((unsigned)(p)[(i)]) << 16)
        for (size_t i = gt; i < NT; i += gs) {
            float v = 0.f;
            if (DBG_STOP == 0) v = BFV(XN, i) + BFV(WINp, i % (size_t)(DIN * DM)) + BFV(WOUTp, i % (size_t)(DM * DM)) + BFV(W1p, i % (size_t)(DFF * DM)) + BFV(W2p, i % (size_t)(DFF * DM)) + BFV(TMEp, i % (size_t)(64 * 256 * KA)) + BFV(FTp, i % (size_t)(64 * 256 * 256));
            if (DBG_STOP == 1) { const size_t e = i % (size_t)(65536 * 256); v = BFV(SGp, i % (size_t)(M * 1024)) + 0.f * (float)(e & 1); }
            if (DBG_STOP == 2) v = Sp[i % (size_t)(65536 * 128)];
            if (DBG_STOP == 3) { const size_t e = i % (size_t)(65536 * 128), y = i % (size_t)(M * 1024); v = BFV(APp, (e >> 7) * KA + 256 + (e & 127)) + BFV(Yp, (y >> 10) * DM + 1024 + (y & 1023)) + PBp[i % (size_t)(M * 8)]; }
            if (DBG_STOP == 4) { const size_t y = i % (size_t)(M * 1024); v = BFV(Yp, (y >> 10) * DM + (y & 1023)) + PAp[i % (size_t)(M * 64)]; }
            if (DBG_STOP == 5) v = p.out[i] + BFV(H1Bp, i) + P2p[i % (size_t)(M * 32)];
            if (DBG_STOP == 6) v = BFV(HIDp, i) + BFV(HIDp, i + NT) + BFV(HIDp, i + 2 * NT) + BFV(HIDp, i + 3 * NT);
            if (DBG_STOP == 7) v = p.out[i] + P3p[i % (size_t)(M * 32)];
            p.out[i] = v;
        }
    }
#endif
#undef IN
#undef SEAM
}

extern "C" void kernel_launch(void* const* d_in, const int* in_sizes, int n_in, void* d_out, int out_size, void* d_ws, size_t ws_size, hipStream_t stream) {
    static int grid = 0;
    if (grid == 0) {
        if (n_in != 21 || out_size != M * DM || ws_size < WS_END) { fprintf(stderr, "kernel_launch: unexpected shapes (n_in %d, out %d, ws %zu)\n", n_in, out_size, ws_size); grid = -1; return; }
        int dev = 0, cus = 0, per_cu = 0;
        hipGetDevice(&dev); hipDeviceGetAttribute(&cus, hipDeviceAttributeMultiprocessorCount, dev);
        if (hipFuncSetAttribute((const void*)fwd_megakernel, hipFuncAttributeMaxDynamicSharedMemorySize, LDS_BYTES) != hipSuccess) { fprintf(stderr, "kernel_launch: hipFuncSetAttribute failed\n"); grid = -1; return; }
        if (hipOccupancyMaxActiveBlocksPerMultiprocessor(&per_cu, (const void*)fwd_megakernel, NTHR, LDS_BYTES) != hipSuccess || per_cu < 1) { fprintf(stderr, "kernel_launch: occupancy query failed (%d)\n", per_cu); (void)hipGetLastError(); per_cu = 1; }
        grid = cus * per_cu;
        if (grid > 256) grid = 256;
    }
    if (grid < 0) return;
#ifdef DIAG_POISON_WS
    (void)hipMemsetAsync((unsigned char*)d_ws, 0xAA, WS_END, stream);
#endif
    Params p{};
    for (int i = 0; i < 21; ++i) p.in[i] = (const float*)d_in[i];
    p.out = (float*)d_out; p.ws = (unsigned char*)d_ws;
#if MK_MULTI
    for (int ph = 0; ph < 7; ++ph) { p.ph_lo = ph; p.ph_hi = ph + 1; hipLaunchKernelGGL(fwd_megakernel, dim3(grid), dim3(NTHR), LDS_BYTES, stream, p); }
#else
#ifdef DBG_STOP
    p.ph_lo = 0; p.ph_hi = DBG_STOP + 1;
#else
    p.ph_lo = 0; p.ph_hi = 7;
#endif
    (void)hipMemsetAsync(d_ws, 0, XCD_BAR_WORDS * 4, stream);
    void* args[] = {&p};
    hipError_t e = hipLaunchCooperativeKernel((const void*)fwd_megakernel, dim3(grid), dim3(NTHR), args, LDS_BYTES, stream);
    if (e != hipSuccess) fprintf(stderr, "cooperative launch failed: %s (grid %d)\n", hipGetErrorString(e), grid);
#endif
}
```

```cpp
#include <hip/hip_runtime.h>
#include <hip/hip_cooperative_groups.h>
#include <cstdio>
#include <cstdint>
namespace cg = cooperative_groups;

#ifndef MK_MULTI
#define MK_MULTI 0
#endif

#define LAS __attribute__((address_space(3)))
typedef unsigned short bf16_t;
typedef short bf16x8 __attribute__((ext_vector_type(8)));
typedef float f32x4 __attribute__((ext_vector_type(4)));
typedef float f32x2 __attribute__((ext_vector_type(2)));
typedef unsigned u32x4 __attribute__((ext_vector_type(4)));
typedef unsigned u32x2 __attribute__((ext_vector_type(2)));

typedef __bf16 bf16x2_t __attribute__((ext_vector_type(2)));
__device__ __forceinline__ unsigned cvt_pk_bf16(float lo, float hi) { const f32x2 v = {lo, hi}; const bf16x2_t b = __builtin_convertvector(v, bf16x2_t); return __builtin_bit_cast(unsigned, b); }
__device__ __forceinline__ float bf_lo(unsigned w) { return __uint_as_float(w << 16); }
__device__ __forceinline__ float bf_hi(unsigned w) { return __uint_as_float(w & 0xffff0000u); }
__device__ __forceinline__ float gelu_tanh(float x) {
    const float t = x * (1.0f + 0.044715f * x * x);
    const float e = __builtin_amdgcn_exp2f(-2.3022081984f * t);
    return x * __builtin_amdgcn_rcpf(1.0f + e);
}
__device__ __forceinline__ float sigmoid_f(float x) { return __builtin_amdgcn_rcpf(1.0f + __builtin_amdgcn_exp2f(-1.4426950409f * x)); }

namespace pg8 {
constexpr int BM = 256, BK = 64, HALF = 128, HTB = HALF * BK * 2, STAGE_BYTES = 8 * HTB, NXCD = 8, WGM = 8;
__host__ __device__ __forceinline__ int lds_byte(int r, int c) { const int st = (r >> 4) * 2 + (c >> 5), rr = r & 15, cc = c & 31, ob = rr * 64 + cc * 2; return st * 1024 + (ob ^ (((ob >> 9) & 1) << 5)); }
__host__ __device__ __forceinline__ void stage_rc(int b, int& R, int& C) { const int st = b / 1024, sb = b % 1024, swz = sb ^ (((sb >> 9) & 1) << 5); R = (st >> 1) * 16 + swz / 64; C = (st & 1) * 32 + (swz % 64) / 2; }
__host__ __device__ __forceinline__ int perm32(int rho) { const int n = rho >> 4, i = rho & 15; return 8 * (i >> 2) + 4 * n + (i & 3); }

struct Unit { int pm, pn; };
struct Gemm { const bf16_t* A; const bf16_t* Bt; int lda, ldb, K; };

struct StaticOrder {
    int nM, nN, nwg, G, c;
    __device__ void init(int M, int N, int G_, int c_) { nM = M / BM; nN = N / BM; nwg = nM * nN; G = G_; c = c_; }
    __device__ bool next(int i, Unit& u) const {
        const long L = (long)i * G + c; if (L >= nwg) return false;
        int wgid = (int)L; { const int q = nwg / NXCD, r = nwg % NXCD, xcd = wgid % NXCD, off = wgid / NXCD; wgid = (xcd < r ? xcd * (q + 1) : r * (q + 1) + (xcd - r) * q) + off; }
        const int nig = WGM * nN, gid = wgid / nig, fm = gid * WGM, gsz = (nM - fm) < WGM ? (nM - fm) : WGM;
        u.pm = fm + ((wgid % nig) % gsz); u.pn = (wgid % nig) / gsz; return true;
    }
};
struct GroupOrder {
    int G, c;
    __device__ void init(int G_, int c_) { G = G_; c = c_; }
    __device__ bool next(int i, Unit& u) const {
        const int L = i * G + c; if (L >= 256) return false;
        const int Lr = (L & 7) * 32 + (L >> 3); u.pm = Lr; u.pn = Lr >> 2; return true;
    }
};

struct OneUnit { int pm, pn; __device__ bool next(int i, Unit& u) const { if (i != 0) return false; u.pm = pm; u.pn = pn; return true; } };

template <class Epi, class Sched, bool ALIGN_EPI>
__device__ __forceinline__ void gemm_phase(LAS unsigned char* lds, const Gemm g, const Sched& S, const Epi& E) {
    const int tid = threadIdx.x, wid = __builtin_amdgcn_readfirstlane(tid >> 6), lane = tid & 63, wr = wid >> 2, wc = wid & 3, fr = lane & 15, fq = lane >> 4;
    int nt = g.K / BK; asm volatile("" : "+s"(nt));
    unsigned voffA[2], voffB[2];
#pragma unroll
    for (int i = 0; i < 2; ++i) { int R, C; stage_rc(tid * 16 + i * 8192, R, C); const int Rb = Epi::PERM ? ((R & ~31) + perm32(R & 31)) : R;
        voffA[i] = (unsigned)(R * g.lda + C) * 2u; voffB[i] = (unsigned)(Rb * g.ldb + C) * 2u; }
    const size_t kstep = (size_t)(BK * 2);
    const size_t hstepA = (size_t)HALF * g.lda * 2, hstepB = (size_t)HALF * g.ldb * 2;
    const size_t tstepA = 2 * hstepA, tstepB = 2 * hstepB;
    const unsigned ldsw = (unsigned)wid * 1024u;
    const int aoff = lds_byte(wr * 64 + fr, fq * 8), boff = lds_byte(wc * 32 + fr, fq * 8);
#define PG8_SA(b, h) (((b) * 2 + (h)) * HTB)
#define PG8_SB(b, h) ((4 + (b) * 2 + (h)) * HTB)
#define PG8_STAGE(bufoff, gbase, voff) do { _Pragma("unroll") for (int _i = 0; _i < 2; ++_i) \
        __builtin_amdgcn_global_load_lds((const unsigned*)((const char*)(gbase) + (voff)[_i]), (LAS unsigned*)(lds + (bufoff) + ldsw + _i * 8192), 16, 0, 0); } while (0)
#define PG8_LDA(dst, b, h) do { _Pragma("unroll") for (int m = 0; m < 4; ++m) _Pragma("unroll") for (int k = 0; k < 2; ++k) dst[m][k] = *(const LAS bf16x8*)(lds + PG8_SA(b, h) + aoff + m * 2048 + k * 1024); } while (0)
#define PG8_LDB(dst, b, h) do { _Pragma("unroll") for (int n = 0; n < 2; ++n) _Pragma("unroll") for (int k = 0; k < 2; ++k) dst[n][k] = *(const LAS bf16x8*)(lds + PG8_SB(b, h) + boff + n * 2048 + k * 1024); } while (0)
#define PG8_MMA(ai, bj, At, Bt) do { __builtin_amdgcn_s_setprio(1); _Pragma("unroll") for (int m = 0; m < 4; ++m) _Pragma("unroll") for (int n = 0; n < 2; ++n) _Pragma("unroll") for (int k = 0; k < 2; ++k) \
        acc[ai][bj][m][n] = __builtin_amdgcn_mfma_f32_16x16x32_bf16(Bt[n][k], At[m][k], acc[ai][bj][m][n], 0, 0, 0); __builtin_amdgcn_s_setprio(0); } while (0)
#define PG8_WAIT_V(n) asm volatile("s_waitcnt vmcnt(" #n ")" ::: "memory")
#define PG8_WAIT_L(n) asm volatile("s_waitcnt lgkmcnt(" #n ")" ::: "memory")
#define PG8_BAR __builtin_amdgcn_s_barrier()
#define PG8_SCHED __builtin_amdgcn_sched_barrier(0)
    Unit cur, nxt; int ui = 0;
    if (!S.next(0, cur)) return;
    f32x4 acc[2][2][4][2];
#pragma unroll
    for (int a = 0; a < 2; ++a)
#pragma unroll
        for (int b = 0; b < 2; ++b)
#pragma unroll
            for (int m = 0; m < 4; ++m)
#pragma unroll
                for (int n = 0; n < 2; ++n) acc[a][b][m][n] = (f32x4){0.f, 0.f, 0.f, 0.f};
    bf16x8 At[4][2], B0[2][2], B1[2][2];
    const char* cA = (const char*)g.A + (size_t)cur.pm * tstepA; const char* cB = (const char*)g.Bt + (size_t)cur.pn * tstepB;
    PG8_STAGE(PG8_SB(0, 0), cB, voffB); PG8_STAGE(PG8_SB(0, 1), cB + hstepB, voffB); PG8_STAGE(PG8_SA(0, 0), cA, voffA); PG8_STAGE(PG8_SA(0, 1), cA + hstepA, voffA);
    if (wr == 1) PG8_BAR;
    PG8_WAIT_V(2); PG8_BAR;
    PG8_STAGE(PG8_SB(1, 0), cB + kstep, voffB); PG8_STAGE(PG8_SA(1, 0), cA + kstep, voffA); PG8_STAGE(PG8_SB(1, 1), cB + hstepB + kstep, voffB);
    PG8_WAIT_V(6); PG8_BAR;
    for (;;) {
        const bool has_next = S.next(ui + 1, nxt);
        const char* nA = has_next ? (const char*)g.A + (size_t)nxt.pm * tstepA : cA; const char* nB = has_next ? (const char*)g.Bt + (size_t)nxt.pn * tstepB : cB;
#pragma nounroll
        for (int t = 0; t < nt; t += 2) {
            const bool last = (t == nt - 2);
            const char* a1 = cA + (size_t)(t + 1) * kstep;
            const char* a2 = last ? nA : cA + (size_t)(t + 2) * kstep; const char* b2 = last ? nB : cB + (size_t)(t + 2) * kstep;
            const char* a3 = a2 + kstep; const char* b3 = b2 + kstep;
            if constexpr (Epi::HAS_MID) { if (t == (nt >> 1)) E.mid(acc, ui, wr, fr); }
            PG8_LDB(B0, 0, 0); PG8_LDB(B1, 0, 1); PG8_SCHED; PG8_LDA(At, 0, 0); PG8_STAGE(PG8_SA(1, 1), a1 + hstepA, voffA);
            PG8_WAIT_V(8); PG8_WAIT_L(0); PG8_BAR; PG8_MMA(0, 0, At, B0); PG8_MMA(0, 1, At, B1); PG8_BAR; PG8_SCHED;
            PG8_LDA(At, 0, 1); PG8_STAGE(PG8_SB(0, 0), b2, voffB); PG8_STAGE(PG8_SB(0, 1), b2 + hstepB, voffB); PG8_STAGE(PG8_SA(0, 0), a2, voffA);
            PG8_WAIT_V(8); PG8_WAIT_L(0); PG8_BAR; PG8_MMA(1, 0, At, B0); PG8_MMA(1, 1, At, B1); PG8_BAR; PG8_SCHED;
            PG8_LDB(B0, 1, 0); PG8_LDB(B1, 1, 1); PG8_SCHED; PG8_LDA(At, 1, 0); PG8_STAGE(PG8_SA(0, 1), a2 + hstepA, voffA);
            PG8_WAIT_V(8); PG8_WAIT_L(0); PG8_BAR; PG8_MMA(0, 0, At, B0); PG8_MMA(0, 1, At, B1); PG8_BAR; PG8_SCHED;
            PG8_LDA(At, 1, 1); PG8_STAGE(PG8_SB(1, 0), b3, voffB); PG8_STAGE(PG8_SB(1, 1), b3 + hstepB, voffB); PG8_STAGE(PG8_SA(1, 0), a3, voffA);
            PG8_WAIT_V(8); PG8_WAIT_L(0); PG8_BAR; PG8_MMA(1, 0, At, B0); PG8_MMA(1, 1, At, B1); PG8_BAR; PG8_SCHED;
        }
        if constexpr (ALIGN_EPI) { if (wr == 0) PG8_BAR; }
        if constexpr (!Epi::AFTER_DRAIN) E(acc, cur, ui, wr, wc, fr, fq);
        if (!has_next) break;
#pragma unroll
        for (int a = 0; a < 2; ++a)
#pragma unroll
            for (int b = 0; b < 2; ++b)
#pragma unroll
                for (int m = 0; m < 4; ++m)
#pragma unroll
                    for (int n = 0; n < 2; ++n) acc[a][b][m][n] = (f32x4){0.f, 0.f, 0.f, 0.f};
        cur = nxt; cA = nA; cB = nB; ++ui;
        if constexpr (ALIGN_EPI) { if (wr == 1) PG8_BAR; }
    }
    PG8_WAIT_V(0);
    if constexpr (!ALIGN_EPI) { if (wr == 0) PG8_BAR; }
    PG8_BAR;
    if constexpr (Epi::AFTER_DRAIN) E.after(acc, cur, wr, wc, fr, fq, lds);
#undef PG8_SA
#undef PG8_SB
#undef PG8_STAGE
#undef PG8_LDA
#undef PG8_LDB
#undef PG8_MMA
#undef PG8_WAIT_V
#undef PG8_WAIT_L
#undef PG8_BAR
#undef PG8_SCHED
}
}
using pg8::Unit;

constexpr int BATCH = 8, SEQ = 2048, DM = 2048, M = BATCH * SEQ;
constexpr int DSSM = 1024, DSGU = 1024, DIN = 4096, DFF = 8192;
constexpr int NG = 64, GS = 16, NS = 64;
constexpr int LC = 16, NCH = SEQ / LC;
constexpr int KA = LC * GS + 2 * NS;
constexpr float EPS = 1e-5f;
constexpr int NWAVES = 8, NTHR = 512;

constexpr size_t MiB = 1u << 20;
constexpr size_t WS_WIN = 1 * MiB, WS_WOUT = 17 * MiB, WS_W1 = 25 * MiB, WS_W2 = 57 * MiB;
constexpr size_t WS_TME = 89 * MiB;
constexpr size_t WS_FT = 101 * MiB;
constexpr size_t WS_A16 = 109 * MiB;
constexpr size_t WS_PV = 110 * MiB;
constexpr size_t WS_PA = 111 * MiB;
constexpr size_t WS_PB = 115 * MiB;
constexpr size_t WS_P2 = 116 * MiB;
constexpr size_t WS_P3 = 118 * MiB;
constexpr size_t WS_H1B = 120 * MiB;
constexpr size_t WS_R1 = 184 * MiB;
constexpr size_t WS_XN = WS_R1;
constexpr size_t WS_S = WS_R1;
constexpr size_t WS_Y = WS_R1 + 64 * MiB;
constexpr size_t WS_AP = WS_R1 + 128 * MiB;
constexpr size_t WS_SG = WS_R1 + 176 * MiB;
constexpr size_t WS_UB = WS_R1 + 208 * MiB;
constexpr size_t WS_VB = WS_R1 + 240 * MiB;
constexpr size_t WS_HID = WS_R1;
constexpr size_t WS_END = WS_R1 + 272 * MiB;

constexpr int RING_BYTES = 131072, TAB_OFF = RING_BYTES, TAB_BYTES = 16384, MISC_OFF = TAB_OFF + TAB_BYTES, LDS_BYTES = MISC_OFF + 256;

struct EpiProj {
    static constexpr bool PERM = true, HAS_MID = false, AFTER_DRAIN = false;
    bf16_t *Ap, *SG, *UB, *VB; float* PV;
    template <int SECT> __device__ __forceinline__ void body(const f32x4 (&acc)[2][2][4][2], const Unit& u, int wr, int wc, int fr, int fq) const {
        const int colt = (u.pn & 3) * 256 + wc * 32 + 8 * fq;
        const int row0 = u.pm * 256 + wr * 64 + fr;
#pragma unroll
        for (int ai = 0; ai < 2; ++ai)
#pragma unroll
            for (int m = 0; m < 4; ++m) {
                const int row = row0 + ai * 128 + m * 16; float ss = 0.f;
#pragma unroll
                for (int bj = 0; bj < 2; ++bj) {
                    const int col8 = colt + bj * 128;
                    f32x4 v0 = acc[ai][bj][m][0], v1 = acc[ai][bj][m][1];
                    if (SECT == 1) {
#pragma unroll
                        for (int j = 0; j < 4; ++j) { v0[j] = sigmoid_f(v0[j]); v1[j] = sigmoid_f(v1[j]); }
                    }
                    if (SECT >= 2) {
#pragma unroll
                        for (int j = 0; j < 4; ++j) { v0[j] = gelu_tanh(v0[j]); v1[j] = gelu_tanh(v1[j]); }
                    }
                    if (SECT == 3) ss += (v0[0] * v0[0] + v0[1] * v0[1]) + (v0[2] * v0[2] + v0[3] * v0[3]) + (v1[0] * v1[0] + v1[1] * v1[1]) + (v1[2] * v1[2] + v1[3] * v1[3]);
                    u32x4 w; w.x = cvt_pk_bf16(v0[0], v0[1]); w.y = cvt_pk_bf16(v0[2], v0[3]); w.z = cvt_pk_bf16(v1[0], v1[1]); w.w = cvt_pk_bf16(v1[2], v1[3]);
                    bf16_t* dst;
                    if (SECT == 0) dst = Ap + ((size_t)((col8 >> 4) * 1024 + (row >> 4)) * KA + (row & 15) * 16 + (col8 & 15));
                    else if (SECT == 1) dst = SG + (size_t)row * 1024 + col8;
                    else if (SECT == 2) dst = UB + (size_t)row * 1024 + col8;
                    else dst = VB + (size_t)row * 1024 + col8;
                    *(u32x4*)dst = w;
                }
                if (SECT == 3) { ss += __shfl_xor(ss, 16); ss += __shfl_xor(ss, 32); if (fq == 0) PV[(size_t)row * 16 + (u.pn & 3) * 4 + wc] = ss; }
            }
    }
    __device__ __forceinline__ void operator()(const f32x4 (&acc)[2][2][4][2], const Unit& u, int ui, int wr, int wc, int fr, int fq) const {
        const int sect = u.pn >> 2;
        if (sect == 0) body<0>(acc, u, wr, wc, fr, fq); else if (sect == 1) body<1>(acc, u, wr, wc, fr, fq);
        else if (sect == 2) body<2>(acc, u, wr, wc, fr, fq); else body<3>(acc, u, wr, wc, fr, fq);
    }
};
struct EpiS {
    static constexpr bool PERM = false, HAS_MID = false, AFTER_DRAIN = true;
    __device__ __forceinline__ void operator()(const f32x4 (&acc)[2][2][4][2], const Unit& u, int ui, int wr, int wc, int fr, int fq) const {}
    __device__ __forceinline__ void after(const f32x4 (&acc)[2][2][4][2], const Unit& u, int wr, int wc, int fr, int fq, LAS unsigned char* lds) const {
        LAS float* S = (LAS float*)lds; const int row0 = wr * 64 + fr, col0 = wc * 32 + 4 * fq;
#pragma unroll
        for (int ai = 0; ai < 2; ++ai)
#pragma unroll
            for (int m = 0; m < 4; ++m) { LAS float* rp = S + (row0 + ai * 128 + m * 16) * 132 + col0;
#pragma unroll
                for (int n = 0; n < 2; ++n) *(LAS f32x4*)(rp + n * 16) = acc[ai][0][m][n]; }
    }
};
struct EpiSsm {
    static constexpr bool PERM = true, HAS_MID = false, AFTER_DRAIN = false;
    const bf16_t *Ap, *SG; const float* dsk; bf16_t* Y; float* PA;
    __device__ __forceinline__ void operator()(const f32x4 (&acc)[2][2][4][2], const Unit& u, int ui, int wr, int wc, int fr, int fq) const {
        asm volatile("" : "+v"(fr), "+v"(fq));
        const int g = u.pn;
#pragma unroll
        for (int bj = 0; bj < 2; ++bj) {
            const int col8 = bj * 128 + wc * 32 + 8 * fq, t = col8 >> 4, hh = col8 & 15, ch = g * 16 + hh;
            const f32x4 d0 = *(const f32x4*)(dsk + ch), d1 = *(const f32x4*)(dsk + ch + 4);
#pragma unroll
            for (int ai = 0; ai < 2; ++ai)
#pragma unroll
                for (int m = 0; m < 4; ++m) {
                    const int R = u.pm * 256 + ai * 128 + wr * 64 + m * 16 + fr, rg = R & 1023, token = (rg >> 7) * SEQ + (rg & 127) * LC + t;
                    const u32x4 uu = *(const u32x4*)(Ap + (size_t)R * KA + t * 16 + hh);
                    const u32x4 sg = *(const u32x4*)(SG + (size_t)token * 1024 + ch);
                    const f32x4 a0 = acc[ai][bj][m][0], a1 = acc[ai][bj][m][1];
                    float o[8];
                    o[0] = gelu_tanh(a0[0] + d0[0] * bf_lo(uu.x)) * bf_lo(sg.x); o[1] = gelu_tanh(a0[1] + d0[1] * bf_hi(uu.x)) * bf_hi(sg.x);
                    o[2] = gelu_tanh(a0[2] + d0[2] * bf_lo(uu.y)) * bf_lo(sg.y); o[3] = gelu_tanh(a0[3] + d0[3] * bf_hi(uu.y)) * bf_hi(sg.y);
                    o[4] = gelu_tanh(a1[0] + d1[0] * bf_lo(uu.z)) * bf_lo(sg.z); o[5] = gelu_tanh(a1[1] + d1[1] * bf_hi(uu.z)) * bf_hi(sg.z);
                    o[6] = gelu_tanh(a1[2] + d1[2] * bf_lo(uu.w)) * bf_lo(sg.w); o[7] = gelu_tanh(a1[3] + d1[3] * bf_hi(uu.w)) * bf_hi(sg.w);
                    float ss = (o[0] * o[0] + o[1] * o[1]) + (o[2] * o[2] + o[3] * o[3]) + (o[4] * o[4] + o[5] * o[5]) + (o[6] * o[6] + o[7] * o[7]);
                    u32x4 w; w.x = cvt_pk_bf16(o[0], o[1]); w.y = cvt_pk_bf16(o[2], o[3]); w.z = cvt_pk_bf16(o[4], o[5]); w.w = cvt_pk_bf16(o[6], o[7]);
                    *(u32x4*)(Y + (size_t)token * DM + ch) = w;
                    ss += __shfl_xor(ss, 16);
                    if ((fq & 1) == 0) PA[(size_t)token * 64 + g] = ss;
                    asm volatile("" ::: "memory"); __builtin_amdgcn_sched_barrier(0);
                }
        }
    }
};
struct EpiOut {
    static constexpr bool PERM = true, HAS_MID = true, AFTER_DRAIN = false;
    const float* x; bf16_t* H1B; float* P2; const LAS f32x2* tab;
    __device__ __forceinline__ void mid(f32x4 (&acc)[2][2][4][2], int ui, int wr, int fr) const {
#pragma unroll
        for (int ai = 0; ai < 2; ++ai)
#pragma unroll
            for (int m = 0; m < 4; ++m) { const float s = tab[ui * 256 + ai * 128 + wr * 64 + m * 16 + fr].x;
#pragma unroll
                for (int bj = 0; bj < 2; ++bj)
#pragma unroll
                    for (int n = 0; n < 2; ++n) acc[ai][bj][m][n] *= s; }
    }
    __device__ __forceinline__ void operator()(const f32x4 (&acc)[2][2][4][2], const Unit& u, int ui, int wr, int wc, int fr, int fq) const {
#pragma unroll
        for (int ai = 0; ai < 2; ++ai)
#pragma unroll
            for (int m = 0; m < 4; ++m) {
                const int rl = ai * 128 + wr * 64 + m * 16 + fr, row = u.pm * 256 + rl; const float rb = tab[ui * 256 + rl].y; float ss = 0.f;
#pragma unroll
                for (int bj = 0; bj < 2; ++bj) {
                    const size_t off = (size_t)row * DM + u.pn * 256 + bj * 128 + wc * 32 + 8 * fq;
                    const f32x4 x0 = *(const f32x4*)(x + off), x1 = *(const f32x4*)(x + off + 4);
                    const f32x4 h0 = x0 + acc[ai][bj][m][0] * rb, hv1 = x1 + acc[ai][bj][m][1] * rb;
                    ss += (h0[0] * h0[0] + h0[1] * h0[1]) + (h0[2] * h0[2] + h0[3] * h0[3]) + (hv1[0] * hv1[0] + hv1[1] * hv1[1]) + (hv1[2] * hv1[2] + hv1[3] * hv1[3]);
                    u32x4 w; w.x = cvt_pk_bf16(h0[0], h0[1]); w.y = cvt_pk_bf16(h0[2], h0[3]); w.z = cvt_pk_bf16(hv1[0], hv1[1]); w.w = cvt_pk_bf16(hv1[2], hv1[3]);
                    *(u32x4*)(H1B + off) = w;
                }
                ss += __shfl_xor(ss, 16); ss += __shfl_xor(ss, 32);
                if (fq == 0) P2[(size_t)row * 32 + u.pn * 4 + wc] = ss;
            }
    }
};
struct EpiFF1 {
    static constexpr bool PERM = true, HAS_MID = false, AFTER_DRAIN = false;
    bf16_t* HID; const LAS float* tab;
    __device__ __forceinline__ void operator()(const f32x4 (&acc)[2][2][4][2], const Unit& u, int ui, int wr, int wc, int fr, int fq) const {
#pragma unroll
        for (int ai = 0; ai < 2; ++ai)
#pragma unroll
            for (int m = 0; m < 4; ++m) {
                const int rl = ai * 128 + wr * 64 + m * 16 + fr, row = u.pm * 256 + rl; const float r2 = tab[ui * 256 + rl];
#pragma unroll
                for (int bj = 0; bj < 2; ++bj) {
                    f32x4 v0 = acc[ai][bj][m][0] * r2, v1 = acc[ai][bj][m][1] * r2;
#pragma unroll
                    for (int j = 0; j < 4; ++j) { const float a = fmaxf(v0[j], 0.f), b = fmaxf(v1[j], 0.f); v0[j] = a * a; v1[j] = b * b; }
                    u32x4 w; w.x = cvt_pk_bf16(v0[0], v0[1]); w.y = cvt_pk_bf16(v0[2], v0[3]); w.z = cvt_pk_bf16(v1[0], v1[1]); w.w = cvt_pk_bf16(v1[2], v1[3]);
                    *(u32x4*)(HID + (size_t)row * DFF + u.pn * 256 + bj * 128 + wc * 32 + 8 * fq) = w;
                }
            }
    }
};
struct EpiFF2 {
    static constexpr bool PERM = true, HAS_MID = false, AFTER_DRAIN = false;
    bf16_t* h; float* P3;
    __device__ __forceinline__ void operator()(const f32x4 (&acc)[2][2][4][2], const Unit& u, int ui, int wr, int wc, int fr, int fq) const {
#pragma unroll
        for (int ai = 0; ai < 2; ++ai)
#pragma unroll
            for (int m = 0; m < 4; ++m) {
                const int row = u.pm * 256 + ai * 128 + wr * 64 + m * 16 + fr; float ss = 0.f;
#pragma unroll
                for (int bj = 0; bj < 2; ++bj) {
                    const size_t off = (size_t)row * DM + u.pn * 256 + bj * 128 + wc * 32 + 8 * fq;
                    const u32x4 hb = *(const u32x4*)(h + off); const f32x4 a0 = acc[ai][bj][m][0], a1 = acc[ai][bj][m][1];
                    const float o0 = bf_lo(hb.x) + a0[0], o1 = bf_hi(hb.x) + a0[1], o2 = bf_lo(hb.y) + a0[2], o3 = bf_hi(hb.y) + a0[3];
                    const float o4 = bf_lo(hb.z) + a1[0], o5 = bf_hi(hb.z) + a1[1], o6 = bf_lo(hb.w) + a1[2], o7 = bf_hi(hb.w) + a1[3];
                    ss += (o0 * o0 + o1 * o1) + (o2 * o2 + o3 * o3) + (o4 * o4 + o5 * o5) + (o6 * o6 + o7 * o7);
                    u32x4 w; w.x = cvt_pk_bf16(o0, o1); w.y = cvt_pk_bf16(o2, o3); w.z = cvt_pk_bf16(o4, o5); w.w = cvt_pk_bf16(o6, o7);
                    *(u32x4*)(h + off) = w;
                }
                ss += __shfl_xor(ss, 16); ss += __shfl_xor(ss, 32);
                if (fq == 0) P3[(size_t)row * 32 + u.pn * 4 + wc] = ss;
            }
    }
};

struct PanelOrder {
    int c;
    __device__ bool next(int i, Unit& u) const { if (i >= 2) return false; const int x = c & 7, j = c >> 3; u.pm = i * 32 + x * 4 + (j >> 3); u.pn = j & 7; return true; }
};
struct EpiFF2N {
    static constexpr bool PERM = true, HAS_MID = false, AFTER_DRAIN = false;
    const bf16_t* h1; float* out; const float* gain; float* P3; unsigned* cnt;
    __device__ __forceinline__ void operator()(f32x4 (&acc)[2][2][4][2], const Unit& u, int ui, int wr, int wc, int fr, int fq) const {
        asm volatile("" : "+v"(fr), "+v"(fq));
        const int colw = u.pn * 256 + wc * 32 + 8 * fq;
#pragma unroll
        for (int ai = 0; ai < 2; ++ai)
#pragma unroll
            for (int m = 0; m < 4; ++m) {
                const int row = u.pm * 256 + ai * 128 + wr * 64 + m * 16 + fr; float ss = 0.f;
#pragma unroll
                for (int bj = 0; bj < 2; ++bj) {
                    const u32x4 hb = *(const u32x4*)(h1 + (size_t)row * DM + colw + bj * 128);
                    f32x4& a0 = acc[ai][bj][m][0]; f32x4& a1 = acc[ai][bj][m][1];
                    a0[0] += bf_lo(hb.x); a0[1] += bf_hi(hb.x); a0[2] += bf_lo(hb.y); a0[3] += bf_hi(hb.y);
                    a1[0] += bf_lo(hb.z); a1[1] += bf_hi(hb.z); a1[2] += bf_lo(hb.w); a1[3] += bf_hi(hb.w);
                    ss += (a0[0] * a0[0] + a0[1] * a0[1]) + (a0[2] * a0[2] + a0[3] * a0[3]) + (a1[0] * a1[0] + a1[1] * a1[1]) + (a1[2] * a1[2] + a1[3] * a1[3]);
                }
                ss += __shfl_xor(ss, 16); ss += __shfl_xor(ss, 32);
                if (fq == 0) __hip_atomic_store(P3 + (size_t)row * 32 + u.pn * 4 + wc, ss, __ATOMIC_RELAXED, __HIP_MEMORY_SCOPE_AGENT);
            }
        asm volatile("s_waitcnt vmcnt(0)" ::: "memory");
        unsigned* cp = cnt + 64 * u.pm;
        if ((fr | fq) == 0) __hip_atomic_fetch_add(cp, 1u, __ATOMIC_RELAXED, __HIP_MEMORY_SCOPE_AGENT);
        { unsigned sp = 0;
          while ((unsigned)__builtin_amdgcn_readfirstlane(__hip_atomic_load(cp, __ATOMIC_RELAXED, __HIP_MEMORY_SCOPE_AGENT)) < 64u) { __builtin_amdgcn_s_sleep(2); if (++sp > (1u << 22)) break; } }
        __builtin_amdgcn_fence(__ATOMIC_ACQUIRE, "agent");
        f32x4 g[2][2];
#pragma unroll
        for (int bj = 0; bj < 2; ++bj) { g[bj][0] = *(const f32x4*)(gain + colw + bj * 128); g[bj][1] = *(const f32x4*)(gain + colw + bj * 128 + 4); }
#pragma unroll
        for (int ai = 0; ai < 2; ++ai)
#pragma unroll
            for (int m = 0; m < 4; ++m) {
                const int row = u.pm * 256 + ai * 128 + wr * 64 + m * 16 + fr;
                const unsigned long long* pr = (const unsigned long long*)(P3 + (size_t)row * 32 + fq * 8); float s = 0.f;
#pragma unroll
                for (int k = 0; k < 4; ++k) { const unsigned long long w = __hip_atomic_load(pr + k, __ATOMIC_RELAXED, __HIP_MEMORY_SCOPE_AGENT); s += __uint_as_float((unsigned)w) + __uint_as_float((unsigned)(w >> 32)); }
                s += __shfl_xor(s, 16); s += __shfl_xor(s, 32);
                const float r = 1.0f / sqrtf(s * (1.0f / DM) + EPS);
#pragma unroll
                for (int bj = 0; bj < 2; ++bj) { float* op = out + (size_t)row * DM + colw + bj * 128;
                    *(f32x4*)op = acc[ai][bj][m][0] * r * g[bj][0]; *(f32x4*)(op + 4) = acc[ai][bj][m][1] * r * g[bj][1]; }
                asm volatile("" ::: "memory");
            }
    }
};

__device__ __forceinline__ float wave_sum(float v) {
#pragma unroll
    for (int o = 1; o < 64; o <<= 1) v += __shfl_xor(v, o);
    return v;
}
__device__ __forceinline__ void p0_transpose_item(const float* W, int K, int N, bf16_t* WT, const float* gain, const float* gain_hi, LAS float* scr, int item, int lane) {
    const int nblk = N / 32, kb = item / nblk, nb = item % nblk, k0 = 64 * kb, n0 = 32 * nb;
    const float* gk = gain ? ((gain_hi && k0 >= 1024) ? gain_hi + (k0 - 1024) : gain + k0) : nullptr;
    float wv[32];
#pragma unroll
    for (int i = 0; i < 32; ++i) wv[i] = W[(size_t)(k0 + 2 * i + (lane >> 5)) * N + n0 + (lane & 31)];
#pragma unroll
    for (int i = 0; i < 32; ++i) { const int kk = 2 * i + (lane >> 5); float v = wv[i]; if (gk) v *= gk[kk]; scr[kk * 33 + (lane & 31)] = v; }
    asm volatile("s_waitcnt lgkmcnt(0)" ::: "memory");
    const int c = lane & 7;
#pragma unroll
    for (int j = 0; j < 4; ++j) { const int n = (lane >> 3) + 8 * j; const LAS float* s = scr + (8 * c) * 33 + n;
        u32x4 o; o.x = cvt_pk_bf16(s[0 * 33], s[1 * 33]); o.y = cvt_pk_bf16(s[2 * 33], s[3 * 33]); o.z = cvt_pk_bf16(s[4 * 33], s[5 * 33]); o.w = cvt_pk_bf16(s[6 * 33], s[7 * 33]);
        *(u32x4*)(WT + (size_t)(n0 + n) * K + k0 + 8 * c) = o; }
    asm volatile("s_waitcnt lgkmcnt(0)" ::: "memory");
}
__device__ __forceinline__ f32x2 cpow_k(float lre, float lim, float dt, int k) {
    const float mag = expf((float)k * lre * dt);
    const double rev = (double)k * (double)lim * (double)dt * 0.15915494309189535;
    const float fr = (float)(rev - rint(rev));
    return (f32x2){mag * __builtin_amdgcn_cosf(fr), mag * __builtin_amdgcn_sinf(fr)};
}

#define RLX_AGENT __ATOMIC_RELAXED, __HIP_MEMORY_SCOPE_AGENT
#define XB_TMO      128
#define XB_XCNT(j)  (256  + 64 * (j))
#define XB_XSUB(j)  (1280 + 64 * (j))
#define XB_XGEN(j)  (2304 + 64 * (j))
#define XB_TOP      3328
#define XB_TOPGEN   3392
#define XCD_BAR_WORDS 3456
#define XB_SPIN_CAP (1u << 22)
__device__ __forceinline__ unsigned xb_ld(unsigned* p)              { return __hip_atomic_load(p, __ATOMIC_RELAXED, __HIP_MEMORY_SCOPE_AGENT); }
__device__ __forceinline__ unsigned xb_add(unsigned* p, unsigned v) { return __hip_atomic_fetch_add(p, v, __ATOMIC_RELAXED, __HIP_MEMORY_SCOPE_AGENT); }
__device__ __forceinline__ unsigned xb_xcc_id() { return (unsigned)__builtin_amdgcn_s_getreg((3 << 11) | 20) & 0xFu; }
#define XB_SPIN(cond, bar) do { unsigned _sp = 0; while (cond) { __builtin_amdgcn_s_sleep(1); \
    if ((++_sp & 255u) == 0u) { if (xb_ld(&(bar)[XB_TMO])) break; if (_sp > XB_SPIN_CAP) { atomicAdd(&(bar)[XB_TMO], 1u); break; } } } } while (0)
struct XcdBarrier { unsigned* bar; unsigned x; volatile LAS unsigned* st; };
__device__ __forceinline__ XcdBarrier xcd_barrier_post(unsigned* bar, volatile LAS unsigned* st) {
    XcdBarrier b; b.bar = bar; b.x = xb_xcc_id(); b.st = st;
    if (threadIdx.x == 0) (void)xb_add(&bar[XB_XCNT(b.x)], 1u);
    return b;
}
__device__ __forceinline__ void xcd_barrier_complete(unsigned* bar, unsigned x, unsigned& nloc, unsigned& nx) {
    const unsigned G = gridDim.x * gridDim.y * gridDim.z;
    unsigned sum, cnt, mine, sp = 0u;
    for (;;) {
        sum = 0u; cnt = 0u; mine = 0u;
#pragma unroll
        for (unsigned j = 0; j < 16; ++j) { const unsigned c = xb_ld(&bar[XB_XCNT(j)]); sum += c; cnt += (c > 0u) ? 1u : 0u; mine = (j == x) ? c : mine; }
        if (sum == G) break;
        __builtin_amdgcn_s_sleep(1);
        if ((++sp & 255u) == 0u) { if (xb_ld(&bar[XB_TMO])) break; if (sp > XB_SPIN_CAP) { atomicAdd(&bar[XB_TMO], 1u); break; } }
    }
    nloc = mine > 0u ? mine : 1u; nx = cnt > 0u ? cnt : 1u;
}
__device__ __forceinline__ void xcd_barrier(const XcdBarrier& b) {
    asm volatile("s_waitcnt vmcnt(0)" ::: "memory");
    __syncthreads();
    if (threadIdx.x == 0) {
        unsigned* bar = b.bar;
        __builtin_amdgcn_s_waitcnt(0);
        unsigned nloc = b.st[0], nx = b.st[1];
        if (nloc == 0u) { xcd_barrier_complete(bar, b.x, nloc, nx); b.st[0] = nloc; b.st[1] = nx; }
        const unsigned old = xb_add(&bar[XB_XSUB(b.x)], 1u);
        const unsigned gen = old / nloc;
        if (old + 1u == (gen + 1u) * nloc) {
            __builtin_amdgcn_fence(__ATOMIC_RELEASE, "agent");
            asm volatile("s_waitcnt vmcnt(0)" ::: "memory");
            const unsigned og = xb_add(&bar[XB_TOP], 1u);
            const unsigned tg = og / nx;
            if (og + 1u == (tg + 1u) * nx) xb_add(&bar[XB_TOPGEN], 1u);
            else XB_SPIN(xb_ld(&bar[XB_TOPGEN]) == tg, bar);
            __builtin_amdgcn_fence(__ATOMIC_ACQUIRE, "agent");
            xb_add(&bar[XB_XGEN(b.x)], 1u);
            asm volatile("s_waitcnt vmcnt(0)" ::: "memory");
        } else {
            XB_SPIN(xb_ld(&bar[XB_XGEN(b.x)]) == gen, bar);
            __builtin_amdgcn_fence(__ATOMIC_ACQUIRE, "agent");
            asm volatile("s_waitcnt vmcnt(0)" ::: "memory");
        }
    }
    __syncthreads();
}

struct Params { const float* in[21]; float* out; unsigned char* ws; int ph_lo, ph_hi; };

__device__ __forceinline__ void p0_ssm_task(const Params& p, LAS unsigned char* lds, int g, int d, int tid) {
    LAS float* coef = (LAS float*)lds;
    LAS float* pd = coef + 128;
    LAS float* pd1 = pd + 128;
    LAS float* wre = pd1 + 128;
    LAS float* wim = wre + 1024;
    LAS float* cre = wim + 1024;
    LAS float* cim = cre + 1024;
    const float* a_re = p.in[2]; const float* a_im = p.in[3]; const float* log_dt = p.in[4];
    const float* b_re = p.in[5]; const float* b_im = p.in[6]; const float* c_re = p.in[7]; const float* c_im = p.in[8];
    bf16_t* TmE = (bf16_t*)(p.ws + WS_TME) + (size_t)g * 256 * KA;
    bf16_t* Ft = (bf16_t*)(p.ws + WS_FT) + (size_t)g * 256 * 256;
    if (tid < 64) {
        const int n = tid; const float dt = expf(log_dt[g]); const float lre = fminf(a_re[g * 64 + n], -1e-4f), lim = a_im[g * 64 + n];
        const f32x2 ab = cpow_k(lre, lim, dt, 1);
        const float den = lre * lre + lim * lim, nre = ab.x - 1.0f;
        coef[2 * n] = (nre * lre + ab.y * lim) / den; coef[2 * n + 1] = (ab.y * lre - nre * lim) / den;
        const f32x2 q = cpow_k(lre, lim, dt, d), q1 = cpow_k(lre, lim, dt, d + 1);
        pd[2 * n] = q.x; pd[2 * n + 1] = q.y; pd1[2 * n] = q1.x; pd1[2 * n + 1] = q1.y;
        if (d == 0) { const f32x2 q16 = cpow_k(lre, lim, dt, 16); *(f32x2*)((float*)(p.ws + WS_A16) + (size_t)(g * 64 + n) * 2) = q16; }
    }
    __syncthreads();
    for (int idx = tid; idx < 1024; idx += NTHR) {
        const int n = idx >> 4;
        const float br = b_re[(size_t)g * 1024 + idx], bi = b_im[(size_t)g * 1024 + idx], cr = coef[2 * n], ci = coef[2 * n + 1];
        const float bbr = cr * br - ci * bi, bbi = cr * bi + ci * br, pr = pd[2 * n], pi = pd[2 * n + 1];
        wre[idx] = pr * bbr - pi * bbi; wim[idx] = pr * bbi + pi * bbr;
        cre[idx] = c_re[(size_t)g * 1024 + idx]; cim[idx] = c_im[(size_t)g * 1024 + idx];
    }
    __syncthreads();
    if (tid < 256) {
        const int h = tid >> 4, h2 = tid & 15; float s = 0.f;
#pragma unroll 8
        for (int n = 0; n < 64; ++n) s += cre[h * 64 + n] * wre[n * 16 + h2] - cim[h * 64 + n] * wim[n * 16 + h2];
        const bf16_t kb = (bf16_t)(cvt_pk_bf16(s, 0.f) & 0xffffu);
        for (int t = d; t < 16; ++t) TmE[(size_t)(t * 16 + h) * KA + (t - d) * 16 + h2] = kb;
        if (d > 0) for (int t = 0; t < 16 - d; ++t) TmE[(size_t)(t * 16 + h) * KA + (t + d) * 16 + h2] = 0;
    } else {
        const int q = tid - 256;
#pragma unroll
        for (int r = 0; r < 4; ++r) {
            const int idx = q + 256 * r;
            { const int h = idx >> 6, n = idx & 63; const float pr = pd1[2 * n], pi = pd1[2 * n + 1], cr = cre[h * 64 + n], ci = cim[h * 64 + n];
              const unsigned w = cvt_pk_bf16(cr * pr - ci * pi, -(cr * pi + ci * pr));
              bf16_t* rowp = TmE + (size_t)(d * 16 + h) * KA + 256; rowp[n] = (bf16_t)(w & 0xffffu); rowp[64 + n] = (bf16_t)(w >> 16); }
            { const int n = idx >> 4, h2 = idx & 15, col = (15 - d) * 16 + h2; const unsigned w = cvt_pk_bf16(wre[idx], wim[idx]);
              Ft[(size_t)n * 256 + col] = (bf16_t)(w & 0xffffu); Ft[(size_t)(64 + n) * 256 + col] = (bf16_t)(w >> 16);
              Ft[(size_t)(128 + n) * 256 + col] = 0; Ft[(size_t)(192 + n) * 256 + col] = 0; }
        }
    }
    __syncthreads();
}

__device__ __forceinline__ void sgu_unit(const Params& p, LAS unsigned char* lds, int unit, int tid) {
    constexpr int LDT = 136;
    LAS bf16_t* At = (LAS bf16_t*)lds;
    LAS bf16_t* Bt = (LAS bf16_t*)(lds + 128 * LDT * 2);
    LAS float* rvs = (LAS float*)(lds + 2 * 128 * LDT * 2);
    const int h = unit & 7, bnb = unit >> 3, tok0 = bnb * 128;
    const float* PV = (const float*)(p.ws + WS_PV); const bf16_t* VB = (const bf16_t*)(p.ws + WS_VB); const bf16_t* UB = (const bf16_t*)(p.ws + WS_UB);
    bf16_t* Y = (bf16_t*)(p.ws + WS_Y); float* PB = (float*)(p.ws + WS_PB);
    const float* vgain = p.in[10]; const float* sw = p.in[11] + (size_t)h * 128 * 128; const float* sb = p.in[12] + h * 128;
    if (tid < 128) { const f32x4* pp = (const f32x4*)(PV + (size_t)(tok0 + tid) * 16); const f32x4 a = pp[0], b = pp[1], c = pp[2], d = pp[3];
        const float s = ((a[0] + a[1]) + (a[2] + a[3])) + ((b[0] + b[1]) + (b[2] + b[3])) + ((c[0] + c[1]) + (c[2] + c[3])) + ((d[0] + d[1]) + (d[2] + d[3]));
        rvs[tid] = 1.0f / sqrtf(s * (1.0f / 1024.0f) + EPS); }
    __syncthreads();
#pragma unroll
    for (int q = 0; q < 4; ++q) {
        const int pc = tid + NTHR * q, r = pc >> 4, c0 = (pc & 15) * 8;
        {
            const bool on = (c0 >> 6) <= (r >> 6);
            const f32x4 w0 = *(const f32x4*)(sw + r * 128 + c0), w1 = *(const f32x4*)(sw + r * 128 + c0 + 4);
            const f32x4 r0 = *(const LAS f32x4*)(rvs + c0), r1 = *(const LAS f32x4*)(rvs + c0 + 4);
            u32x4 o;
            if (on) { o.x = cvt_pk_bf16(w0[0] * r0[0], w0[1] * r0[1]); o.y = cvt_pk_bf16(w0[2] * r0[2], w0[3] * r0[3]); o.z = cvt_pk_bf16(w1[0] * r1[0], w1[1] * r1[1]); o.w = cvt_pk_bf16(w1[2] * r1[2], w1[3] * r1[3]); }
            else { o = (u32x4){0u, 0u, 0u, 0u}; }
            *(LAS u32x4*)(At + r * LDT + c0) = o;
        }
        {
            const u32x4 vv = *(const u32x4*)(VB + (size_t)(tok0 + r) * 1024 + h * 128 + c0);
            Bt[(c0 + 0) * LDT + r] = (bf16_t)(vv.x & 0xffffu); Bt[(c0 + 1) * LDT + r] = (bf16_t)(vv.x >> 16);
            Bt[(c0 + 2) * LDT + r] = (bf16_t)(vv.y & 0xffffu); Bt[(c0 + 3) * LDT + r] = (bf16_t)(vv.y >> 16);
            Bt[(c0 + 4) * LDT + r] = (bf16_t)(vv.z & 0xffffu); Bt[(c0 + 5) * LDT + r] = (bf16_t)(vv.z >> 16);
            Bt[(c0 + 6) * LDT + r] = (bf16_t)(vv.w & 0xffffu); Bt[(c0 + 7) * LDT + r] = (bf16_t)(vv.w >> 16);
        }
    }
    __syncthreads();
    const int w = tid >> 6, lane = tid & 63, fr = lane & 15, fq = lane >> 4;
    bf16x8 wf[4];
#pragma unroll
    for (int ks = 0; ks < 4; ++ks) wf[ks] = *(const LAS bf16x8*)(At + (16 * w + fr) * LDT + ks * 32 + fq * 8);
    const int i = 16 * w + fr; const size_t tok = (size_t)(tok0 + i); const float bsi = sb[i]; float ss = 0.f;
#pragma unroll
    for (int ct = 0; ct < 8; ++ct) {
        f32x4 acc = (f32x4){0.f, 0.f, 0.f, 0.f};
#pragma unroll
        for (int ks = 0; ks < 4; ++ks) { const bf16x8 vf = *(const LAS bf16x8*)(Bt + (16 * ct + fr) * LDT + ks * 32 + fq * 8); acc = __builtin_amdgcn_mfma_f32_16x16x32_bf16(vf, wf[ks], acc, 0, 0, 0); }
        const int c = 16 * ct + 4 * fq;
        const u32x2 uu = *(const u32x2*)(UB + tok * 1024 + h * 128 + c); const f32x4 vg = *(const f32x4*)(vgain + h * 128 + c);
        const float o0 = bf_lo(uu.x) * (vg[0] * acc[0] + bsi), o1 = bf_hi(uu.x) * (vg[1] * acc[1] + bsi), o2 = bf_lo(uu.y) * (vg[2] * acc[2] + bsi), o3 = bf_hi(uu.y) * (vg[3] * acc[3] + bsi);
        ss += (o0 * o0 + o1 * o1) + (o2 * o2 + o3 * o3);
        u32x2 wv; wv.x = cvt_pk_bf16(o0, o1); wv.y = cvt_pk_bf16(o2, o3);
        *(u32x2*)(Y + tok * DM + DSSM + h * 128 + c) = wv;
    }
    ss += __shfl_xor(ss, 16); ss += __shfl_xor(ss, 32);
    if (fq == 0) PB[tok * 8 + h] = ss;
    __syncthreads();
}

__device__ __forceinline__ void carry_task(const Params& p, int g, int tid) {
    const int b = tid >> 6, n = tid & 63;
    const float* S = (const float*)(p.ws + WS_S); bf16_t* Ap = (bf16_t*)(p.ws + WS_AP);
    const f32x2 a16 = *(const f32x2*)((const float*)(p.ws + WS_A16) + (size_t)(g * 64 + n) * 2);
    float hr = 0.f, hi = 0.f; const size_t row0 = (size_t)g * 1024 + b * 128;
#pragma unroll 8
    for (int c = 0; c < NCH; ++c) {
        const size_t row = row0 + c; const float sr = S[row * 128 + n], si = S[row * 128 + 64 + n];
        const unsigned w = cvt_pk_bf16(hr, hi);
        Ap[row * KA + 256 + n] = (bf16_t)(w & 0xffffu); Ap[row * KA + 320 + n] = (bf16_t)(w >> 16);
        const float nr = a16.x * hr - a16.y * hi + sr, ni = a16.x * hi + a16.y * hr + si; hr = nr; hi = ni;
    }
}

__global__ void __launch_bounds__(NTHR, 2) fwd_megakernel(Params p) {
    extern __shared__ __attribute__((aligned(16))) unsigned char lds_raw[];
    LAS unsigned char* lds = (LAS unsigned char*)lds_raw;
    cg::grid_group grid = cg::this_grid();
    const int tid = threadIdx.x, lane = tid & 63, wave = __builtin_amdgcn_readfirstlane(tid >> 6);
    const int G = gridDim.x, bx = blockIdx.x;
    const int lo = p.ph_lo, hi = p.ph_hi;
    unsigned char* ws = p.ws;
#ifndef PH_MASK
#define PH_MASK 0x7f
#endif
#define IN(k) (((PH_MASK >> (k)) & 1) && lo <= (k) && (k) < hi)
    volatile LAS unsigned* MISC = (volatile LAS unsigned*)(lds + MISC_OFF);
    if (tid < 64) MISC[tid] = 0u;
    __syncthreads();
    XcdBarrier xbar = xcd_barrier_post((unsigned*)ws, MISC);
#define SEAM(k) do { if (IN(k) && IN((k) + 1)) xcd_barrier(xbar); } while (0)
    if (lo == 0 && hi > 1) grid.sync();

    if (IN(0)) {
        for (int t = bx; t < NG * 16; t += G) p0_ssm_task(p, lds, t >> 4, t & 15, tid);
        LAS float* scr = (LAS float*)(lds + wave * 16384);
        const int gw = bx * NWAVES + wave, NGW = G * NWAVES;
        constexpr int I_IN = (DM / 64) * (DIN / 32), I_OUT = (DM / 64) * (DM / 32), I_1 = (DM / 64) * (DFF / 32), I_2 = (DFF / 64) * (DM / 32);
        for (int it = gw; it < I_IN + I_OUT + I_1 + I_2; it += NGW) {
            int r = it;
            if (r < I_IN) { p0_transpose_item(p.in[1], DM, DIN, (bf16_t*)(ws + WS_WIN), nullptr, nullptr, scr, r, lane); continue; } r -= I_IN;
            if (r < I_OUT) { p0_transpose_item(p.in[15], DM, DM, (bf16_t*)(ws + WS_WOUT), p.in[13], p.in[14], scr, r, lane); continue; } r -= I_OUT;
            if (r < I_1) { p0_transpose_item(p.in[18], DM, DFF, (bf16_t*)(ws + WS_W1), p.in[17], nullptr, scr, r, lane); continue; } r -= I_1;
            p0_transpose_item(p.in[19], DFF, DM, (bf16_t*)(ws + WS_W2), nullptr, nullptr, scr, r, lane);
        }
        const float* x = p.in[0]; const float* mg = p.in[16]; bf16_t* XN = (bf16_t*)(ws + WS_XN);
        for (int m = gw; m < M; m += NGW) {
            const f32x4* xr = (const f32x4*)(x + (size_t)m * DM) + lane; f32x4 v[8]; float s = 0.f;
#pragma unroll
            for (int j = 0; j < 8; ++j) { v[j] = xr[64 * j]; s += (v[j][0] * v[j][0] + v[j][1] * v[j][1]) + (v[j][2] * v[j][2] + v[j][3] * v[j][3]); }
            const float r = 1.0f / sqrtf(wave_sum(s) * (1.0f / DM) + EPS);
            u32x2* o = (u32x2*)(XN + (size_t)m * DM) + lane;
#pragma unroll
            for (int j = 0; j < 8; ++j) { const f32x4 gg = *((const f32x4*)mg + 64 * j + lane); u32x2 w; w.x = cvt_pk_bf16(v[j][0] * r * gg[0], v[j][1] * r * gg[1]); w.y = cvt_pk_bf16(v[j][2] * r * gg[2], v[j][3] * r * gg[3]); o[64 * j] = w; }
        }
    }
    SEAM(0);
    if (IN(1)) {
        pg8::Gemm g{(const bf16_t*)(ws + WS_XN), (const bf16_t*)(ws + WS_WIN), DM, DM, DM}; pg8::StaticOrder S; S.init(M, DIN, G, bx);
        EpiProj E{(bf16_t*)(ws + WS_AP), (bf16_t*)(ws + WS_SG), (bf16_t*)(ws + WS_UB), (bf16_t*)(ws + WS_VB), (float*)(ws + WS_PV)};
        pg8::gemm_phase<EpiProj, pg8::StaticOrder, true>(lds, g, S, E);
    }
    SEAM(1);
    if (IN(2)) {
        pg8::GroupOrder GO; GO.init(G, bx);
        for (int i = 0;; ++i) {
            Unit u; if (!GO.next(i, u)) break;
            pg8::OneUnit S1{u.pm, u.pn};
            { pg8::Gemm g{(const bf16_t*)(ws + WS_AP), (const bf16_t*)(ws + WS_FT), KA, 256, 256}; EpiS E{};
              pg8::gemm_phase<EpiS, pg8::OneUnit, false>(lds, g, S1, E); }
            __syncthreads();
            if (tid < 128) {
                const int b2 = tid >> 6, n = tid & 63; const LAS float* S = (const LAS float*)lds + (b2 * 128) * 132 + n;
                bf16_t* hp = (bf16_t*)(ws + WS_AP) + ((size_t)u.pm * 256 + b2 * 128) * KA + 256 + n;
                const f32x2 a16 = *(const f32x2*)((const float*)(ws + WS_A16) + (size_t)(u.pn * 64 + n) * 2);
                float hr = 0.f, hi = 0.f;
#pragma unroll 8
                for (int c = 0; c < NCH; ++c) {
                    const float sr = S[c * 132], si = S[c * 132 + 64];
                    const unsigned w = cvt_pk_bf16(hr, hi);
                    hp[(size_t)c * KA] = (bf16_t)(w & 0xffffu); hp[(size_t)c * KA + 64] = (bf16_t)(w >> 16);
                    const float nr = a16.x * hr - a16.y * hi + sr, ni = a16.x * hi + a16.y * hr + si; hr = nr; hi = ni;
                }
            }
            asm volatile("s_waitcnt vmcnt(0)" ::: "memory");
            __syncthreads();
            { pg8::Gemm g{(const bf16_t*)(ws + WS_AP), (const bf16_t*)(ws + WS_TME), KA, KA, KA};
              EpiSsm E{(const bf16_t*)(ws + WS_AP), (const bf16_t*)(ws + WS_SG), p.in[9], (bf16_t*)(ws + WS_Y), (float*)(ws + WS_PA)};
              pg8::gemm_phase<EpiSsm, pg8::OneUnit, true>(lds, g, S1, E); }
        }
        for (int uu = bx; uu < 1024; uu += G) sgu_unit(p, lds, uu, tid);
    }
    SEAM(2);
    if (IN(3)) {
        pg8::StaticOrder S; S.init(M, DM, G, bx);
        LAS f32x2* tab = (LAS f32x2*)(lds + TAB_OFF);
        const float* PA = (const float*)(ws + WS_PA); const float* PB = (const float*)(ws + WS_PB);
        for (int idx = tid; idx < TAB_BYTES / 8; idx += NTHR) {
            Unit u; if (!S.next(idx >> 8, u)) break;
            const int row = u.pm * 256 + (idx & 255); const f32x4* pa = (const f32x4*)(PA + (size_t)row * 64); float sa = 0.f;
#pragma unroll
            for (int j = 0; j < 16; ++j) { const f32x4 v = pa[j]; sa += (v[0] + v[1]) + (v[2] + v[3]); }
            const f32x4* pb = (const f32x4*)(PB + (size_t)row * 8); const f32x4 b0 = pb[0], b1 = pb[1]; const float sbb = ((b0[0] + b0[1]) + (b0[2] + b0[3])) + ((b1[0] + b1[1]) + (b1[2] + b1[3]));
            const float ra = 1.0f / sqrtf(sa * (1.0f / 1024.0f) + EPS), rb = 1.0f / sqrtf(sbb * (1.0f / 1024.0f) + EPS);
            tab[idx] = (f32x2){ra / rb, rb};
        }
        __syncthreads();
        pg8::Gemm g{(const bf16_t*)(ws + WS_Y), (const bf16_t*)(ws + WS_WOUT), DM, DM, DM};
        EpiOut E{p.in[0], (bf16_t*)(ws + WS_H1B), (float*)(ws + WS_P2), tab};
        pg8::gemm_phase<EpiOut, pg8::StaticOrder, true>(lds, g, S, E);
    }
    SEAM(3);
    if (IN(4)) {
        pg8::StaticOrder S; S.init(M, DFF, G, bx);
        LAS float* tab = (LAS float*)(lds + TAB_OFF);
        const float* P2 = (const float*)(ws + WS_P2);
        for (int idx = tid; idx < TAB_BYTES / 4; idx += NTHR) {
            Unit u; if (!S.next(idx >> 8, u)) break;
            const int row = u.pm * 256 + (idx & 255); const f32x4* pp = (const f32x4*)(P2 + (size_t)row * 32); float s = 0.f;
#pragma unroll
            for (int j = 0; j < 8; ++j) { const f32x4 v = pp[j]; s += (v[0] + v[1]) + (v[2] + v[3]); }
            tab[idx] = 1.0f / sqrtf(s * (1.0f / DM) + EPS);
        }
        __syncthreads();
        pg8::Gemm g{(const bf16_t*)(ws + WS_H1B), (const bf16_t*)(ws + WS_W1), DM, DM, DM};
        EpiFF1 E{(bf16_t*)(ws + WS_HID), tab};
        pg8::gemm_phase<EpiFF1, pg8::StaticOrder, true>(lds, g, S, E);
    }
    SEAM(4);
    const bool fused_norm = (G == 256);
    if (IN(5)) {
        pg8::Gemm g{(const bf16_t*)(ws + WS_HID), (const bf16_t*)(ws + WS_W2), DFF, DFF, DFF};
        if (fused_norm) {
            PanelOrder S{bx};
            EpiFF2N E{(const bf16_t*)(ws + WS_H1B), p.out, p.in[20], (float*)(ws + WS_P3), (unsigned*)ws + 4096};
            pg8::gemm_phase<EpiFF2N, PanelOrder, true>(lds, g, S, E);
        } else {
            pg8::StaticOrder S; S.init(M, DM, G, bx);
            EpiFF2 E{(bf16_t*)(ws + WS_H1B), (float*)(ws + WS_P3)};
            pg8::gemm_phase<EpiFF2, pg8::StaticOrder, true>(lds, g, S, E);
        }
    }
    if (!fused_norm) SEAM(5);
    if (IN(6) && !fused_norm) {
        const int gw = bx * NWAVES + wave, NGW = G * NWAVES; const float* P3 = (const float*)(ws + WS_P3); const float* fg = p.in[20]; const bf16_t* H2 = (const bf16_t*)(ws + WS_H1B);
        for (int m = gw; m < M; m += NGW) {
            const float ps = (lane < 32) ? P3[(size_t)m * 32 + lane] : 0.f;
            const u32x4* hr = (const u32x4*)(H2 + (size_t)m * DM) + lane; u32x4 hv[4];
#pragma unroll
            for (int j = 0; j < 4; ++j) hv[j] = hr[64 * j];
            const float r = 1.0f / sqrtf(wave_sum(ps) * (1.0f / DM) + EPS);
            f32x4* orow = (f32x4*)(p.out + (size_t)m * DM) + 2 * lane;
#pragma unroll
            for (int j = 0; j < 4; ++j) { const f32x4 g0 = *((const f32x4*)fg + 128 * j + 2 * lane), g1 = *((const f32x4*)fg + 128 * j + 2 * lane + 1);
                f32x4 o0 = {bf_lo(hv[j].x), bf_hi(hv[j].x), bf_lo(hv[j].y), bf_hi(hv[j].y)}, o1 = {bf_lo(hv[j].z), bf_hi(hv[j].z), bf_lo(hv[j].w), bf_hi(hv[j].w)};
                orow[128 * j] = o0 * r * g0; orow[128 * j + 1] = o1 * r * g1; }
        }
    }
#ifdef DBG_STOP
    grid.sync();
    {
        const size_t NT = (size_t)M * DM; const size_t gt = (size_t)bx * NTHR + tid, gs = (size_t)G * NTHR;
        const bf16_t* XN = (const bf16_t*)(ws + WS_XN); const bf16_t* WINp = (const bf16_t*)(ws + WS_WIN); const bf16_t* WOUTp = (const bf16_t*)(ws + WS_WOUT);
        const bf16_t* W1p = (const bf16_t*)(ws + WS_W1); const bf16_t* W2p = (const bf16_t*)(ws + WS_W2); const bf16_t* TMEp = (const bf16_t*)(ws + WS_TME); const bf16_t* FTp = (const bf16_t*)(ws + WS_FT);
        const bf16_t* SGp = (const bf16_t*)(ws + WS_SG); const bf16_t* UBp = (const bf16_t*)(ws + WS_UB); const bf16_t* VBp = (const bf16_t*)(ws + WS_VB); const bf16_t* APp = (const bf16_t*)(ws + WS_AP);
        const bf16_t* Yp = (const bf16_t*)(ws + WS_Y); const bf16_t* H1Bp = (const bf16_t*)(ws + WS_H1B); const bf16_t* HIDp = (const bf16_t*)(ws + WS_HID);
        const float* Sp = (const float*)(ws + WS_S); const float* PVp = (const float*)(ws + WS_PV); const float* PAp = (const float*)(ws + WS_PA); const float* PBp = (const float*)(ws + WS_PB);
        const float* P2p = (const float*)(ws + WS_P2); const float* P3p = (const float*)(ws + WS_P3);
#define BFV(p, i) __uint_as_float(((unsigned)(p)[(i)]) << 16)
        for (size_t i = gt; i < NT; i += gs) {
            float v = 0.f;
            if (DBG_STOP == 0) v = BFV(XN, i) + BFV(WINp, i % (size_t)(DIN * DM)) + BFV(WOUTp, i % (size_t)(DM * DM)) + BFV(W1p, i % (size_t)(DFF * DM)) + BFV(W2p, i % (size_t)(DFF * DM)) + BFV(TMEp, i % (size_t)(64 * 256 * KA)) + BFV(FTp, i % (size_t)(64 * 256 * 256));
            if (DBG_STOP == 1) { const size_t e = i % (size_t)(65536 * 256); v = BFV(SGp, i % (size_t)(M * 1024)) + 0.f * (float)(e & 1); }
            if (DBG_STOP == 2) v = Sp[i % (size_t)(65536 * 128)];
            if (DBG_STOP == 3) { const size_t e = i % (size_t)(65536 * 128), y = i % (size_t)(M * 1024); v = BFV(APp, (e >> 7) * KA + 256 + (e & 127)) + BFV(Yp, (y >> 10) * DM + 1024 + (y & 1023)) + PBp[i % (size_t)(M * 8)]; }
            if (DBG_STOP == 4) { const size_t y = i % (size_t)(M * 1024); v = BFV(Yp, (y >> 10) * DM + (y & 1023)) + PAp[i % (size_t)(M * 64)]; }
            if (DBG_STOP == 5) v = p.out[i] + BFV(H1Bp, i) + P2p[i % (size_t)(M * 32)];
            if (DBG_STOP == 6) v = BFV(HIDp, i) + BFV(HIDp, i + NT) + BFV(HIDp, i + 2 * NT) + BFV(HIDp, i + 3 * NT);
            if (DBG_STOP == 7) v = p.out[i] + P3p[i % (size_t)(M * 32)];
            p.out[i] = v;
        }
    }
#endif
#undef IN
#undef SEAM
}

extern "C" void kernel_launch(void* const* d_in, const int* in_sizes, int n_in, void* d_out, int out_size, void* d_ws, size_t ws_size, hipStream_t stream) {
    static int grid = 0;
    if (grid == 0) {
        if (n_in != 21 || out_size != M * DM || ws_size < WS_END) { fprintf(stderr, "kernel_launch: unexpected shapes (n_in %d, out %d, ws %zu)\n", n_in, out_size, ws_size); grid = -1; return; }
        int dev = 0, cus = 0, per_cu = 0;
        hipGetDevice(&dev); hipDeviceGetAttribute(&cus, hipDeviceAttributeMultiprocessorCount, dev);
        if (hipFuncSetAttribute((const void*)fwd_megakernel, hipFuncAttributeMaxDynamicSharedMemorySize, LDS_BYTES) != hipSuccess) { fprintf(stderr, "kernel_launch: hipFuncSetAttribute failed\n"); grid = -1; return; }
        if (hipOccupancyMaxActiveBlocksPerMultiprocessor(&per_cu, (const void*)fwd_megakernel, NTHR, LDS_BYTES) != hipSuccess || per_cu < 1) { fprintf(stderr, "kernel_launch: occupancy query failed (%d)\n", per_cu); (void)hipGetLastError(); per_cu = 1; }
        grid = cus * per_cu;
        if (grid > 256) grid = 256;
    }
    if (grid < 0) return;
#ifdef DIAG_POISON_WS
    (void)hipMemsetAsync((unsigned char*)d_ws, 0xAA, WS_END, stream);
#endif
    Params p{};
    for (int i = 0; i < 21; ++i) p.in[i] = (const float*)d_in[i];
    p.out = (float*)d_out; p.ws = (unsigned char*)d_ws;
#if MK_MULTI
    for (int ph = 0; ph < 7; ++ph) { p.ph_lo = ph; p.ph_hi = ph + 1; hipLaunchKernelGGL(fwd_megakernel, dim3(grid), dim3(NTHR), LDS_BYTES, stream, p); }
#else
#ifdef DBG_STOP
    p.ph_lo = 0; p.ph_hi = DBG_STOP + 1;
#else
    p.ph_lo = 0; p.ph_hi = 7;
#endif
    (void)hipMemsetAsync(d_ws, 0, 32768, stream);
    void* args[] = {&p};
    hipError_t e = hipLaunchCooperativeKernel((const void*)fwd_megakernel, dim3(grid), dim3(NTHR), args, LDS_BYTES, stream);
    if (e != hipSuccess) fprintf(stderr, "cooperative launch failed: %s (grid %d)\n", hipGetErrorString(e), grid);
#endif
}
```

```cpp
#include <hip/hip_runtime.h>
#include <hip/hip_cooperative_groups.h>
#include <cstdio>
#include <cstdint>
namespace cg = cooperative_groups;

#ifndef MK_MULTI
#define MK_MULTI 0
#endif

#define LAS __attribute__((address_space(3)))
typedef unsigned short bf16_t;
typedef short bf16x8 __attribute__((ext_vector_type(8)));
typedef float f32x4 __attribute__((ext_vector_type(4)));
typedef float f32x2 __attribute__((ext_vector_type(2)));
typedef unsigned u32x4 __attribute__((ext_vector_type(4)));
typedef unsigned u32x2 __attribute__((ext_vector_type(2)));

typedef __bf16 bf16x2_t __attribute__((ext_vector_type(2)));
__device__ __forceinline__ unsigned cvt_pk_bf16(float lo, float hi) { const f32x2 v = {lo, hi}; const bf16x2_t b = __builtin_convertvector(v, bf16x2_t); return __builtin_bit_cast(unsigned, b); }
__device__ __forceinline__ float bf_lo(unsigned w) { return __uint_as_float(w << 16); }
__device__ __forceinline__ float bf_hi(unsigned w) { return __uint_as_float(w & 0xffff0000u); }
__device__ __forceinline__ float gelu_tanh(float x) {
    const float t = x * (1.0f + 0.044715f * x * x);
    const float e = __builtin_amdgcn_exp2f(-2.3022081984f * t);
    return x * __builtin_amdgcn_rcpf(1.0f + e);
}
__device__ __forceinline__ float sigmoid_f(float x) { return __builtin_amdgcn_rcpf(1.0f + __builtin_amdgcn_exp2f(-1.4426950409f * x)); }

namespace pg8 {
constexpr int BM = 256, BK = 64, HALF = 128, HTB = HALF * BK * 2, STAGE_BYTES = 8 * HTB, NXCD = 8, WGM = 8;
__host__ __device__ __forceinline__ int lds_byte(int r, int c) { const int st = (r >> 4) * 2 + (c >> 5), rr = r & 15, cc = c & 31, ob = rr * 64 + cc * 2; return st * 1024 + (ob ^ (((ob >> 9) & 1) << 5)); }
__host__ __device__ __forceinline__ void stage_rc(int b, int& R, int& C) { const int st = b / 1024, sb = b % 1024, swz = sb ^ (((sb >> 9) & 1) << 5); R = (st >> 1) * 16 + swz / 64; C = (st & 1) * 32 + (swz % 64) / 2; }
__host__ __device__ __forceinline__ int perm32(int rho) { const int n = rho >> 4, i = rho & 15; return 8 * (i >> 2) + 4 * n + (i & 3); }

struct Unit { int pm, pn; };
struct Gemm { const bf16_t* A; const bf16_t* Bt; int lda, ldb, K; };

struct StaticOrder {
    int nM, nN, nwg, G, c;
    __device__ void init(int M, int N, int G_, int c_) { nM = M / BM; nN = N / BM; nwg = nM * nN; G = G_; c = c_; }
    __device__ bool next(int i, Unit& u) const {
        const long L = (long)i * G + c; if (L >= nwg) return false;
        int wgid = (int)L; { const int q = nwg / NXCD, r = nwg % NXCD, xcd = wgid % NXCD, off = wgid / NXCD; wgid = (xcd < r ? xcd * (q + 1) : r * (q + 1) + (xcd - r) * q) + off; }
        const int nig = WGM * nN, gid = wgid / nig, fm = gid * WGM, gsz = (nM - fm) < WGM ? (nM - fm) : WGM;
        u.pm = fm + ((wgid % nig) % gsz); u.pn = (wgid % nig) / gsz; return true;
    }
};
struct GroupOrder {
    int G, c;
    __device__ void init(int G_, int c_) { G = G_; c = c_; }
    __device__ bool next(int i, Unit& u) const {
        const int L = i * G + c; if (L >= 256) return false;
        const int Lr = (L & 7) * 32 + (L >> 3); u.pm = Lr; u.pn = Lr >> 2; return true;
    }
};

struct OneUnit { int pm, pn; __device__ bool next(int i, Unit& u) const { if (i != 0) return false; u.pm = pm; u.pn = pn; return true; } };

template <class Epi, class Sched, bool ALIGN_EPI>
__device__ __forceinline__ void gemm_phase(LAS unsigned char* lds, const Gemm g, const Sched& S, const Epi& E) {
    const int tid = threadIdx.x, wid = __builtin_amdgcn_readfirstlane(tid >> 6), lane = tid & 63, wr = wid >> 2, wc = wid & 3, fr = lane & 15, fq = lane >> 4;
    int nt = g.K / BK; asm volatile("" : "+s"(nt));
    unsigned voffA[2], voffB[2];
#pragma unroll
    for (int i = 0; i < 2; ++i) { int R, C; stage_rc(tid * 16 + i * 8192, R, C); const int Rb = Epi::PERM ? ((R & ~31) + perm32(R & 31)) : R;
        voffA[i] = (unsigned)(R * g.lda + C) * 2u; voffB[i] = (unsigned)(Rb * g.ldb + C) * 2u; }
    const size_t kstep = (size_t)(BK * 2);
    const size_t hstepA = (size_t)HALF * g.lda * 2, hstepB = (size_t)HALF * g.ldb * 2;
    const size_t tstepA = 2 * hstepA, tstepB = 2 * hstepB;
    const unsigned ldsw = (unsigned)wid * 1024u;
    const int aoff = lds_byte(wr * 64 + fr, fq * 8), boff = lds_byte(wc * 32 + fr, fq * 8);
#define PG8_SA(b, h) (((b) * 2 + (h)) * HTB)
#define PG8_SB(b, h) ((4 + (b) * 2 + (h)) * HTB)
#define PG8_STAGE(bufoff, gbase, voff) do { _Pragma("unroll") for (int _i = 0; _i < 2; ++_i) \
        __builtin_amdgcn_global_load_lds((const unsigned*)((const char*)(gbase) + (voff)[_i]), (LAS unsigned*)(lds + (bufoff) + ldsw + _i * 8192), 16, 0, 0); } while (0)
#define PG8_LDA(dst, b, h) do { _Pragma("unroll") for (int m = 0; m < 4; ++m) _Pragma("unroll") for (int k = 0; k < 2; ++k) dst[m][k] = *(const LAS bf16x8*)(lds + PG8_SA(b, h) + aoff + m * 2048 + k * 1024); } while (0)
#define PG8_LDB(dst, b, h) do { _Pragma("unroll") for (int n = 0; n < 2; ++n) _Pragma("unroll") for (int k = 0; k < 2; ++k) dst[n][k] = *(const LAS bf16x8*)(lds + PG8_SB(b, h) + boff + n * 2048 + k * 1024); } while (0)
#define PG8_MMA(ai, bj, At, Bt) do { __builtin_amdgcn_s_setprio(1); _Pragma("unroll") for (int m = 0; m < 4; ++m) _Pragma("unroll") for (int n = 0; n < 2; ++n) _Pragma("unroll") for (int k = 0; k < 2; ++k) \
        acc[ai][bj][m][n] = __builtin_amdgcn_mfma_f32_16x16x32_bf16(Bt[n][k], At[m][k], acc[ai][bj][m][n], 0, 0, 0); __builtin_amdgcn_s_setprio(0); } while (0)
#define PG8_WAIT_V(n) asm volatile("s_waitcnt vmcnt(" #n ")" ::: "memory")
#define PG8_WAIT_L(n) asm volatile("s_waitcnt lgkmcnt(" #n ")" ::: "memory")
#define PG8_BAR __builtin_amdgcn_s_barrier()
#define PG8_SCHED __builtin_amdgcn_sched_barrier(0)
    Unit cur, nxt; int ui = 0;
    if (!S.next(0, cur)) return;
    f32x4 acc[2][2][4][2];
#pragma unroll
    for (int a = 0; a < 2; ++a)
#pragma unroll
        for (int b = 0; b < 2; ++b)
#pragma unroll
            for (int m = 0; m < 4; ++m)
#pragma unroll
                for (int n = 0; n < 2; ++n) acc[a][b][m][n] = (f32x4){0.f, 0.f, 0.f, 0.f};
    bf16x8 At[4][2], B0[2][2], B1[2][2];
    const char* cA = (const char*)g.A + (size_t)cur.pm * tstepA; const char* cB = (const char*)g.Bt + (size_t)cur.pn * tstepB;
    PG8_STAGE(PG8_SB(0, 0), cB, voffB); PG8_STAGE(PG8_SB(0, 1), cB + hstepB, voffB); PG8_STAGE(PG8_SA(0, 0), cA, voffA); PG8_STAGE(PG8_SA(0, 1), cA + hstepA, voffA);
    if (wr == 1) PG8_BAR;
    PG8_WAIT_V(2); PG8_BAR;
    PG8_STAGE(PG8_SB(1, 0), cB + kstep, voffB); PG8_STAGE(PG8_SA(1, 0), cA + kstep, voffA); PG8_STAGE(PG8_SB(1, 1), cB + hstepB + kstep, voffB);
    PG8_WAIT_V(6); PG8_BAR;
    for (;;) {
        const bool has_next = S.next(ui + 1, nxt);
        const char* nA = has_next ? (const char*)g.A + (size_t)nxt.pm * tstepA : cA; const char* nB = has_next ? (const char*)g.Bt + (size_t)nxt.pn * tstepB : cB;
#pragma nounroll
        for (int t = 0; t < nt; t += 2) {
            const bool last = (t == nt - 2);
            const char* a1 = cA + (size_t)(t + 1) * kstep;
            const char* a2 = last ? nA : cA + (size_t)(t + 2) * kstep; const char* b2 = last ? nB : cB + (size_t)(t + 2) * kstep;
            const char* a3 = a2 + kstep; const char* b3 = b2 + kstep;
            if constexpr (Epi::HAS_MID) { if (t == (nt >> 1)) E.mid(acc, ui, wr, fr); }
            PG8_LDB(B0, 0, 0); PG8_LDB(B1, 0, 1); PG8_SCHED; PG8_LDA(At, 0, 0); PG8_STAGE(PG8_SA(1, 1), a1 + hstepA, voffA);
            PG8_WAIT_V(8); PG8_WAIT_L(0); PG8_BAR; PG8_MMA(0, 0, At, B0); PG8_MMA(0, 1, At, B1); PG8_BAR; PG8_SCHED;
            PG8_LDA(At, 0, 1); PG8_STAGE(PG8_SB(0, 0), b2, voffB); PG8_STAGE(PG8_SB(0, 1), b2 + hstepB, voffB); PG8_STAGE(PG8_SA(0, 0), a2, voffA);
            PG8_WAIT_V(8); PG8_WAIT_L(0); PG8_BAR; PG8_MMA(1, 0, At, B0); PG8_MMA(1, 1, At, B1); PG8_BAR; PG8_SCHED;
            PG8_LDB(B0, 1, 0); PG8_LDB(B1, 1, 1); PG8_SCHED; PG8_LDA(At, 1, 0); PG8_STAGE(PG8_SA(0, 1), a2 + hstepA, voffA);
            PG8_WAIT_V(8); PG8_WAIT_L(0); PG8_BAR; PG8_MMA(0, 0, At, B0); PG8_MMA(0, 1, At, B1); PG8_BAR; PG8_SCHED;
            PG8_LDA(At, 1, 1); PG8_STAGE(PG8_SB(1, 0), b3, voffB); PG8_STAGE(PG8_SB(1, 1), b3 + hstepB, voffB); PG8_STAGE(PG8_SA(1, 0), a3, voffA);
            PG8_WAIT_V(8); PG8_WAIT_L(0); PG8_BAR; PG8_MMA(1, 0, At, B0); PG8_MMA(1, 1, At, B1); PG8_BAR; PG8_SCHED;
        }
        if constexpr (ALIGN_EPI) { if (wr == 0) PG8_BAR; }
        if constexpr (!Epi::AFTER_DRAIN) E(acc, cur, ui, wr, wc, fr, fq);
        if (!has_next) break;
#pragma unroll
        for (int a = 0; a < 2; ++a)
#pragma unroll
            for (int b = 0; b < 2; ++b)
#pragma unroll
                for (int m = 0; m < 4; ++m)
#pragma unroll
                    for (int n = 0; n < 2; ++n) acc[a][b][m][n] = (f32x4){0.f, 0.f, 0.f, 0.f};
        cur = nxt; cA = nA; cB = nB; ++ui;
        if constexpr (ALIGN_EPI) { if (wr == 1) PG8_BAR; }
    }
    PG8_WAIT_V(0);
    if constexpr (!ALIGN_EPI) { if (wr == 0) PG8_BAR; }
    PG8_BAR;
    if constexpr (Epi::AFTER_DRAIN) E.after(acc, cur, wr, wc, fr, fq, lds);
#undef PG8_SA
#undef PG8_SB
#undef PG8_STAGE
#undef PG8_LDA
#undef PG8_LDB
#undef PG8_MMA
#undef PG8_WAIT_V
#undef PG8_WAIT_L
#undef PG8_BAR
#undef PG8_SCHED
}
}
using pg8::Unit;

constexpr int BATCH = 8, SEQ = 2048, DM = 2048, M = BATCH * SEQ;
constexpr int DSSM = 1024, DSGU = 1024, DIN = 4096, DFF = 8192;
constexpr int LDH = DFF + 64;
constexpr int NG = 64, GS = 16, NS = 64;
constexpr int LC = 16, NCH = SEQ / LC;
constexpr int KA = LC * GS + 2 * NS;
constexpr float EPS = 1e-5f;
constexpr int NWAVES = 8, NTHR = 512;

constexpr size_t MiB = 1u << 20;
constexpr size_t WS_WIN = 1 * MiB, WS_WOUT = 17 * MiB, WS_W1 = 25 * MiB, WS_W2 = 57 * MiB;
constexpr size_t WS_TME = 89 * MiB;
constexpr size_t WS_FT = 101 * MiB;
constexpr size_t WS_A16 = 109 * MiB;
constexpr size_t WS_PV = 110 * MiB;
constexpr size_t WS_PA = 111 * MiB;
constexpr size_t WS_PB = 115 * MiB;
constexpr size_t WS_P2 = 116 * MiB;
constexpr size_t WS_P3 = 118 * MiB;
constexpr size_t WS_H1B = 120 * MiB;
constexpr size_t WS_R1 = 184 * MiB;
constexpr size_t WS_XN = WS_R1;
constexpr size_t WS_S = WS_R1;
constexpr size_t WS_Y = WS_R1 + 64 * MiB;
constexpr size_t WS_AP = WS_R1 + 128 * MiB;
constexpr size_t WS_SG = WS_R1 + 176 * MiB;
constexpr size_t WS_UB = WS_R1 + 208 * MiB;
constexpr size_t WS_VB = WS_R1 + 240 * MiB;
constexpr size_t WS_HID = WS_R1;
constexpr size_t WS_W2P = WS_R1 + 272 * MiB;
constexpr size_t WS_END = WS_W2P + 33 * MiB;

constexpr int RING_BYTES = 131072, TAB_OFF = RING_BYTES, TAB_BYTES = 16384, MISC_OFF = TAB_OFF + TAB_BYTES, LDS_BYTES = MISC_OFF + 256;

struct EpiProj {
    static constexpr bool PERM = true, HAS_MID = false, AFTER_DRAIN = false;
    bf16_t *Ap, *SG, *UB, *VB; float* PV;
    template <int SECT> __device__ __forceinline__ void body(const f32x4 (&acc)[2][2][4][2], const Unit& u, int wr, int wc, int fr, int fq) const {
        const int colt = (u.pn & 3) * 256 + wc * 32 + 8 * fq;
        const int row0 = u.pm * 256 + wr * 64 + fr;
#pragma unroll
        for (int ai = 0; ai < 2; ++ai)
#pragma unroll
            for (int m = 0; m < 4; ++m) {
                const int row = row0 + ai * 128 + m * 16; float ss = 0.f;
#pragma unroll
                for (int bj = 0; bj < 2; ++bj) {
                    const int col8 = colt + bj * 128;
                    f32x4 v0 = acc[ai][bj][m][0], v1 = acc[ai][bj][m][1];
                    if (SECT == 1) {
#pragma unroll
                        for (int j = 0; j < 4; ++j) { v0[j] = sigmoid_f(v0[j]); v1[j] = sigmoid_f(v1[j]); }
                    }
                    if (SECT >= 2) {
#pragma unroll
                        for (int j = 0; j < 4; ++j) { v0[j] = gelu_tanh(v0[j]); v1[j] = gelu_tanh(v1[j]); }
                    }
                    if (SECT == 3) ss += (v0[0] * v0[0] + v0[1] * v0[1]) + (v0[2] * v0[2] + v0[3] * v0[3]) + (v1[0] * v1[0] + v1[1] * v1[1]) + (v1[2] * v1[2] + v1[3] * v1[3]);
                    u32x4 w; w.x = cvt_pk_bf16(v0[0], v0[1]); w.y = cvt_pk_bf16(v0[2], v0[3]); w.z = cvt_pk_bf16(v1[0], v1[1]); w.w = cvt_pk_bf16(v1[2], v1[3]);
                    bf16_t* dst;
                    if (SECT == 0) dst = Ap + ((size_t)((col8 >> 4) * 1024 + (row >> 4)) * KA + (row & 15) * 16 + (col8 & 15));
                    else if (SECT == 1) dst = SG + (size_t)row * 1024 + col8;
                    else if (SECT == 2) dst = UB + (size_t)row * 1024 + col8;
                    else dst = VB + (size_t)row * 1024 + col8;
                    *(u32x4*)dst = w;
                }
                if (SECT == 3) { ss += __shfl_xor(ss, 16); ss += __shfl_xor(ss, 32); if (fq == 0) PV[(size_t)row * 16 + (u.pn & 3) * 4 + wc] = ss; }
            }
    }
    __device__ __forceinline__ void operator()(const f32x4 (&acc)[2][2][4][2], const Unit& u, int ui, int wr, int wc, int fr, int fq) const {
        const int sect = u.pn >> 2;
        if (sect == 0) body<0>(acc, u, wr, wc, fr, fq); else if (sect == 1) body<1>(acc, u, wr, wc, fr, fq);
        else if (sect == 2) body<2>(acc, u, wr, wc, fr, fq); else body<3>(acc, u, wr, wc, fr, fq);
    }
};
struct EpiS {
    static constexpr bool PERM = false, HAS_MID = false, AFTER_DRAIN = true;
    __device__ __forceinline__ void operator()(const f32x4 (&acc)[2][2][4][2], const Unit& u, int ui, int wr, int wc, int fr, int fq) const {}
    __device__ __forceinline__ void after(const f32x4 (&acc)[2][2][4][2], const Unit& u, int wr, int wc, int fr, int fq, LAS unsigned char* lds) const {
        LAS float* S = (LAS float*)lds; const int row0 = wr * 64 + fr, col0 = wc * 32 + 4 * fq;
#pragma unroll
        for (int ai = 0; ai < 2; ++ai)
#pragma unroll
            for (int m = 0; m < 4; ++m) { LAS float* rp = S + (row0 + ai * 128 + m * 16) * 132 + col0;
#pragma unroll
                for (int n = 0; n < 2; ++n) *(LAS f32x4*)(rp + n * 16) = acc[ai][0][m][n]; }
    }
};
struct EpiSsm {
    static constexpr bool PERM = true, HAS_MID = false, AFTER_DRAIN = false;
    const bf16_t *Ap, *SG; const float* dsk; bf16_t* Y; float* PA;
    __device__ __forceinline__ void operator()(const f32x4 (&acc)[2][2][4][2], const Unit& u, int ui, int wr, int wc, int fr, int fq) const {
        asm volatile("" : "+v"(fr), "+v"(fq));
        const int g = u.pn;
#pragma unroll
        for (int bj = 0; bj < 2; ++bj) {
            const int col8 = bj * 128 + wc * 32 + 8 * fq, t = col8 >> 4, hh = col8 & 15, ch = g * 16 + hh;
            const f32x4 d0 = *(const f32x4*)(dsk + ch), d1 = *(const f32x4*)(dsk + ch + 4);
#pragma unroll
            for (int ai = 0; ai < 2; ++ai)
#pragma unroll
                for (int m = 0; m < 4; ++m) {
                    const int R = u.pm * 256 + ai * 128 + wr * 64 + m * 16 + fr, rg = R & 1023, token = (rg >> 7) * SEQ + (rg & 127) * LC + t;
                    const u32x4 uu = *(const u32x4*)(Ap + (size_t)R * KA + t * 16 + hh);
                    const u32x4 sg = *(const u32x4*)(SG + (size_t)token * 1024 + ch);
                    const f32x4 a0 = acc[ai][bj][m][0], a1 = acc[ai][bj][m][1];
                    float o[8];
                    o[0] = gelu_tanh(a0[0] + d0[0] * bf_lo(uu.x)) * bf_lo(sg.x); o[1] = gelu_tanh(a0[1] + d0[1] * bf_hi(uu.x)) * bf_hi(sg.x);
                    o[2] = gelu_tanh(a0[2] + d0[2] * bf_lo(uu.y)) * bf_lo(sg.y); o[3] = gelu_tanh(a0[3] + d0[3] * bf_hi(uu.y)) * bf_hi(sg.y);
                    o[4] = gelu_tanh(a1[0] + d1[0] * bf_lo(uu.z)) * bf_lo(sg.z); o[5] = gelu_tanh(a1[1] + d1[1] * bf_hi(uu.z)) * bf_hi(sg.z);
                    o[6] = gelu_tanh(a1[2] + d1[2] * bf_lo(uu.w)) * bf_lo(sg.w); o[7] = gelu_tanh(a1[3] + d1[3] * bf_hi(uu.w)) * bf_hi(sg.w);
                    float ss = (o[0] * o[0] + o[1] * o[1]) + (o[2] * o[2] + o[3] * o[3]) + (o[4] * o[4] + o[5] * o[5]) + (o[6] * o[6] + o[7] * o[7]);
                    u32x4 w; w.x = cvt_pk_bf16(o[0], o[1]); w.y = cvt_pk_bf16(o[2], o[3]); w.z = cvt_pk_bf16(o[4], o[5]); w.w = cvt_pk_bf16(o[6], o[7]);
                    *(u32x4*)(Y + (size_t)token * DM + ch) = w;
                    ss += __shfl_xor(ss, 16);
                    if ((fq & 1) == 0) PA[(size_t)token * 64 + g] = ss;
                    asm volatile("" ::: "memory"); __builtin_amdgcn_sched_barrier(0);
                }
        }
    }
};
struct EpiOut {
    static constexpr bool PERM = true, HAS_MID = true, AFTER_DRAIN = false;
    const float* x; bf16_t* H1B; float* P2; const LAS f32x2* tab;
    __device__ __forceinline__ void mid(f32x4 (&acc)[2][2][4][2], int ui, int wr, int fr) const {
#pragma unroll
        for (int ai = 0; ai < 2; ++ai)
#pragma unroll
            for (int m = 0; m < 4; ++m) { const float s = tab[ui * 256 + ai * 128 + wr * 64 + m * 16 + fr].x;
#pragma unroll
                for (int bj = 0; bj < 2; ++bj)
#pragma unroll
                    for (int n = 0; n < 2; ++n) acc[ai][bj][m][n] *= s; }
    }
    __device__ __forceinline__ void operator()(const f32x4 (&acc)[2][2][4][2], const Unit& u, int ui, int wr, int wc, int fr, int fq) const {
        asm volatile("" : "+v"(fr), "+v"(fq));
        const int colw = u.pn * 256 + wc * 32 + 8 * fq;
#pragma unroll
        for (int ai = 0; ai < 2; ++ai) {
            f32x4 xr[4][2][2];
#pragma unroll
            for (int m = 0; m < 4; ++m) { const float* xp = x + (size_t)(u.pm * 256 + ai * 128 + wr * 64 + m * 16 + fr) * DM + colw;
#pragma unroll
                for (int bj = 0; bj < 2; ++bj) { xr[m][bj][0] = *(const f32x4*)(xp + bj * 128); xr[m][bj][1] = *(const f32x4*)(xp + bj * 128 + 4); } }
#pragma unroll
            for (int m = 0; m < 4; ++m) {
                const int rl = ai * 128 + wr * 64 + m * 16 + fr, row = u.pm * 256 + rl; const float rb = tab[ui * 256 + rl].y; float ss = 0.f;
#pragma unroll
                for (int bj = 0; bj < 2; ++bj) {
                    const size_t off = (size_t)row * DM + colw + bj * 128;
                    const f32x4 h0 = xr[m][bj][0] + acc[ai][bj][m][0] * rb, hv1 = xr[m][bj][1] + acc[ai][bj][m][1] * rb;
                    ss += (h0[0] * h0[0] + h0[1] * h0[1]) + (h0[2] * h0[2] + h0[3] * h0[3]) + (hv1[0] * hv1[0] + hv1[1] * hv1[1]) + (hv1[2] * hv1[2] + hv1[3] * hv1[3]);
                    u32x4 w; w.x = cvt_pk_bf16(h0[0], h0[1]); w.y = cvt_pk_bf16(h0[2], h0[3]); w.z = cvt_pk_bf16(hv1[0], hv1[1]); w.w = cvt_pk_bf16(hv1[2], hv1[3]);
                    *(u32x4*)(H1B + off) = w;
                }
                ss += __shfl_xor(ss, 16); ss += __shfl_xor(ss, 32);
                if (fq == 0) P2[(size_t)row * 32 + u.pn * 4 + wc] = ss;
            }
            asm volatile("" ::: "memory");
        }
    }
};
struct EpiFF1 {
    static constexpr bool PERM = true, HAS_MID = false, AFTER_DRAIN = false;
    bf16_t* HID; const LAS float* tab;
    __device__ __forceinline__ void operator()(const f32x4 (&acc)[2][2][4][2], const Unit& u, int ui, int wr, int wc, int fr, int fq) const {
#pragma unroll
        for (int ai = 0; ai < 2; ++ai)
#pragma unroll
            for (int m = 0; m < 4; ++m) {
                const int rl = ai * 128 + wr * 64 + m * 16 + fr, row = u.pm * 256 + rl; const float r2 = tab[ui * 256 + rl];
#pragma unroll
                for (int bj = 0; bj < 2; ++bj) {
                    f32x4 v0 = acc[ai][bj][m][0] * r2, v1 = acc[ai][bj][m][1] * r2;
#pragma unroll
                    for (int j = 0; j < 4; ++j) { const float a = fmaxf(v0[j], 0.f), b = fmaxf(v1[j], 0.f); v0[j] = a * a; v1[j] = b * b; }
                    u32x4 w; w.x = cvt_pk_bf16(v0[0], v0[1]); w.y = cvt_pk_bf16(v0[2], v0[3]); w.z = cvt_pk_bf16(v1[0], v1[1]); w.w = cvt_pk_bf16(v1[2], v1[3]);
                    *(u32x4*)(HID + (size_t)row * LDH + u.pn * 256 + bj * 128 + wc * 32 + 8 * fq) = w;
                }
            }
    }
};
struct EpiFF2 {
    static constexpr bool PERM = true, HAS_MID = false, AFTER_DRAIN = false;
    bf16_t* h; float* P3;
    __device__ __forceinline__ void operator()(const f32x4 (&acc)[2][2][4][2], const Unit& u, int ui, int wr, int wc, int fr, int fq) const {
#pragma unroll
        for (int ai = 0; ai < 2; ++ai)
#pragma unroll
            for (int m = 0; m < 4; ++m) {
                const int row = u.pm * 256 + ai * 128 + wr * 64 + m * 16 + fr; float ss = 0.f;
#pragma unroll
                for (int bj = 0; bj < 2; ++bj) {
                    const size_t off = (size_t)row * DM + u.pn * 256 + bj * 128 + wc * 32 + 8 * fq;
                    const u32x4 hb = *(const u32x4*)(h + off); const f32x4 a0 = acc[ai][bj][m][0], a1 = acc[ai][bj][m][1];
                    const float o0 = bf_lo(hb.x) + a0[0], o1 = bf_hi(hb.x) + a0[1], o2 = bf_lo(hb.y) + a0[2], o3 = bf_hi(hb.y) + a0[3];
                    const float o4 = bf_lo(hb.z) + a1[0], o5 = bf_hi(hb.z) + a1[1], o6 = bf_lo(hb.w) + a1[2], o7 = bf_hi(hb.w) + a1[3];
                    ss += (o0 * o0 + o1 * o1) + (o2 * o2 + o3 * o3) + (o4 * o4 + o5 * o5) + (o6 * o6 + o7 * o7);
                    u32x4 w; w.x = cvt_pk_bf16(o0, o1); w.y = cvt_pk_bf16(o2, o3); w.z = cvt_pk_bf16(o4, o5); w.w = cvt_pk_bf16(o6, o7);
                    *(u32x4*)(h + off) = w;
                }
                ss += __shfl_xor(ss, 16); ss += __shfl_xor(ss, 32);
                if (fq == 0) P3[(size_t)row * 32 + u.pn * 4 + wc] = ss;
            }
    }
};

struct PanelOrder {
    int c;
    __device__ bool next(int i, Unit& u) const { if (i >= 2) return false; const int x = c & 7, j = c >> 3; u.pm = i * 32 + x * 4 + (j >> 3); u.pn = j & 7; return true; }
};
struct EpiFF2N {
    static constexpr bool PERM = true, HAS_MID = false, AFTER_DRAIN = false;
    const bf16_t* h1; float* out; const float* gain; float* P3; unsigned* cnt;
    __device__ __forceinline__ void operator()(f32x4 (&acc)[2][2][4][2], const Unit& u, int ui, int wr, int wc, int fr, int fq) const {
        asm volatile("" : "+v"(fr), "+v"(fq));
        const int colw = u.pn * 256 + wc * 32 + 8 * fq;
#pragma unroll
        for (int ai = 0; ai < 2; ++ai)
#pragma unroll
            for (int m = 0; m < 4; ++m) {
                const int row = u.pm * 256 + ai * 128 + wr * 64 + m * 16 + fr; float ss = 0.f;
#pragma unroll
                for (int bj = 0; bj < 2; ++bj) {
                    const u32x4 hb = *(const u32x4*)(h1 + (size_t)row * DM + colw + bj * 128);
                    f32x4& a0 = acc[ai][bj][m][0]; f32x4& a1 = acc[ai][bj][m][1];
                    a0[0] += bf_lo(hb.x); a0[1] += bf_hi(hb.x); a0[2] += bf_lo(hb.y); a0[3] += bf_hi(hb.y);
                    a1[0] += bf_lo(hb.z); a1[1] += bf_hi(hb.z); a1[2] += bf_lo(hb.w); a1[3] += bf_hi(hb.w);
                    ss += (a0[0] * a0[0] + a0[1] * a0[1]) + (a0[2] * a0[2] + a0[3] * a0[3]) + (a1[0] * a1[0] + a1[1] * a1[1]) + (a1[2] * a1[2] + a1[3] * a1[3]);
                }
                ss += __shfl_xor(ss, 16); ss += __shfl_xor(ss, 32);
                if (fq == 0) __hip_atomic_store(P3 + (size_t)row * 32 + u.pn * 4 + wc, ss, __ATOMIC_RELAXED, __HIP_MEMORY_SCOPE_AGENT);
            }
        asm volatile("s_waitcnt vmcnt(0)" ::: "memory");
        unsigned* cp = cnt + 64 * u.pm;
        if ((fr | fq) == 0) __hip_atomic_fetch_add(cp, 1u, __ATOMIC_RELAXED, __HIP_MEMORY_SCOPE_AGENT);
        { unsigned sp = 0;
          while ((unsigned)__builtin_amdgcn_readfirstlane(__hip_atomic_load(cp, __ATOMIC_RELAXED, __HIP_MEMORY_SCOPE_AGENT)) < 64u) { __builtin_amdgcn_s_sleep(2); if (++sp > (1u << 22)) break; } }
        __builtin_amdgcn_fence(__ATOMIC_ACQUIRE, "agent");
        f32x4 g[2][2];
#pragma unroll
        for (int bj = 0; bj < 2; ++bj) { g[bj][0] = *(const f32x4*)(gain + colw + bj * 128); g[bj][1] = *(const f32x4*)(gain + colw + bj * 128 + 4); }
#pragma unroll
        for (int ai = 0; ai < 2; ++ai)
#pragma unroll
            for (int m = 0; m < 4; ++m) {
                const int row = u.pm * 256 + ai * 128 + wr * 64 + m * 16 + fr;
                const unsigned long long* pr = (const unsigned long long*)(P3 + (size_t)row * 32 + fq * 8); float s = 0.f;
#pragma unroll
                for (int k = 0; k < 4; ++k) { const unsigned long long w = __hip_atomic_load(pr + k, __ATOMIC_RELAXED, __HIP_MEMORY_SCOPE_AGENT); s += __uint_as_float((unsigned)w) + __uint_as_float((unsigned)(w >> 32)); }
                s += __shfl_xor(s, 16); s += __shfl_xor(s, 32);
                const float r = 1.0f / sqrtf(s * (1.0f / DM) + EPS);
#pragma unroll
                for (int bj = 0; bj < 2; ++bj) { float* op = out + (size_t)row * DM + colw + bj * 128;
                    *(f32x4*)op = acc[ai][bj][m][0] * r * g[bj][0]; *(f32x4*)(op + 4) = acc[ai][bj][m][1] * r * g[bj][1]; }
                asm volatile("" ::: "memory");
            }
    }
};

__device__ __forceinline__ float wave_sum(float v) {
#pragma unroll
    for (int o = 1; o < 64; o <<= 1) v += __shfl_xor(v, o);
    return v;
}
__device__ __forceinline__ void p0_transpose_item(const float* W, int K, int N, bf16_t* WT, const float* gain, const float* gain_hi, LAS float* scr, int item, int lane, int ldw = 0) {
    if (ldw == 0) ldw = K;
    const int nblk = N / 32, kb = item / nblk, nb = item % nblk, k0 = 64 * kb, n0 = 32 * nb;
    const float* gk = gain ? ((gain_hi && k0 >= 1024) ? gain_hi + (k0 - 1024) : gain + k0) : nullptr;
    float wv[32];
#pragma unroll
    for (int i = 0; i < 32; ++i) wv[i] = W[(size_t)(k0 + 2 * i + (lane >> 5)) * N + n0 + (lane & 31)];
#pragma unroll
    for (int i = 0; i < 32; ++i) { const int kk = 2 * i + (lane >> 5); float v = wv[i]; if (gk) v *= gk[kk]; scr[kk * 33 + (lane & 31)] = v; }
    asm volatile("s_waitcnt lgkmcnt(0)" ::: "memory");
    const int c = lane & 7;
#pragma unroll
    for (int j = 0; j < 4; ++j) { const int n = (lane >> 3) + 8 * j; const LAS float* s = scr + (8 * c) * 33 + n;
        u32x4 o; o.x = cvt_pk_bf16(s[0 * 33], s[1 * 33]); o.y = cvt_pk_bf16(s[2 * 33], s[3 * 33]); o.z = cvt_pk_bf16(s[4 * 33], s[5 * 33]); o.w = cvt_pk_bf16(s[6 * 33], s[7 * 33]);
        *(u32x4*)(WT + (size_t)(n0 + n) * ldw + k0 + 8 * c) = o; }
    asm volatile("s_waitcnt lgkmcnt(0)" ::: "memory");
}
__device__ __forceinline__ f32x2 cpow_k(float lre, float lim, float dt, int k) {
    const float mag = expf((float)k * lre * dt);
    const double rev = (double)k * (double)lim * (double)dt * 0.15915494309189535;
    const float fr = (float)(rev - rint(rev));
    return (f32x2){mag * __builtin_amdgcn_cosf(fr), mag * __builtin_amdgcn_sinf(fr)};
}

#define RLX_AGENT __ATOMIC_RELAXED, __HIP_MEMORY_SCOPE_AGENT
#define XB_TMO      128
#define XB_XCNT(j)  (256  + 64 * (j))
#define XB_XSUB(j)  (1280 + 64 * (j))
#define XB_XGEN(j)  (2304 + 64 * (j))
#define XB_TOP      3328
#define XB_TOPGEN   3392
#define XCD_BAR_WORDS 3456
#define XB_SPIN_CAP (1u << 22)
__device__ __forceinline__ unsigned xb_ld(unsigned* p)              { return __hip_atomic_load(p, __ATOMIC_RELAXED, __HIP_MEMORY_SCOPE_AGENT); }
__device__ __forceinline__ unsigned xb_add(unsigned* p, unsigned v) { return __hip_atomic_fetch_add(p, v, __ATOMIC_RELAXED, __HIP_MEMORY_SCOPE_AGENT); }
__device__ __forceinline__ unsigned xb_xcc_id() { return (unsigned)__builtin_amdgcn_s_getreg((3 << 11) | 20) & 0xFu; }
#define XB_SPIN(cond, bar) do { unsigned _sp = 0; while (cond) { __builtin_amdgcn_s_sleep(1); \
    if ((++_sp & 255u) == 0u) { if (xb_ld(&(bar)[XB_TMO])) break; if (_sp > XB_SPIN_CAP) { atomicAdd(&(bar)[XB_TMO], 1u); break; } } } } while (0)
struct XcdBarrier { unsigned* bar; unsigned x; volatile LAS unsigned* st; };
__device__ __forceinline__ XcdBarrier xcd_barrier_post(unsigned* bar, volatile LAS unsigned* st) {
    XcdBarrier b; b.bar = bar; b.x = xb_xcc_id(); b.st = st;
    if (threadIdx.x == 0) (void)xb_add(&bar[XB_XCNT(b.x)], 1u);
    return b;
}
__device__ __forceinline__ void xcd_barrier_complete(unsigned* bar, unsigned x, unsigned& nloc, unsigned& nx) {
    const unsigned G = gridDim.x * gridDim.y * gridDim.z;
    unsigned sum, cnt, mine, sp = 0u;
    for (;;) {
        sum = 0u; cnt = 0u; mine = 0u;
#pragma unroll
        for (unsigned j = 0; j < 16; ++j) { const unsigned c = xb_ld(&bar[XB_XCNT(j)]); sum += c; cnt += (c > 0u) ? 1u : 0u; mine = (j == x) ? c : mine; }
        if (sum == G) break;
        __builtin_amdgcn_s_sleep(1);
        if ((++sp & 255u) == 0u) { if (xb_ld(&bar[XB_TMO])) break; if (sp > XB_SPIN_CAP) { atomicAdd(&bar[XB_TMO], 1u); break; } }
    }
    nloc = mine > 0u ? mine : 1u; nx = cnt > 0u ? cnt : 1u;
}
__device__ __forceinline__ void xcd_barrier(const XcdBarrier& b) {
    asm volatile("s_waitcnt vmcnt(0)" ::: "memory");
    __syncthreads();
    if (threadIdx.x == 0) {
        unsigned* bar = b.bar;
        __builtin_amdgcn_s_waitcnt(0);
        unsigned nloc = b.st[0], nx = b.st[1];
        if (nloc == 0u) { xcd_barrier_complete(bar, b.x, nloc, nx); b.st[0] = nloc; b.st[1] = nx; }
        const unsigned old = xb_add(&bar[XB_XSUB(b.x)], 1u);
        const unsigned gen = old / nloc;
        if (old + 1u == (gen + 1u) * nloc) {
            __builtin_amdgcn_fence(__ATOMIC_RELEASE, "agent");
            asm volatile("s_waitcnt vmcnt(0)" ::: "memory");
            const unsigned og = xb_add(&bar[XB_TOP], 1u);
            const unsigned tg = og / nx;
            if (og + 1u == (tg + 1u) * nx) xb_add(&bar[XB_TOPGEN], 1u);
            else XB_SPIN(xb_ld(&bar[XB_TOPGEN]) == tg, bar);
            __builtin_amdgcn_fence(__ATOMIC_ACQUIRE, "agent");
            xb_add(&bar[XB_XGEN(b.x)], 1u);
            asm volatile("s_waitcnt vmcnt(0)" ::: "memory");
        } else {
            XB_SPIN(xb_ld(&bar[XB_XGEN(b.x)]) == gen, bar);
            __builtin_amdgcn_fence(__ATOMIC_ACQUIRE, "agent");
            asm volatile("s_waitcnt vmcnt(0)" ::: "memory");
        }
    }
    __syncthreads();
}

struct Params { const float* in[21]; float* out; unsigned char* ws; int ph_lo, ph_hi; };

__device__ __forceinline__ void p0_ssm_task(const Params& p, LAS unsigned char* lds, int g, int d, int tid) {
    LAS float* coef = (LAS float*)lds;
    LAS float* pd = coef + 128;
    LAS float* pd1 = pd + 128;
    LAS float* wre = pd1 + 128;
    LAS float* wim = wre + 1024;
    LAS float* cre = wim + 1024;
    LAS float* cim = cre + 1024;
    const float* a_re = p.in[2]; const float* a_im = p.in[3]; const float* log_dt = p.in[4];
    const float* b_re = p.in[5]; const float* b_im = p.in[6]; const float* c_re = p.in[7]; const float* c_im = p.in[8];
    bf16_t* TmE = (bf16_t*)(p.ws + WS_TME) + (size_t)g * 256 * KA;
    bf16_t* Ft = (bf16_t*)(p.ws + WS_FT) + (size_t)g * 256 * 256;
    if (tid < 64) {
        const int n = tid; const float dt = expf(log_dt[g]); const float lre = fminf(a_re[g * 64 + n], -1e-4f), lim = a_im[g * 64 + n];
        const f32x2 ab = cpow_k(lre, lim, dt, 1);
        const float den = lre * lre + lim * lim, nre = ab.x - 1.0f;
        coef[2 * n] = (nre * lre + ab.y * lim) / den; coef[2 * n + 1] = (ab.y * lre - nre * lim) / den;
        const f32x2 q = cpow_k(lre, lim, dt, d), q1 = cpow_k(lre, lim, dt, d + 1);
        pd[2 * n] = q.x; pd[2 * n + 1] = q.y; pd1[2 * n] = q1.x; pd1[2 * n + 1] = q1.y;
        if (d == 0) { const f32x2 q16 = cpow_k(lre, lim, dt, 16); *(f32x2*)((float*)(p.ws + WS_A16) + (size_t)(g * 64 + n) * 2) = q16; }
    }
    __syncthreads();
    for (int idx = tid; idx < 1024; idx += NTHR) {
        const int n = idx >> 4;
        const float br = b_re[(size_t)g * 1024 + idx], bi = b_im[(size_t)g * 1024 + idx], cr = coef[2 * n], ci = coef[2 * n + 1];
        const float bbr = cr * br - ci * bi, bbi = cr * bi + ci * br, pr = pd[2 * n], pi = pd[2 * n + 1];
        wre[idx] = pr * bbr - pi * bbi; wim[idx] = pr * bbi + pi * bbr;
        cre[idx] = c_re[(size_t)g * 1024 + idx]; cim[idx] = c_im[(size_t)g * 1024 + idx];
    }
    __syncthreads();
    if (tid < 256) {
        const int h = tid >> 4, h2 = tid & 15; float s = 0.f;
#pragma unroll 8
        for (int n = 0; n < 64; ++n) s += cre[h * 64 + n] * wre[n * 16 + h2] - cim[h * 64 + n] * wim[n * 16 + h2];
        const bf16_t kb = (bf16_t)(cvt_pk_bf16(s, 0.f) & 0xffffu);
        for (int t = d; t < 16; ++t) TmE[(size_t)(t * 16 + h) * KA + (t - d) * 16 + h2] = kb;
        if (d > 0) for (int t = 0; t < 16 - d; ++t) TmE[(size_t)(t * 16 + h) * KA + (t + d) * 16 + h2] = 0;
    } else {
        const int q = tid - 256;
#pragma unroll
        for (int r = 0; r < 4; ++r) {
            const int idx = q + 256 * r;
            { const int h = idx >> 6, n = idx & 63; const float pr = pd1[2 * n], pi = pd1[2 * n + 1], cr = cre[h * 64 + n], ci = cim[h * 64 + n];
              const unsigned w = cvt_pk_bf16(cr * pr - ci * pi, -(cr * pi + ci * pr));
              bf16_t* rowp = TmE + (size_t)(d * 16 + h) * KA + 256; rowp[n] = (bf16_t)(w & 0xffffu); rowp[64 + n] = (bf16_t)(w >> 16); }
            { const int n = idx >> 4, h2 = idx & 15, col = (15 - d) * 16 + h2; const unsigned w = cvt_pk_bf16(wre[idx], wim[idx]);
              Ft[(size_t)n * 256 + col] = (bf16_t)(w & 0xffffu); Ft[(size_t)(64 + n) * 256 + col] = (bf16_t)(w >> 16);
              Ft[(size_t)(128 + n) * 256 + col] = 0; Ft[(size_t)(192 + n) * 256 + col] = 0; }
        }
    }
    __syncthreads();
}

__device__ __forceinline__ void sgu_unit(const Params& p, LAS unsigned char* lds, int unit, int tid) {
    constexpr int LDT = 136;
    LAS bf16_t* At = (LAS bf16_t*)lds;
    LAS bf16_t* Bt = (LAS bf16_t*)(lds + 128 * LDT * 2);
    LAS float* rvs = (LAS float*)(lds + 2 * 128 * LDT * 2);
    const int h = unit & 7, bnb = unit >> 3, tok0 = bnb * 128;
    const float* PV = (const float*)(p.ws + WS_PV); const bf16_t* VB = (const bf16_t*)(p.ws + WS_VB); const bf16_t* UB = (const bf16_t*)(p.ws + WS_UB);
    bf16_t* Y = (bf16_t*)(p.ws + WS_Y); float* PB = (float*)(p.ws + WS_PB);
    const float* vgain = p.in[10]; const float* sw = p.in[11] + (size_t)h * 128 * 128; const float* sb = p.in[12] + h * 128;
    if (tid < 128) { const f32x4* pp = (const f32x4*)(PV + (size_t)(tok0 + tid) * 16); const f32x4 a = pp[0], b = pp[1], c = pp[2], d = pp[3];
        const float s = ((a[0] + a[1]) + (a[2] + a[3])) + ((b[0] + b[1]) + (b[2] + b[3])) + ((c[0] + c[1]) + (c[2] + c[3])) + ((d[0] + d[1]) + (d[2] + d[3]));
        rvs[tid] = 1.0f / sqrtf(s * (1.0f / 1024.0f) + EPS); }
    __syncthreads();
#pragma unroll
    for (int q = 0; q < 4; ++q) {
        const int pc = tid + NTHR * q, r = pc >> 4, c0 = (pc & 15) * 8;
        {
            const bool on = (c0 >> 6) <= (r >> 6);
            const f32x4 w0 = *(const f32x4*)(sw + r * 128 + c0), w1 = *(const f32x4*)(sw + r * 128 + c0 + 4);
            const f32x4 r0 = *(const LAS f32x4*)(rvs + c0), r1 = *(const LAS f32x4*)(rvs + c0 + 4);
            u32x4 o;
            if (on) { o.x = cvt_pk_bf16(w0[0] * r0[0], w0[1] * r0[1]); o.y = cvt_pk_bf16(w0[2] * r0[2], w0[3] * r0[3]); o.z = cvt_pk_bf16(w1[0] * r1[0], w1[1] * r1[1]); o.w = cvt_pk_bf16(w1[2] * r1[2], w1[3] * r1[3]); }
            else { o = (u32x4){0u, 0u, 0u, 0u}; }
            *(LAS u32x4*)(At + r * LDT + c0) = o;
        }
        {
            const int rt = pc & 127, ct0 = (pc >> 7) * 8;
            const u32x4 vv = *(const u32x4*)(VB + (size_t)(tok0 + rt) * 1024 + h * 128 + ct0);
            Bt[(ct0 + 0) * LDT + rt] = (bf16_t)(vv.x & 0xffffu); Bt[(ct0 + 1) * LDT + rt] = (bf16_t)(vv.x >> 16);
            Bt[(ct0 + 2) * LDT + rt] = (bf16_t)(vv.y & 0xffffu); Bt[(ct0 + 3) * LDT + rt] = (bf16_t)(vv.y >> 16);
            Bt[(ct0 + 4) * LDT + rt] = (bf16_t)(vv.z & 0xffffu); Bt[(ct0 + 5) * LDT + rt] = (bf16_t)(vv.z >> 16);
            Bt[(ct0 + 6) * LDT + rt] = (bf16_t)(vv.w & 0xffffu); Bt[(ct0 + 7) * LDT + rt] = (bf16_t)(vv.w >> 16);
        }
    }
    __syncthreads();
    const int w = tid >> 6, lane = tid & 63, fr = lane & 15, fq = lane >> 4;
    bf16x8 wf[4];
#pragma unroll
    for (int ks = 0; ks < 4; ++ks) wf[ks] = *(const LAS bf16x8*)(At + (16 * w + fr) * LDT + ks * 32 + fq * 8);
    const int i = 16 * w + fr; const size_t tok = (size_t)(tok0 + i); const float bsi = sb[i]; float ss = 0.f;
#pragma unroll
    for (int ct = 0; ct < 8; ++ct) {
        f32x4 acc = (f32x4){0.f, 0.f, 0.f, 0.f};
#pragma unroll
        for (int ks = 0; ks < 4; ++ks) { const bf16x8 vf = *(const LAS bf16x8*)(Bt + (16 * ct + fr) * LDT + ks * 32 + fq * 8); acc = __builtin_amdgcn_mfma_f32_16x16x32_bf16(vf, wf[ks], acc, 0, 0, 0); }
        const int c = 16 * ct + 4 * fq;
        const u32x2 uu = *(const u32x2*)(UB + tok * 1024 + h * 128 + c); const f32x4 vg = *(const f32x4*)(vgain + h * 128 + c);
        const float o0 = bf_lo(uu.x) * (vg[0] * acc[0] + bsi), o1 = bf_hi(uu.x) * (vg[1] * acc[1] + bsi), o2 = bf_lo(uu.y) * (vg[2] * acc[2] + bsi), o3 = bf_hi(uu.y) * (vg[3] * acc[3] + bsi);
        ss += (o0 * o0 + o1 * o1) + (o2 * o2 + o3 * o3);
        u32x2 wv; wv.x = cvt_pk_bf16(o0, o1); wv.y = cvt_pk_bf16(o2, o3);
        *(u32x2*)(Y + tok * DM + DSSM + h * 128 + c) = wv;
    }
    ss += __shfl_xor(ss, 16); ss += __shfl_xor(ss, 32);
    if (fq == 0) PB[tok * 8 + h] = ss;
    __syncthreads();
}

__device__ __forceinline__ void carry_task(const Params& p, int g, int tid) {
    const int b = tid >> 6, n = tid & 63;
    const float* S = (const float*)(p.ws + WS_S); bf16_t* Ap = (bf16_t*)(p.ws + WS_AP);
    const f32x2 a16 = *(const f32x2*)((const float*)(p.ws + WS_A16) + (size_t)(g * 64 + n) * 2);
    float hr = 0.f, hi = 0.f; const size_t row0 = (size_t)g * 1024 + b * 128;
#pragma unroll 8
    for (int c = 0; c < NCH; ++c) {
        const size_t row = row0 + c; const float sr = S[row * 128 + n], si = S[row * 128 + 64 + n];
        const unsigned w = cvt_pk_bf16(hr, hi);
        Ap[row * KA + 256 + n] = (bf16_t)(w & 0xffffu); Ap[row * KA + 320 + n] = (bf16_t)(w >> 16);
        const float nr = a16.x * hr - a16.y * hi + sr, ni = a16.x * hi + a16.y * hr + si; hr = nr; hi = ni;
    }
}

__global__ void __launch_bounds__(NTHR, 2) fwd_megakernel(Params p) {
    extern __shared__ __attribute__((aligned(16))) unsigned char lds_raw[];
    LAS unsigned char* lds = (LAS unsigned char*)lds_raw;
    cg::grid_group grid = cg::this_grid();
    const int tid = threadIdx.x, lane = tid & 63, wave = __builtin_amdgcn_readfirstlane(tid >> 6);
    const int G = gridDim.x, bx = blockIdx.x;
    const int lo = p.ph_lo, hi = p.ph_hi;
    unsigned char* ws = p.ws;
#ifndef PH_MASK
#define PH_MASK 0x7f
#endif
#define IN(k) (((PH_MASK >> (k)) & 1) && lo <= (k) && (k) < hi)
    volatile LAS unsigned* MISC = (volatile LAS unsigned*)(lds + MISC_OFF);
    if (tid < 64) MISC[tid] = 0u;
    __syncthreads();
    XcdBarrier xbar = xcd_barrier_post((unsigned*)ws, MISC);
#define SEAM(k) do { if (IN(k) && IN((k) + 1)) xcd_barrier(xbar); } while (0)
    if (hi > 64) grid.sync();

    if (IN(0)) {
        for (int t = bx; t < NG * 16; t += G) p0_ssm_task(p, lds, t >> 4, t & 15, tid);
        LAS float* scr = (LAS float*)(lds + wave * 16384);
        const int gw = bx * NWAVES + wave, NGW = G * NWAVES;
        constexpr int I_IN = (DM / 64) * (DIN / 32), I_OUT = (DM / 64) * (DM / 32), I_1 = (DM / 64) * (DFF / 32), I_2 = (DFF / 64) * (DM / 32);
        for (int it = gw; it < I_IN + I_OUT + I_1 + I_2; it += NGW) {
            int r = it;
            if (r < I_IN) { p0_transpose_item(p.in[1], DM, DIN, (bf16_t*)(ws + WS_WIN), nullptr, nullptr, scr, r, lane); continue; } r -= I_IN;
            if (r < I_OUT) { p0_transpose_item(p.in[15], DM, DM, (bf16_t*)(ws + WS_WOUT), p.in[13], p.in[14], scr, r, lane); continue; } r -= I_OUT;
            if (r < I_1) { p0_transpose_item(p.in[18], DM, DFF, (bf16_t*)(ws + WS_W1), p.in[17], nullptr, scr, r, lane); continue; } r -= I_1;
            p0_transpose_item(p.in[19], DFF, DM, (bf16_t*)(ws + WS_W2P), nullptr, nullptr, scr, r, lane, LDH);
        }
        const float* x = p.in[0]; const float* mg = p.in[16]; bf16_t* XN = (bf16_t*)(ws + WS_XN);
        for (int m = gw; m < M; m += NGW) {
            const f32x4* xr = (const f32x4*)(x + (size_t)m * DM) + lane; f32x4 v[8]; float s = 0.f;
#pragma unroll
            for (int j = 0; j < 8; ++j) { v[j] = xr[64 * j]; s += (v[j][0] * v[j][0] + v[j][1] * v[j][1]) + (v[j][2] * v[j][2] + v[j][3] * v[j][3]); }
            const float r = 1.0f / sqrtf(wave_sum(s) * (1.0f / DM) + EPS);
            u32x2* o = (u32x2*)(XN + (size_t)m * DM) + lane;
#pragma unroll
            for (int j = 0; j < 8; ++j) { const f32x4 gg = *((const f32x4*)mg + 64 * j + lane); u32x2 w; w.x = cvt_pk_bf16(v[j][0] * r * gg[0], v[j][1] * r * gg[1]); w.y = cvt_pk_bf16(v[j][2] * r * gg[2], v[j][3] * r * gg[3]); o[64 * j] = w; }
        }
    }
    SEAM(0);
    if (IN(1)) {
        pg8::Gemm g{(const bf16_t*)(ws + WS_XN), (const bf16_t*)(ws + WS_WIN), DM, DM, DM}; pg8::StaticOrder S; S.init(M, DIN, G, bx);
        EpiProj E{(bf16_t*)(ws + WS_AP), (bf16_t*)(ws + WS_SG), (bf16_t*)(ws + WS_UB), (bf16_t*)(ws + WS_VB), (float*)(ws + WS_PV)};
        pg8::gemm_phase<EpiProj, pg8::StaticOrder, true>(lds, g, S, E);
    }
    SEAM(1);
    if (IN(2)) {
        pg8::GroupOrder GO; GO.init(G, bx);
        for (int i = 0;; ++i) {
            Unit u; if (!GO.next(i, u)) break;
            pg8::OneUnit S1{u.pm, u.pn};
            { pg8::Gemm g{(const bf16_t*)(ws + WS_AP), (const bf16_t*)(ws + WS_FT), KA, 256, 256}; EpiS E{};
              pg8::gemm_phase<EpiS, pg8::OneUnit, false>(lds, g, S1, E); }
            __syncthreads();
            if (tid < 128) {
                const int b2 = tid >> 6, n = tid & 63; const LAS float* S = (const LAS float*)lds + (b2 * 128) * 132 + n;
                bf16_t* hp = (bf16_t*)(ws + WS_AP) + ((size_t)u.pm * 256 + b2 * 128) * KA + 256 + n;
                const f32x2 a16 = *(const f32x2*)((const float*)(ws + WS_A16) + (size_t)(u.pn * 64 + n) * 2);
                float hr = 0.f, hi = 0.f;
#pragma unroll 8
                for (int c = 0; c < NCH; ++c) {
                    const float sr = S[c * 132], si = S[c * 132 + 64];
                    const unsigned w = cvt_pk_bf16(hr, hi);
                    hp[(size_t)c * KA] = (bf16_t)(w & 0xffffu); hp[(size_t)c * KA + 64] = (bf16_t)(w >> 16);
                    const float nr = a16.x * hr - a16.y * hi + sr, ni = a16.x * hi + a16.y * hr + si; hr = nr; hi = ni;
                }
            }
            asm volatile("s_waitcnt vmcnt(0)" ::: "memory");
            __syncthreads();
            { pg8::Gemm g{(const bf16_t*)(ws + WS_AP), (const bf16_t*)(ws + WS_TME), KA, KA, KA};
              EpiSsm E{(const bf16_t*)(ws + WS_AP), (const bf16_t*)(ws + WS_SG), p.in[9], (bf16_t*)(ws + WS_Y), (float*)(ws + WS_PA)};
              pg8::gemm_phase<EpiSsm, pg8::OneUnit, true>(lds, g, S1, E); }
        }
        for (int uu = bx; uu < 1024; uu += G) sgu_unit(p, lds, uu, tid);
    }
    SEAM(2);
    if (IN(3)) {
        pg8::StaticOrder S; S.init(M, DM, G, bx);
        LAS f32x2* tab = (LAS f32x2*)(lds + TAB_OFF);
        const float* PA = (const float*)(ws + WS_PA); const float* PB = (const float*)(ws + WS_PB);
        for (int idx = tid; idx < TAB_BYTES / 8; idx += NTHR) {
            Unit u; if (!S.next(idx >> 8, u)) break;
            const int row = u.pm * 256 + (idx & 255); const f32x4* pa = (const f32x4*)(PA + (size_t)row * 64); float sa = 0.f;
#pragma unroll
            for (int j = 0; j < 16; ++j) { const f32x4 v = pa[j]; sa += (v[0] + v[1]) + (v[2] + v[3]); }
            const f32x4* pb = (const f32x4*)(PB + (size_t)row * 8); const f32x4 b0 = pb[0], b1 = pb[1]; const float sbb = ((b0[0] + b0[1]) + (b0[2] + b0[3])) + ((b1[0] + b1[1]) + (b1[2] + b1[3]));
            const float ra = 1.0f / sqrtf(sa * (1.0f / 1024.0f) + EPS), rb = 1.0f / sqrtf(sbb * (1.0f / 1024.0f) + EPS);
            tab[idx] = (f32x2){ra / rb, rb};
        }
        __syncthreads();
        pg8::Gemm g{(const bf16_t*)(ws + WS_Y), (const bf16_t*)(ws + WS_WOUT), DM, DM, DM};
        EpiOut E{p.in[0], (bf16_t*)(ws + WS_H1B), (float*)(ws + WS_P2), tab};
        pg8::gemm_phase<EpiOut, pg8::StaticOrder, true>(lds, g, S, E);
    }
    SEAM(3);
    if (IN(4)) {
        pg8::StaticOrder S; S.init(M, DFF, G, bx);
        LAS float* tab = (LAS float*)(lds + TAB_OFF);
        const float* P2 = (const float*)(ws + WS_P2);
        for (int idx = tid; idx < TAB_BYTES / 4; idx += NTHR) {
            Unit u; if (!S.next(idx >> 8, u)) break;
            const int row = u.pm * 256 + (idx & 255); const f32x4* pp = (const f32x4*)(P2 + (size_t)row * 32); float s = 0.f;
#pragma unroll
            for (int j = 0; j < 8; ++j) { const f32x4 v = pp[j]; s += (v[0] + v[1]) + (v[2] + v[3]); }
            tab[idx] = 1.0f / sqrtf(s * (1.0f / DM) + EPS);
        }
        __syncthreads();
        pg8::Gemm g{(const bf16_t*)(ws + WS_H1B), (const bf16_t*)(ws + WS_W1), DM, DM, DM};
        EpiFF1 E{(bf16_t*)(ws + WS_HID), tab};
        pg8::gemm_phase<EpiFF1, pg8::StaticOrder, true>(lds, g, S, E);
    }
    SEAM(4);
    const bool fused_norm = (G == 256);
    if (IN(5)) {
        pg8::Gemm g{(const bf16_t*)(ws + WS_HID), (const bf16_t*)(ws + WS_W2P), LDH, LDH, DFF};
        if (fused_norm) {
            PanelOrder S{bx};
            EpiFF2N E{(const bf16_t*)(ws + WS_H1B), p.out, p.in[20], (float*)(ws + WS_P3), (unsigned*)ws + 4096};
            pg8::gemm_phase<EpiFF2N, PanelOrder, true>(lds, g, S, E);
        } else {
            pg8::StaticOrder S; S.init(M, DM, G, bx);
            EpiFF2 E{(bf16_t*)(ws + WS_H1B), (float*)(ws + WS_P3)};
            pg8::gemm_phase<EpiFF2, pg8::StaticOrder, true>(lds, g, S, E);
        }
    }
    if (!fused_norm) SEAM(5);
    if (IN(6) && !fused_norm) {
        const int gw = bx * NWAVES + wave, NGW = G * NWAVES; const float* P3 = (const float*)(ws + WS_P3); const float* fg = p.in[20]; const bf16_t* H2 = (const bf16_t*)(ws + WS_H1B);
        for (int m = gw; m < M; m += NGW) {
            const float ps = (lane < 32) ? P3[(size_t)m * 32 + lane] : 0.f;
            const u32x4* hr = (const u32x4*)(H2 + (size_t)m * DM) + lane; u32x4 hv[4];
#pragma unroll
            for (int j = 0; j < 4; ++j) hv[j] = hr[64 * j];
            const float r = 1.0f / sqrtf(wave_sum(ps) * (1.0f / DM) + EPS);
            f32x4* orow = (f32x4*)(p.out + (size_t)m * DM) + 2 * lane;
#pragma unroll
            for (int j = 0; j < 4; ++j) { const f32x4 g0 = *((const f32x4*)fg + 128 * j + 2 * lane), g1 = *((const f32x4*)fg + 128 * j + 2 * lane + 1);
                f32x4 o0 = {bf_lo(hv[j].x), bf_hi(hv[j].x), bf_lo(hv[j].y), bf_hi(hv[j].y)}, o1 = {bf_lo(hv[j].z), bf_hi(hv[j].z), bf_lo(hv[j].w), bf_hi(hv[j].w)};
                orow[128 * j] = o0 * r * g0; orow[128 * j + 1] = o1 * r * g1; }
        }
    }
#ifdef DBG_STOP
    grid.sync();
    {
        const size_t NT = (size_t)M * DM; const size_t gt = (size_t)bx * NTHR + tid, gs = (size_t)G * NTHR;
        const bf16_t* XN = (const bf16_t*)(ws + WS_XN); const bf16_t* WINp = (const bf16_t*)(ws + WS_WIN); const bf16_t* WOUTp = (const bf16_t*)(ws + WS_WOUT);
        const bf16_t* W1p = (const bf16_t*)(ws + WS_W1); const bf16_t* W2p = (const bf16_t*)(ws + WS_W2); const bf16_t* TMEp = (const bf16_t*)(ws + WS_TME); const bf16_t* FTp = (const bf16_t*)(ws + WS_FT);
        const bf16_t* SGp = (const bf16_t*)(ws + WS_SG); const bf16_t* UBp = (const bf16_t*)(ws + WS_UB); const bf16_t* VBp = (const bf16_t*)(ws + WS_VB); const bf16_t* APp = (const bf16_t*)(ws + WS_AP);
        const bf16_t* Yp = (const bf16_t*)(ws + WS_Y); const bf16_t* H1Bp = (const bf16_t*)(ws + WS_H1B); const bf16_t* HIDp = (const bf16_t*)(ws + WS_HID);
        const float* Sp = (const float*)(ws + WS_S); const float* PVp = (const float*)(ws + WS_PV); const float* PAp = (const float*)(ws + WS_PA); const float* PBp = (const float*)(ws + WS_PB);
        const float* P2p = (const float*)(ws + WS_P2); const float* P3p = (const float*)(ws + WS_P3);
#define BFV(p, i) __uint_as_float(((unsigned)(p)[(i)]) << 16)
        for (size_t i = gt; i < NT; i += gs) {
            float v = 0.f;
            if (DBG_STOP == 0) v = BFV(XN, i) + BFV(WINp, i % (size_t)(DIN * DM)) + BFV(WOUTp, i % (size_t)(DM * DM)) + BFV(W1p, i % (size_t)(DFF * DM)) + BFV(W2p, i % (size_t)(DFF * DM)) + BFV(TMEp, i % (size_t)(64 * 256 * KA)) + BFV(FTp, i % (size_t)(64 * 256 * 256));
            if (DBG_STOP == 1) { const size_t e = i % (size_t)(65536 * 256); v = BFV(SGp, i % (size_t)(M * 1024)) + 0.f * (float)(e & 1); }
            if (DBG_STOP == 2) v = Sp[i % (size_t)(65536 * 128)];
            if (DBG_STOP == 3) { const size_t e = i % (size_t)(65536 * 128), y = i % (size_t)(M * 1024); v = BFV(APp, (e >> 7) * KA + 256 + (e & 127)) + BFV(Yp, (y >> 10) * DM + 1024 + (y & 1023)) + PBp[i % (size_t)(M * 8)]; }
            if (DBG_STOP == 4) { const size_t y = i % (size_t)(M * 1024); v = BFV(Yp, (y >> 10) * DM + (y & 1023)) + PAp[i % (size_t)(M * 64)]; }
            if (DBG_STOP == 5) v = p.out[i] + BFV(H1Bp, i) + P2p[i % (size_t)(M * 32)];
            if (DBG_STOP == 6) v = BFV(HIDp, i) + BFV(HIDp, i + NT) + BFV(HIDp, i + 2 * NT) + BFV(HIDp, i + 3 * NT);
            if (DBG_STOP == 7) v = p.out[i] + P3p[i % (size_t)(M * 32)];
            p.out[i] = v;
        }
    }
#endif
#undef IN
#undef SEAM
}

extern "C" void kernel_launch(void* const* d_in, const int* in_sizes, int n_in, void* d_out, int out_size, void* d_ws, size_t ws_size, hipStream_t stream) {
    static int grid = 0;
    if (grid == 0) {
        if (n_in != 21 || out_size != M * DM || ws_size < WS_END) { fprintf(stderr, "kernel_launch: unexpected shapes (n_in %d, out %d, ws %zu)\n", n_in, out_size, ws_size); grid = -1; return; }
        int dev = 0, cus = 0, per_cu = 0;
        hipGetDevice(&dev); hipDeviceGetAttribute(&cus, hipDeviceAttributeMultiprocessorCount, dev);
        if (hipFuncSetAttribute((const void*)fwd_megakernel, hipFuncAttributeMaxDynamicSharedMemorySize, LDS_BYTES) != hipSuccess) { fprintf(stderr, "kernel_launch: hipFuncSetAttribute failed\n"); grid = -1; return; }
        if (hipOccupancyMaxActiveBlocksPerMultiprocessor(&per_cu, (const void*)fwd_megakernel, NTHR, LDS_BYTES) != hipSuccess || per_cu < 1) { fprintf(stderr, "kernel_launch: occupancy query failed (%d)\n", per_cu); (void)hipGetLastError(); per_cu = 1; }
        grid = cus * per_cu;
        if (grid > 256) grid = 256;
    }
    if (grid < 0) return;
#ifdef DIAG_POISON_WS
    (void)hipMemsetAsync((unsigned char*)d_ws, 0xAA, WS_END, stream);
#endif
    Params p{};
    for (int i = 0; i < 21; ++i) p.in[i] = (const float*)d_in[i];
    p.out = (float*)d_out; p.ws = (unsigned char*)d_ws;
#if MK_MULTI
    for (int ph = 0; ph < 7; ++ph) { p.ph_lo = ph; p.ph_hi = ph + 1; hipLaunchKernelGGL(fwd_megakernel, dim3(grid), dim3(NTHR), LDS_BYTES, stream, p); }
#else
#ifdef DBG_STOP
    p.ph_lo = 0; p.ph_hi = DBG_STOP + 1;
#else
    p.ph_lo = 0; p.ph_hi = 7;
#endif
    (void)hipMemsetAsync(d_ws, 0, 32768, stream);
    void* args[] = {&p};
    hipError_t e = hipLaunchCooperativeKernel((const void*)fwd_megakernel, dim3(grid), dim3(NTHR), args, LDS_BYTES, stream);
    if (e != hipSuccess) fprintf(stderr, "cooperative launch failed: %s (grid %d)\n", hipGetErrorString(e), grid);
#endif
}
```

```cpp
#include <hip/hip_runtime.h>
#include <hip/hip_cooperative_groups.h>
#include <cstdio>
#include <cstdint>
namespace cg = cooperative_groups;

#ifndef MK_MULTI
#define MK_MULTI 0
#endif

#define LAS __attribute__((address_space(3)))
typedef unsigned short bf16_t;
typedef short bf16x8 __attribute__((ext_vector_type(8)));
typedef float f32x4 __attribute__((ext_vector_type(4)));
typedef float f32x2 __attribute__((ext_vector_type(2)));
typedef unsigned u32x4 __attribute__((ext_vector_type(4)));
typedef unsigned u32x2 __attribute__((ext_vector_type(2)));

typedef __bf16 bf16x2_t __attribute__((ext_vector_type(2)));
__device__ __forceinline__ unsigned cvt_pk_bf16(float lo, float hi) { const f32x2 v = {lo, hi}; const bf16x2_t b = __builtin_convertvector(v, bf16x2_t); return __builtin_bit_cast(unsigned, b); }
__device__ __forceinline__ float bf_lo(unsigned w) { return __uint_as_float(w << 16); }
__device__ __forceinline__ float bf_hi(unsigned w) { return __uint_as_float(w & 0xffff0000u); }
__device__ __forceinline__ float gelu_tanh(float x) {
    const float t = x * (1.0f + 0.044715f * x * x);
    const float e = __builtin_amdgcn_exp2f(-2.3022081984f * t);
    return x * __builtin_amdgcn_rcpf(1.0f + e);
}
__device__ __forceinline__ float sigmoid_f(float x) { return __builtin_amdgcn_rcpf(1.0f + __builtin_amdgcn_exp2f(-1.4426950409f * x)); }

namespace pg8 {
constexpr int BM = 256, BK = 64, HALF = 128, HTB = HALF * BK * 2, STAGE_BYTES = 8 * HTB, NXCD = 8, WGM = 8;
__host__ __device__ __forceinline__ int lds_byte(int r, int c) { const int st = (r >> 4) * 2 + (c >> 5), rr = r & 15, cc = c & 31, ob = rr * 64 + cc * 2; return st * 1024 + (ob ^ (((ob >> 9) & 1) << 5)); }
__host__ __device__ __forceinline__ void stage_rc(int b, int& R, int& C) { const int st = b / 1024, sb = b % 1024, swz = sb ^ (((sb >> 9) & 1) << 5); R = (st >> 1) * 16 + swz / 64; C = (st & 1) * 32 + (swz % 64) / 2; }
__host__ __device__ __forceinline__ int perm32(int rho) { const int n = rho >> 4, i = rho & 15; return 8 * (i >> 2) + 4 * n + (i & 3); }

struct Unit { int pm, pn; };
struct Gemm { const bf16_t* A; const bf16_t* Bt; int lda, ldb, K; };

struct StaticOrder {
    int nM, nN, nwg, G, c;
    __device__ void init(int M, int N, int G_, int c_) { nM = M / BM; nN = N / BM; nwg = nM * nN; G = G_; c = c_; }
    __device__ bool next(int i, Unit& u) const {
        const long L = (long)i * G + c; if (L >= nwg) return false;
        int wgid = (int)L; { const int q = nwg / NXCD, r = nwg % NXCD, xcd = wgid % NXCD, off = wgid / NXCD; wgid = (xcd < r ? xcd * (q + 1) : r * (q + 1) + (xcd - r) * q) + off; }
        const int nig = WGM * nN, gid = wgid / nig, fm = gid * WGM, gsz = (nM - fm) < WGM ? (nM - fm) : WGM;
        u.pm = fm + ((wgid % nig) % gsz); u.pn = (wgid % nig) / gsz; return true;
    }
};
struct GroupOrder {
    int G, c;
    __device__ void init(int G_, int c_) { G = G_; c = c_; }
    __device__ bool next(int i, Unit& u) const {
        const int L = i * G + c; if (L >= 256) return false;
        const int Lr = (L & 7) * 32 + (L >> 3); u.pm = Lr; u.pn = Lr >> 2; return true;
    }
};

struct OneUnit { int pm, pn; __device__ bool next(int i, Unit& u) const { if (i != 0) return false; u.pm = pm; u.pn = pn; return true; } };

template <class Epi, class Sched, bool ALIGN_EPI>
__device__ __forceinline__ void gemm_phase(LAS unsigned char* lds, const Gemm g, const Sched& S, const Epi& E) {
    const int tid = threadIdx.x, wid = __builtin_amdgcn_readfirstlane(tid >> 6), lane = tid & 63, wr = wid >> 2, wc = wid & 3, fr = lane & 15, fq = lane >> 4;
    int nt = g.K / BK; asm volatile("" : "+s"(nt));
    unsigned voffA[2], voffB[2];
#pragma unroll
    for (int i = 0; i < 2; ++i) { int R, C; stage_rc(tid * 16 + i * 8192, R, C); const int Rb = Epi::PERM ? ((R & ~31) + perm32(R & 31)) : R;
        voffA[i] = (unsigned)(R * g.lda + C) * 2u; voffB[i] = (unsigned)(Rb * g.ldb + C) * 2u; }
    const size_t kstep = (size_t)(BK * 2);
    const size_t hstepA = (size_t)HALF * g.lda * 2, hstepB = (size_t)HALF * g.ldb * 2;
    const size_t tstepA = 2 * hstepA, tstepB = 2 * hstepB;
    const unsigned ldsw = (unsigned)wid * 1024u;
    const int aoff = lds_byte(wr * 64 + fr, fq * 8), boff = lds_byte(wc * 32 + fr, fq * 8);
#define PG8_SA(b, h) (((b) * 2 + (h)) * HTB)
#define PG8_SB(b, h) ((4 + (b) * 2 + (h)) * HTB)
#define PG8_STAGE(bufoff, gbase, voff) do { _Pragma("unroll") for (int _i = 0; _i < 2; ++_i) \
        __builtin_amdgcn_global_load_lds((const unsigned*)((const char*)(gbase) + (voff)[_i]), (LAS unsigned*)(lds + (bufoff) + ldsw + _i * 8192), 16, 0, 0); } while (0)
#define PG8_LDA(dst, b, h) do { _Pragma("unroll") for (int m = 0; m < 4; ++m) _Pragma("unroll") for (int k = 0; k < 2; ++k) dst[m][k] = *(const LAS bf16x8*)(lds + PG8_SA(b, h) + aoff + m * 2048 + k * 1024); } while (0)
#define PG8_LDB(dst, b, h) do { _Pragma("unroll") for (int n = 0; n < 2; ++n) _Pragma("unroll") for (int k = 0; k < 2; ++k) dst[n][k] = *(const LAS bf16x8*)(lds + PG8_SB(b, h) + boff + n * 2048 + k * 1024); } while (0)
#define PG8_MMA(ai, bj, At, Bt) do { __builtin_amdgcn_s_setprio(1); _Pragma("unroll") for (int m = 0; m < 4; ++m) _Pragma("unroll") for (int n = 0; n < 2; ++n) _Pragma("unroll") for (int k = 0; k < 2; ++k) \
        acc[ai][bj][m][n] = __builtin_amdgcn_mfma_f32_16x16x32_bf16(Bt[n][k], At[m][k], acc[ai][bj][m][n], 0, 0, 0); __builtin_amdgcn_s_setprio(0); } while (0)
#define PG8_WAIT_V(n) asm volatile("s_waitcnt vmcnt(" #n ")" ::: "memory")
#define PG8_WAIT_L(n) asm volatile("s_waitcnt lgkmcnt(" #n ")" ::: "memory")
#define PG8_BAR __builtin_amdgcn_s_barrier()
#define PG8_SCHED __builtin_amdgcn_sched_barrier(0)
    Unit cur, nxt; int ui = 0;
    if (!S.next(0, cur)) return;
    f32x4 acc[2][2][4][2];
#pragma unroll
    for (int a = 0; a < 2; ++a)
#pragma unroll
        for (int b = 0; b < 2; ++b)
#pragma unroll
            for (int m = 0; m < 4; ++m)
#pragma unroll
                for (int n = 0; n < 2; ++n) acc[a][b][m][n] = (f32x4){0.f, 0.f, 0.f, 0.f};
    bf16x8 At[4][2], B0[2][2], B1[2][2];
    const char* cA = (const char*)g.A + (size_t)cur.pm * tstepA; const char* cB = (const char*)g.Bt + (size_t)cur.pn * tstepB;
    PG8_STAGE(PG8_SB(0, 0), cB, voffB); PG8_STAGE(PG8_SB(0, 1), cB + hstepB, voffB); PG8_STAGE(PG8_SA(0, 0), cA, voffA); PG8_STAGE(PG8_SA(0, 1), cA + hstepA, voffA);
    if (wr == 1) PG8_BAR;
    PG8_WAIT_V(2); PG8_BAR;
    PG8_STAGE(PG8_SB(1, 0), cB + kstep, voffB); PG8_STAGE(PG8_SA(1, 0), cA + kstep, voffA); PG8_STAGE(PG8_SB(1, 1), cB + hstepB + kstep, voffB);
    PG8_WAIT_V(6); PG8_BAR;
    for (;;) {
        const bool has_next = S.next(ui + 1, nxt);
        const char* nA = has_next ? (const char*)g.A + (size_t)nxt.pm * tstepA : cA; const char* nB = has_next ? (const char*)g.Bt + (size_t)nxt.pn * tstepB : cB;
#pragma nounroll
        for (int t = 0; t < nt; t += 2) {
            const bool last = (t == nt - 2);
            const char* a1 = cA + (size_t)(t + 1) * kstep;
            const char* a2 = last ? nA : cA + (size_t)(t + 2) * kstep; const char* b2 = last ? nB : cB + (size_t)(t + 2) * kstep;
            const char* a3 = a2 + kstep; const char* b3 = b2 + kstep;
            if constexpr (Epi::HAS_MID) { if (t == (nt >> 1)) E.mid(acc, ui, wr, fr); }
            PG8_LDB(B0, 0, 0); PG8_LDB(B1, 0, 1); PG8_SCHED; PG8_LDA(At, 0, 0); PG8_STAGE(PG8_SA(1, 1), a1 + hstepA, voffA);
            PG8_WAIT_V(8); PG8_WAIT_L(0); PG8_BAR; PG8_MMA(0, 0, At, B0); PG8_MMA(0, 1, At, B1); PG8_BAR; PG8_SCHED;
            PG8_LDA(At, 0, 1); PG8_STAGE(PG8_SB(0, 0), b2, voffB); PG8_STAGE(PG8_SB(0, 1), b2 + hstepB, voffB); PG8_STAGE(PG8_SA(0, 0), a2, voffA);
            PG8_WAIT_V(8); PG8_WAIT_L(0); PG8_BAR; PG8_MMA(1, 0, At, B0); PG8_MMA(1, 1, At, B1); PG8_BAR; PG8_SCHED;
            PG8_LDB(B0, 1, 0); PG8_LDB(B1, 1, 1); PG8_SCHED; PG8_LDA(At, 1, 0); PG8_STAGE(PG8_SA(0, 1), a2 + hstepA, voffA);
            PG8_WAIT_V(8); PG8_WAIT_L(0); PG8_BAR; PG8_MMA(0, 0, At, B0); PG8_MMA(0, 1, At, B1); PG8_BAR; PG8_SCHED;
            PG8_LDA(At, 1, 1); PG8_STAGE(PG8_SB(1, 0), b3, voffB); PG8_STAGE(PG8_SB(1, 1), b3 + hstepB, voffB); PG8_STAGE(PG8_SA(1, 0), a3, voffA);
            PG8_WAIT_V(8); PG8_WAIT_L(0); PG8_BAR; PG8_MMA(1, 0, At, B0); PG8_MMA(1, 1, At, B1); PG8_BAR; PG8_SCHED;
        }
        if constexpr (ALIGN_EPI) { if (wr == 0) PG8_BAR; }
        if constexpr (!Epi::AFTER_DRAIN) E(acc, cur, ui, wr, wc, fr, fq);
        if (!has_next) break;
#pragma unroll
        for (int a = 0; a < 2; ++a)
#pragma unroll
            for (int b = 0; b < 2; ++b)
#pragma unroll
                for (int m = 0; m < 4; ++m)
#pragma unroll
                    for (int n = 0; n < 2; ++n) acc[a][b][m][n] = (f32x4){0.f, 0.f, 0.f, 0.f};
        cur = nxt; cA = nA; cB = nB; ++ui;
        if constexpr (ALIGN_EPI) { if (wr == 1) PG8_BAR; }
    }
    PG8_WAIT_V(0);
    if constexpr (!ALIGN_EPI) { if (wr == 0) PG8_BAR; }
    PG8_BAR;
    if constexpr (Epi::AFTER_DRAIN) E.after(acc, cur, wr, wc, fr, fq, lds);
#undef PG8_SA
#undef PG8_SB
#undef PG8_STAGE
#undef PG8_LDA
#undef PG8_LDB
#undef PG8_MMA
#undef PG8_WAIT_V
#undef PG8_WAIT_L
#undef PG8_BAR
#undef PG8_SCHED
}
}
using pg8::Unit;

constexpr int BATCH = 8, SEQ = 2048, DM = 2048, M = BATCH * SEQ;
constexpr int DSSM = 1024, DSGU = 1024, DIN = 4096, DFF = 8192;
constexpr int LDH = DFF + 64;
constexpr int NG = 64, GS = 16, NS = 64;
constexpr int LC = 16, NCH = SEQ / LC;
constexpr int KA = LC * GS + 2 * NS;
constexpr float EPS = 1e-5f;
constexpr int NWAVES = 8, NTHR = 512;

constexpr size_t MiB = 1u << 20;
constexpr size_t WS_WIN = 1 * MiB, WS_WOUT = 17 * MiB, WS_W1 = 25 * MiB, WS_W2 = 57 * MiB;
constexpr size_t WS_TME = 89 * MiB;
constexpr size_t WS_FT = 101 * MiB;
constexpr size_t WS_A16 = 109 * MiB;
constexpr size_t WS_PV = 110 * MiB;
constexpr size_t WS_PA = 111 * MiB;
constexpr size_t WS_PB = 115 * MiB;
constexpr size_t WS_P2 = 116 * MiB;
constexpr size_t WS_P3 = 118 * MiB;
constexpr size_t WS_H1B = 120 * MiB;
constexpr size_t WS_R1 = 184 * MiB;
constexpr size_t WS_XN = WS_R1;
constexpr size_t WS_S = WS_R1;
constexpr size_t WS_Y = WS_R1 + 64 * MiB;
constexpr size_t WS_AP = WS_R1 + 128 * MiB;
constexpr size_t WS_SG = WS_R1 + 176 * MiB;
constexpr size_t WS_UB = WS_R1 + 208 * MiB;
constexpr size_t WS_VB = WS_R1 + 240 * MiB;
constexpr size_t WS_HID = WS_R1;
constexpr size_t WS_W2P = WS_R1 + 272 * MiB;
constexpr size_t WS_END = WS_W2P + 33 * MiB;

constexpr int RING_BYTES = 131072, TAB_OFF = RING_BYTES, TAB_BYTES = 16384, MISC_OFF = TAB_OFF + TAB_BYTES, LDS_BYTES = MISC_OFF + 256;

struct EpiProj {
    static constexpr bool PERM = true, HAS_MID = false, AFTER_DRAIN = false;
    bf16_t *Ap, *SG, *UB, *VB; float* PV;
    template <int SECT> __device__ __forceinline__ void body(const f32x4 (&acc)[2][2][4][2], const Unit& u, int wr, int wc, int fr, int fq) const {
        const int colt = (u.pn & 3) * 256 + wc * 32 + 8 * fq;
        const int row0 = u.pm * 256 + wr * 64 + fr;
#pragma unroll
        for (int ai = 0; ai < 2; ++ai)
#pragma unroll
            for (int m = 0; m < 4; ++m) {
                const int row = row0 + ai * 128 + m * 16; float ss = 0.f;
#pragma unroll
                for (int bj = 0; bj < 2; ++bj) {
                    const int col8 = colt + bj * 128;
                    f32x4 v0 = acc[ai][bj][m][0], v1 = acc[ai][bj][m][1];
                    if (SECT == 1) {
#pragma unroll
                        for (int j = 0; j < 4; ++j) { v0[j] = sigmoid_f(v0[j]); v1[j] = sigmoid_f(v1[j]); }
                    }
                    if (SECT >= 2) {
#pragma unroll
                        for (int j = 0; j < 4; ++j) { v0[j] = gelu_tanh(v0[j]); v1[j] = gelu_tanh(v1[j]); }
                    }
                    if (SECT == 3) ss += (v0[0] * v0[0] + v0[1] * v0[1]) + (v0[2] * v0[2] + v0[3] * v0[3]) + (v1[0] * v1[0] + v1[1] * v1[1]) + (v1[2] * v1[2] + v1[3] * v1[3]);
                    u32x4 w; w.x = cvt_pk_bf16(v0[0], v0[1]); w.y = cvt_pk_bf16(v0[2], v0[3]); w.z = cvt_pk_bf16(v1[0], v1[1]); w.w = cvt_pk_bf16(v1[2], v1[3]);
                    bf16_t* dst;
                    if (SECT == 0) dst = Ap + ((size_t)((col8 >> 4) * 1024 + (row >> 4)) * KA + (row & 15) * 16 + (col8 & 15));
                    else if (SECT == 1) dst = SG + (size_t)row * 1024 + col8;
                    else if (SECT == 2) dst = UB + (size_t)row * 1024 + col8;
                    else dst = VB + (size_t)row * 1024 + col8;
                    *(u32x4*)dst = w;
                }
                if (SECT == 3) { ss += __shfl_xor(ss, 16); ss += __shfl_xor(ss, 32); if (fq == 0) PV[(size_t)row * 16 + (u.pn & 3) * 4 + wc] = ss; }
            }
    }
    __device__ __forceinline__ void operator()(const f32x4 (&acc)[2][2][4][2], const Unit& u, int ui, int wr, int wc, int fr, int fq) const {
        const int sect = u.pn >> 2;
        if (sect == 0) body<0>(acc, u, wr, wc, fr, fq); else if (sect == 1) body<1>(acc, u, wr, wc, fr, fq);
        else if (sect == 2) body<2>(acc, u, wr, wc, fr, fq); else body<3>(acc, u, wr, wc, fr, fq);
    }
};
struct EpiS {
    static constexpr bool PERM = false, HAS_MID = false, AFTER_DRAIN = true;
    __device__ __forceinline__ void operator()(const f32x4 (&acc)[2][2][4][2], const Unit& u, int ui, int wr, int wc, int fr, int fq) const {}
    __device__ __forceinline__ void after(const f32x4 (&acc)[2][2][4][2], const Unit& u, int wr, int wc, int fr, int fq, LAS unsigned char* lds) const {
        LAS float* S = (LAS float*)lds; const int row0 = wr * 64 + fr, col0 = wc * 32 + 4 * fq;
#pragma unroll
        for (int ai = 0; ai < 2; ++ai)
#pragma unroll
            for (int m = 0; m < 4; ++m) { LAS float* rp = S + (row0 + ai * 128 + m * 16) * 132 + col0;
#pragma unroll
                for (int n = 0; n < 2; ++n) *(LAS f32x4*)(rp + n * 16) = acc[ai][0][m][n]; }
    }
};
struct EpiSsm {
    static constexpr bool PERM = true, HAS_MID = false, AFTER_DRAIN = false;
    const bf16_t *Ap, *SG; const float* dsk; bf16_t* Y; float* PA;
    __device__ __forceinline__ void operator()(const f32x4 (&acc)[2][2][4][2], const Unit& u, int ui, int wr, int wc, int fr, int fq) const {
        asm volatile("" : "+v"(fr), "+v"(fq));
        const int g = u.pn;
#pragma unroll
        for (int bj = 0; bj < 2; ++bj) {
            const int col8 = bj * 128 + wc * 32 + 8 * fq, t = col8 >> 4, hh = col8 & 15, ch = g * 16 + hh;
            const f32x4 d0 = *(const f32x4*)(dsk + ch), d1 = *(const f32x4*)(dsk + ch + 4);
#pragma unroll
            for (int ai = 0; ai < 2; ++ai)
#pragma unroll
                for (int m = 0; m < 4; ++m) {
                    const int R = u.pm * 256 + ai * 128 + wr * 64 + m * 16 + fr, rg = R & 1023, token = (rg >> 7) * SEQ + (rg & 127) * LC + t;
                    const u32x4 uu = *(const u32x4*)(Ap + (size_t)R * KA + t * 16 + hh);
                    const u32x4 sg = *(const u32x4*)(SG + (size_t)token * 1024 + ch);
                    const f32x4 a0 = acc[ai][bj][m][0], a1 = acc[ai][bj][m][1];
                    float o[8];
                    o[0] = gelu_tanh(a0[0] + d0[0] * bf_lo(uu.x)) * bf_lo(sg.x); o[1] = gelu_tanh(a0[1] + d0[1] * bf_hi(uu.x)) * bf_hi(sg.x);
                    o[2] = gelu_tanh(a0[2] + d0[2] * bf_lo(uu.y)) * bf_lo(sg.y); o[3] = gelu_tanh(a0[3] + d0[3] * bf_hi(uu.y)) * bf_hi(sg.y);
                    o[4] = gelu_tanh(a1[0] + d1[0] * bf_lo(uu.z)) * bf_lo(sg.z); o[5] = gelu_tanh(a1[1] + d1[1] * bf_hi(uu.z)) * bf_hi(sg.z);
                    o[6] = gelu_tanh(a1[2] + d1[2] * bf_lo(uu.w)) * bf_lo(sg.w); o[7] = gelu_tanh(a1[3] + d1[3] * bf_hi(uu.w)) * bf_hi(sg.w);
                    float ss = (o[0] * o[0] + o[1] * o[1]) + (o[2] * o[2] + o[3] * o[3]) + (o[4] * o[4] + o[5] * o[5]) + (o[6] * o[6] + o[7] * o[7]);
                    u32x4 w; w.x = cvt_pk_bf16(o[0], o[1]); w.y = cvt_pk_bf16(o[2], o[3]); w.z = cvt_pk_bf16(o[4], o[5]); w.w = cvt_pk_bf16(o[6], o[7]);
                    *(u32x4*)(Y + (size_t)token * DM + ch) = w;
                    ss += __shfl_xor(ss, 16);
                    if ((fq & 1) == 0) PA[(size_t)token * 64 + g] = ss;
                    asm volatile("" ::: "memory"); __builtin_amdgcn_sched_barrier(0);
                }
        }
    }
};
struct EpiOut {
    static constexpr bool PERM = true, HAS_MID = true, AFTER_DRAIN = false;
    const float* x; bf16_t* H1B; float* P2; const LAS f32x2* tab;
    __device__ __forceinline__ void mid(f32x4 (&acc)[2][2][4][2], int ui, int wr, int fr) const {
#pragma unroll
        for (int ai = 0; ai < 2; ++ai)
#pragma unroll
            for (int m = 0; m < 4; ++m) { const float s = tab[ui * 256 + ai * 128 + wr * 64 + m * 16 + fr].x;
#pragma unroll
                for (int bj = 0; bj < 2; ++bj)
#pragma unroll
                    for (int n = 0; n < 2; ++n) acc[ai][bj][m][n] *= s; }
    }
    __device__ __forceinline__ void operator()(const f32x4 (&acc)[2][2][4][2], const Unit& u, int ui, int wr, int wc, int fr, int fq) const {
        asm volatile("" : "+v"(fr), "+v"(fq));
        const int colw = u.pn * 256 + wc * 32 + 8 * fq;
#pragma unroll
        for (int ai = 0; ai < 2; ++ai) {
            f32x4 xr[4][2][2];
#pragma unroll
            for (int m = 0; m < 4; ++m) { const float* xp = x + (size_t)(u.pm * 256 + ai * 128 + wr * 64 + m * 16 + fr) * DM + colw;
#pragma unroll
                for (int bj = 0; bj < 2; ++bj) { xr[m][bj][0] = *(const f32x4*)(xp + bj * 128); xr[m][bj][1] = *(const f32x4*)(xp + bj * 128 + 4); } }
#pragma unroll
            for (int m = 0; m < 4; ++m) {
                const int rl = ai * 128 + wr * 64 + m * 16 + fr, row = u.pm * 256 + rl; const float rb = tab[ui * 256 + rl].y; float ss = 0.f;
#pragma unroll
                for (int bj = 0; bj < 2; ++bj) {
                    const size_t off = (size_t)row * DM + colw + bj * 128;
                    const f32x4 h0 = xr[m][bj][0] + acc[ai][bj][m][0] * rb, hv1 = xr[m][bj][1] + acc[ai][bj][m][1] * rb;
                    ss += (h0[0] * h0[0] + h0[1] * h0[1]) + (h0[2] * h0[2] + h0[3] * h0[3]) + (hv1[0] * hv1[0] + hv1[1] * hv1[1]) + (hv1[2] * hv1[2] + hv1[3] * hv1[3]);
                    u32x4 w; w.x = cvt_pk_bf16(h0[0], h0[1]); w.y = cvt_pk_bf16(h0[2], h0[3]); w.z = cvt_pk_bf16(hv1[0], hv1[1]); w.w = cvt_pk_bf16(hv1[2], hv1[3]);
                    *(u32x4*)(H1B + off) = w;
                }
                ss += __shfl_xor(ss, 16); ss += __shfl_xor(ss, 32);
                if (fq == 0) P2[(size_t)row * 32 + u.pn * 4 + wc] = ss;
            }
            asm volatile("" ::: "memory");
        }
    }
};
struct EpiFF1 {
    static constexpr bool PERM = true, HAS_MID = false, AFTER_DRAIN = false;
    bf16_t* HID; const LAS float* tab;
    __device__ __forceinline__ void operator()(const f32x4 (&acc)[2][2][4][2], const Unit& u, int ui, int wr, int wc, int fr, int fq) const {
#pragma unroll
        for (int ai = 0; ai < 2; ++ai)
#pragma unroll
            for (int m = 0; m < 4; ++m) {
                const int rl = ai * 128 + wr * 64 + m * 16 + fr, row = u.pm * 256 + rl; const float r2 = tab[ui * 256 + rl];
#pragma unroll
                for (int bj = 0; bj < 2; ++bj) {
                    f32x4 v0 = acc[ai][bj][m][0] * r2, v1 = acc[ai][bj][m][1] * r2;
#pragma unroll
                    for (int j = 0; j < 4; ++j) { const float a = fmaxf(v0[j], 0.f), b = fmaxf(v1[j], 0.f); v0[j] = a * a; v1[j] = b * b; }
                    u32x4 w; w.x = cvt_pk_bf16(v0[0], v0[1]); w.y = cvt_pk_bf16(v0[2], v0[3]); w.z = cvt_pk_bf16(v1[0], v1[1]); w.w = cvt_pk_bf16(v1[2], v1[3]);
                    *(u32x4*)(HID + (size_t)row * LDH + u.pn * 256 + bj * 128 + wc * 32 + 8 * fq) = w;
                }
            }
    }
};
struct EpiFF2 {
    static constexpr bool PERM = true, HAS_MID = false, AFTER_DRAIN = false;
    bf16_t* h; float* P3;
    __device__ __forceinline__ void operator()(const f32x4 (&acc)[2][2][4][2], const Unit& u, int ui, int wr, int wc, int fr, int fq) const {
#pragma unroll
        for (int ai = 0; ai < 2; ++ai)
#pragma unroll
            for (int m = 0; m < 4; ++m) {
                const int row = u.pm * 256 + ai * 128 + wr * 64 + m * 16 + fr; float ss = 0.f;
#pragma unroll
                for (int bj = 0; bj < 2; ++bj) {
                    const size_t off = (size_t)row * DM + u.pn * 256 + bj * 128 + wc * 32 + 8 * fq;
                    const u32x4 hb = *(const u32x4*)(h + off); const f32x4 a0 = acc[ai][bj][m][0], a1 = acc[ai][bj][m][1];
                    const float o0 = bf_lo(hb.x) + a0[0], o1 = bf_hi(hb.x) + a0[1], o2 = bf_lo(hb.y) + a0[2], o3 = bf_hi(hb.y) + a0[3];
                    const float o4 = bf_lo(hb.z) + a1[0], o5 = bf_hi(hb.z) + a1[1], o6 = bf_lo(hb.w) + a1[2], o7 = bf_hi(hb.w) + a1[3];
                    ss += (o0 * o0 + o1 * o1) + (o2 * o2 + o3 * o3) + (o4 * o4 + o5 * o5) + (o6 * o6 + o7 * o7);
                    u32x4 w; w.x = cvt_pk_bf16(o0, o1); w.y = cvt_pk_bf16(o2, o3); w.z = cvt_pk_bf16(o4, o5); w.w = cvt_pk_bf16(o6, o7);
                    *(u32x4*)(h + off) = w;
                }
                ss += __shfl_xor(ss, 16); ss += __shfl_xor(ss, 32);
                if (fq == 0) P3[(size_t)row * 32 + u.pn * 4 + wc] = ss;
            }
    }
};

struct PanelOrder {
    int c;
    __device__ bool next(int i, Unit& u) const { if (i >= 2) return false; const int x = c & 7, j = c >> 3; u.pm = i * 32 + x * 4 + (j >> 3); u.pn = j & 7; return true; }
};
struct EpiFF2N {
    static constexpr bool PERM = true, HAS_MID = false, AFTER_DRAIN = false;
    const bf16_t* h1; float* out; const float* gain; float* P3; unsigned* cnt;
    __device__ __forceinline__ void operator()(f32x4 (&acc)[2][2][4][2], const Unit& u, int ui, int wr, int wc, int fr, int fq) const {
        asm volatile("" : "+v"(fr), "+v"(fq));
        const int colw = u.pn * 256 + wc * 32 + 8 * fq;
#pragma unroll
        for (int ai = 0; ai < 2; ++ai)
#pragma unroll
            for (int m = 0; m < 4; ++m) {
                const int row = u.pm * 256 + ai * 128 + wr * 64 + m * 16 + fr; float ss = 0.f;
#pragma unroll
                for (int bj = 0; bj < 2; ++bj) {
                    const u32x4 hb = *(const u32x4*)(h1 + (size_t)row * DM + colw + bj * 128);
                    f32x4& a0 = acc[ai][bj][m][0]; f32x4& a1 = acc[ai][bj][m][1];
                    a0[0] += bf_lo(hb.x); a0[1] += bf_hi(hb.x); a0[2] += bf_lo(hb.y); a0[3] += bf_hi(hb.y);
                    a1[0] += bf_lo(hb.z); a1[1] += bf_hi(hb.z); a1[2] += bf_lo(hb.w); a1[3] += bf_hi(hb.w);
                    ss += (a0[0] * a0[0] + a0[1] * a0[1]) + (a0[2] * a0[2] + a0[3] * a0[3]) + (a1[0] * a1[0] + a1[1] * a1[1]) + (a1[2] * a1[2] + a1[3] * a1[3]);
                }
                ss += __shfl_xor(ss, 16); ss += __shfl_xor(ss, 32);
                if (fq == 0) __hip_atomic_store(P3 + (size_t)row * 32 + u.pn * 4 + wc, ss, __ATOMIC_RELAXED, __HIP_MEMORY_SCOPE_AGENT);
            }
        asm volatile("s_waitcnt vmcnt(0)" ::: "memory");
        unsigned* cp = cnt + 64 * u.pm;
        if ((fr | fq) == 0) __hip_atomic_fetch_add(cp, 1u, __ATOMIC_RELAXED, __HIP_MEMORY_SCOPE_AGENT);
        { unsigned sp = 0;
          while ((unsigned)__builtin_amdgcn_readfirstlane(__hip_atomic_load(cp, __ATOMIC_RELAXED, __HIP_MEMORY_SCOPE_AGENT)) < 64u) { __builtin_amdgcn_s_sleep(2); if (++sp > (1u << 22)) break; } }
        __builtin_amdgcn_fence(__ATOMIC_ACQUIRE, "agent");
        f32x4 g[2][2];
#pragma unroll
        for (int bj = 0; bj < 2; ++bj) { g[bj][0] = *(const f32x4*)(gain + colw + bj * 128); g[bj][1] = *(const f32x4*)(gain + colw + bj * 128 + 4); }
#pragma unroll
        for (int ai = 0; ai < 2; ++ai)
#pragma unroll
            for (int m = 0; m < 4; ++m) {
                const int row = u.pm * 256 + ai * 128 + wr * 64 + m * 16 + fr;
                const unsigned long long* pr = (const unsigned long long*)(P3 + (size_t)row * 32 + fq * 8); float s = 0.f;
#pragma unroll
                for (int k = 0; k < 4; ++k) { const unsigned long long w = __hip_atomic_load(pr + k, __ATOMIC_RELAXED, __HIP_MEMORY_SCOPE_AGENT); s += __uint_as_float((unsigned)w) + __uint_as_float((unsigned)(w >> 32)); }
                s += __shfl_xor(s, 16); s += __shfl_xor(s, 32);
                const float r = 1.0f / sqrtf(s * (1.0f / DM) + EPS);
#pragma unroll
                for (int bj = 0; bj < 2; ++bj) { float* op = out + (size_t)row * DM + colw + bj * 128;
                    *(f32x4*)op = acc[ai][bj][m][0] * r * g[bj][0]; *(f32x4*)(op + 4) = acc[ai][bj][m][1] * r * g[bj][1]; }
                asm volatile("" ::: "memory");
            }
    }
};

__device__ __forceinline__ float wave_sum(float v) {
#pragma unroll
    for (int o = 1; o < 64; o <<= 1) v += __shfl_xor(v, o);
    return v;
}
__device__ __forceinline__ void p0_transpose_item(const float* W, int K, int N, bf16_t* WT, const float* gain, const float* gain_hi, LAS float* scr, int item, int lane, int ldw = 0) {
    if (ldw == 0) ldw = K;
    const int nblk = N / 32, kb = item / nblk, nb = item % nblk, k0 = 64 * kb, n0 = 32 * nb;
    const float* gk = gain ? ((gain_hi && k0 >= 1024) ? gain_hi + (k0 - 1024) : gain + k0) : nullptr;
    float wv[32];
#pragma unroll
    for (int i = 0; i < 32; ++i) wv[i] = W[(size_t)(k0 + 2 * i + (lane >> 5)) * N + n0 + (lane & 31)];
#pragma unroll
    for (int i = 0; i < 32; ++i) { const int kk = 2 * i + (lane >> 5); float v = wv[i]; if (gk) v *= gk[kk]; scr[kk * 33 + (lane & 31)] = v; }
    asm volatile("s_waitcnt lgkmcnt(0)" ::: "memory");
    const int c = lane & 7;
#pragma unroll
    for (int j = 0; j < 4; ++j) { const int n = (lane >> 3) + 8 * j; const LAS float* s = scr + (8 * c) * 33 + n;
        u32x4 o; o.x = cvt_pk_bf16(s[0 * 33], s[1 * 33]); o.y = cvt_pk_bf16(s[2 * 33], s[3 * 33]); o.z = cvt_pk_bf16(s[4 * 33], s[5 * 33]); o.w = cvt_pk_bf16(s[6 * 33], s[7 * 33]);
        *(u32x4*)(WT + (size_t)(n0 + n) * ldw + k0 + 8 * c) = o; }
    asm volatile("s_waitcnt lgkmcnt(0)" ::: "memory");
}
__device__ __forceinline__ f32x2 cpow_k(float lre, float lim, float dt, int k) {
    const float mag = expf((float)k * lre * dt);
    const double rev = (double)k * (double)lim * (double)dt * 0.15915494309189535;
    const float fr = (float)(rev - rint(rev));
    return (f32x2){mag * __builtin_amdgcn_cosf(fr), mag * __builtin_amdgcn_sinf(fr)};
}

#define RLX_AGENT __ATOMIC_RELAXED, __HIP_MEMORY_SCOPE_AGENT
#define XB_TMO      128
#define XB_XCNT(j)  (256  + 64 * (j))
#define XB_XSUB(j)  (1280 + 64 * (j))
#define XB_XGEN(j)  (2304 + 64 * (j))
#define XB_TOP      3328
#define XB_TOPGEN   3392
#define XCD_BAR_WORDS 3456
#define XB_SPIN_CAP (1u << 22)
__device__ __forceinline__ unsigned xb_ld(unsigned* p)              { return __hip_atomic_load(p, __ATOMIC_RELAXED, __HIP_MEMORY_SCOPE_AGENT); }
__device__ __forceinline__ unsigned xb_add(unsigned* p, unsigned v) { return __hip_atomic_fetch_add(p, v, __ATOMIC_RELAXED, __HIP_MEMORY_SCOPE_AGENT); }
__device__ __forceinline__ unsigned xb_xcc_id() { return (unsigned)__builtin_amdgcn_s_getreg((3 << 11) | 20) & 0xFu; }
#define XB_SPIN(cond, bar) do { unsigned _sp = 0; while (cond) { __builtin_amdgcn_s_sleep(1); \
    if ((++_sp & 255u) == 0u) { if (xb_ld(&(bar)[XB_TMO])) break; if (_sp > XB_SPIN_CAP) { atomicAdd(&(bar)[XB_TMO], 1u); break; } } } } while (0)
struct XcdBarrier { unsigned* bar; unsigned x; volatile LAS unsigned* st; };
__device__ __forceinline__ XcdBarrier xcd_barrier_post(unsigned* bar, volatile LAS unsigned* st) {
    XcdBarrier b; b.bar = bar; b.x = xb_xcc_id(); b.st = st;
    if (threadIdx.x == 0) (void)xb_add(&bar[XB_XCNT(b.x)], 1u);
    return b;
}
__device__ __forceinline__ void xcd_barrier_complete(unsigned* bar, unsigned x, unsigned& nloc, unsigned& nx) {
    const unsigned G = gridDim.x * gridDim.y * gridDim.z;
    unsigned sum, cnt, mine, sp = 0u;
    for (;;) {
        sum = 0u; cnt = 0u; mine = 0u;
#pragma unroll
        for (unsigned j = 0; j < 16; ++j) { const unsigned c = xb_ld(&bar[XB_XCNT(j)]); sum += c; cnt += (c > 0u) ? 1u : 0u; mine = (j == x) ? c : mine; }
        if (sum == G) break;
        __builtin_amdgcn_s_sleep(1);
        if ((++sp & 255u) == 0u) { if (xb_ld(&bar[XB_TMO])) break; if (sp > XB_SPIN_CAP) { atomicAdd(&bar[XB_TMO], 1u); break; } }
    }
    nloc = mine > 0u ? mine : 1u; nx = cnt > 0u ? cnt : 1u;
}
__device__ __forceinline__ void xcd_barrier(const XcdBarrier& b) {
    asm volatile("s_waitcnt vmcnt(0)" ::: "memory");
    __syncthreads();
    if (threadIdx.x == 0) {
        unsigned* bar = b.bar;
        __builtin_amdgcn_s_waitcnt(0);
        unsigned nloc = b.st[0], nx = b.st[1];
        if (nloc == 0u) { xcd_barrier_complete(bar, b.x, nloc, nx); b.st[0] = nloc; b.st[1] = nx; }
        const unsigned old = xb_add(&bar[XB_XSUB(b.x)], 1u);
        const unsigned gen = old / nloc;
        if (old + 1u == (gen + 1u) * nloc) {
            __builtin_amdgcn_fence(__ATOMIC_RELEASE, "agent");
            asm volatile("s_waitcnt vmcnt(0)" ::: "memory");
            const unsigned og = xb_add(&bar[XB_TOP], 1u);
            const unsigned tg = og / nx;
            if (og + 1u == (tg + 1u) * nx) xb_add(&bar[XB_TOPGEN], 1u);
            else XB_SPIN(xb_ld(&bar[XB_TOPGEN]) == tg, bar);
            __builtin_amdgcn_fence(__ATOMIC_ACQUIRE, "agent");
            xb_add(&bar[XB_XGEN(b.x)], 1u);
            asm volatile("s_waitcnt vmcnt(0)" ::: "memory");
        } else {
            XB_SPIN(xb_ld(&bar[XB_XGEN(b.x)]) == gen, bar);
            __builtin_amdgcn_fence(__ATOMIC_ACQUIRE, "agent");
            asm volatile("s_waitcnt vmcnt(0)" ::: "memory");
        }
    }
    __syncthreads();
}

struct Params { const float* in[21]; float* out; unsigned char* ws; int ph_lo, ph_hi; };

__device__ __forceinline__ void p0_ssm_task(const Params& p, LAS unsigned char* lds, int g, int d, int tid) {
    LAS float* coef = (LAS float*)lds;
    LAS float* pd = coef + 128;
    LAS float* pd1 = pd + 128;
    LAS float* wre = pd1 + 128;
    LAS float* wim = wre + 1024;
    LAS float* cre = wim + 1024;
    LAS float* cim = cre + 1024;
    const float* a_re = p.in[2]; const float* a_im = p.in[3]; const float* log_dt = p.in[4];
    const float* b_re = p.in[5]; const float* b_im = p.in[6]; const float* c_re = p.in[7]; const float* c_im = p.in[8];
    bf16_t* TmE = (bf16_t*)(p.ws + WS_TME) + (size_t)g * 256 * KA;
    bf16_t* Ft = (bf16_t*)(p.ws + WS_FT) + (size_t)g * 256 * 256;
    if (tid < 64) {
        const int n = tid; const float dt = expf(log_dt[g]); const float lre = fminf(a_re[g * 64 + n], -1e-4f), lim = a_im[g * 64 + n];
        const f32x2 ab = cpow_k(lre, lim, dt, 1);
        const float den = lre * lre + lim * lim, nre = ab.x - 1.0f;
        coef[2 * n] = (nre * lre + ab.y * lim) / den; coef[2 * n + 1] = (ab.y * lre - nre * lim) / den;
        const f32x2 q = cpow_k(lre, lim, dt, d), q1 = cpow_k(lre, lim, dt, d + 1);
        pd[2 * n] = q.x; pd[2 * n + 1] = q.y; pd1[2 * n] = q1.x; pd1[2 * n + 1] = q1.y;
        if (d == 0) { const f32x2 q16 = cpow_k(lre, lim, dt, 16); *(f32x2*)((float*)(p.ws + WS_A16) + (size_t)(g * 64 + n) * 2) = q16; }
    }
    __syncthreads();
    for (int idx = tid; idx < 1024; idx += NTHR) {
        const int n = idx >> 4;
        const float br = b_re[(size_t)g * 1024 + idx], bi = b_im[(size_t)g * 1024 + idx], cr = coef[2 * n], ci = coef[2 * n + 1];
        const float bbr = cr * br - ci * bi, bbi = cr * bi + ci * br, pr = pd[2 * n], pi = pd[2 * n + 1];
        wre[idx] = pr * bbr - pi * bbi; wim[idx] = pr * bbi + pi * bbr;
        cre[idx] = c_re[(size_t)g * 1024 + idx]; cim[idx] = c_im[(size_t)g * 1024 + idx];
    }
    __syncthreads();
    if (tid < 256) {
        const int h = tid >> 4, h2 = tid & 15; float s = 0.f;
#pragma unroll 8
        for (int n = 0; n < 64; ++n) s += cre[h * 64 + n] * wre[n * 16 + h2] - cim[h * 64 + n] * wim[n * 16 + h2];
        const bf16_t kb = (bf16_t)(cvt_pk_bf16(s, 0.f) & 0xffffu);
        for (int t = d; t < 16; ++t) TmE[(size_t)(t * 16 + h) * KA + (t - d) * 16 + h2] = kb;
        if (d > 0) for (int t = 0; t < 16 - d; ++t) TmE[(size_t)(t * 16 + h) * KA + (t + d) * 16 + h2] = 0;
    } else {
        const int q = tid - 256;
#pragma unroll
        for (int r = 0; r < 4; ++r) {
            const int idx = q + 256 * r;
            { const int h = idx >> 6, n = idx & 63; const float pr = pd1[2 * n], pi = pd1[2 * n + 1], cr = cre[h * 64 + n], ci = cim[h * 64 + n];
              const unsigned w = cvt_pk_bf16(cr * pr - ci * pi, -(cr * pi + ci * pr));
              bf16_t* rowp = TmE + (size_t)(d * 16 + h) * KA + 256; rowp[n] = (bf16_t)(w & 0xffffu); rowp[64 + n] = (bf16_t)(w >> 16); }
            { const int n = idx >> 4, h2 = idx & 15, col = (15 - d) * 16 + h2; const unsigned w = cvt_pk_bf16(wre[idx], wim[idx]);
              Ft[(size_t)n * 256 + col] = (bf16_t)(w & 0xffffu); Ft[(size_t)(64 + n) * 256 + col] = (bf16_t)(w >> 16);
              Ft[(size_t)(128 + n) * 256 + col] = 0; Ft[(size_t)(192 + n) * 256 + col] = 0; }
        }
    }
    __syncthreads();
}

__device__ __forceinline__ void sgu_unit(const Params& p, LAS unsigned char* lds, int unit, int tid) {
    constexpr int LDT = 136;
    LAS bf16_t* At = (LAS bf16_t*)lds;
    LAS bf16_t* Bt = (LAS bf16_t*)(lds + 128 * LDT * 2);
    LAS float* rvs = (LAS float*)(lds + 2 * 128 * LDT * 2);
    const int h = unit & 7, bnb = unit >> 3, tok0 = bnb * 128;
    const float* PV = (const float*)(p.ws + WS_PV); const bf16_t* VB = (const bf16_t*)(p.ws + WS_VB); const bf16_t* UB = (const bf16_t*)(p.ws + WS_UB);
    bf16_t* Y = (bf16_t*)(p.ws + WS_Y); float* PB = (float*)(p.ws + WS_PB);
    const float* vgain = p.in[10]; const float* sw = p.in[11] + (size_t)h * 128 * 128; const float* sb = p.in[12] + h * 128;
    if (tid < 128) { const f32x4* pp = (const f32x4*)(PV + (size_t)(tok0 + tid) * 16); const f32x4 a = pp[0], b = pp[1], c = pp[2], d = pp[3];
        const float s = ((a[0] + a[1]) + (a[2] + a[3])) + ((b[0] + b[1]) + (b[2] + b[3])) + ((c[0] + c[1]) + (c[2] + c[3])) + ((d[0] + d[1]) + (d[2] + d[3]));
        rvs[tid] = 1.0f / sqrtf(s * (1.0f / 1024.0f) + EPS); }
    __syncthreads();
#pragma unroll
    for (int q = 0; q < 4; ++q) {
        const int pc = tid + NTHR * q, r = pc >> 4, c0 = (pc & 15) * 8;
        {
            const bool on = (c0 >> 6) <= (r >> 6);
            const f32x4 w0 = *(const f32x4*)(sw + r * 128 + c0), w1 = *(const f32x4*)(sw + r * 128 + c0 + 4);
            const f32x4 r0 = *(const LAS f32x4*)(rvs + c0), r1 = *(const LAS f32x4*)(rvs + c0 + 4);
            u32x4 o;
            if (on) { o.x = cvt_pk_bf16(w0[0] * r0[0], w0[1] * r0[1]); o.y = cvt_pk_bf16(w0[2] * r0[2], w0[3] * r0[3]); o.z = cvt_pk_bf16(w1[0] * r1[0], w1[1] * r1[1]); o.w = cvt_pk_bf16(w1[2] * r1[2], w1[3] * r1[3]); }
            else { o = (u32x4){0u, 0u, 0u, 0u}; }
            *(LAS u32x4*)(At + r * LDT + c0) = o;
        }
        {
            const int rt = pc & 127, ct0 = (pc >> 7) * 8;
            const u32x4 vv = *(const u32x4*)(VB + (size_t)(tok0 + rt) * 1024 + h * 128 + ct0);
            Bt[(ct0 + 0) * LDT + rt] = (bf16_t)(vv.x & 0xffffu); Bt[(ct0 + 1) * LDT + rt] = (bf16_t)(vv.x >> 16);
            Bt[(ct0 + 2) * LDT + rt] = (bf16_t)(vv.y & 0xffffu); Bt[(ct0 + 3) * LDT + rt] = (bf16_t)(vv.y >> 16);
            Bt[(ct0 + 4) * LDT + rt] = (bf16_t)(vv.z & 0xffffu); Bt[(ct0 + 5) * LDT + rt] = (bf16_t)(vv.z >> 16);
            Bt[(ct0 + 6) * LDT + rt] = (bf16_t)(vv.w & 0xffffu); Bt[(ct0 + 7) * LDT + rt] = (bf16_t)(vv.w >> 16);
        }
    }
    __syncthreads();
    const int w = tid >> 6, lane = tid & 63, fr = lane & 15, fq = lane >> 4;
    bf16x8 wf[4];
#pragma unroll
    for (int ks = 0; ks < 4; ++ks) wf[ks] = *(const LAS bf16x8*)(At + (16 * w + fr) * LDT + ks * 32 + fq * 8);
    const int i = 16 * w + fr; const size_t tok = (size_t)(tok0 + i); const float bsi = sb[i]; float ss = 0.f;
#pragma unroll
    for (int ct = 0; ct < 8; ++ct) {
        f32x4 acc = (f32x4){0.f, 0.f, 0.f, 0.f};
#pragma unroll
        for (int ks = 0; ks < 4; ++ks) { const bf16x8 vf = *(const LAS bf16x8*)(Bt + (16 * ct + fr) * LDT + ks * 32 + fq * 8); acc = __builtin_amdgcn_mfma_f32_16x16x32_bf16(vf, wf[ks], acc, 0, 0, 0); }
        const int c = 16 * ct + 4 * fq;
        const u32x2 uu = *(const u32x2*)(UB + tok * 1024 + h * 128 + c); const f32x4 vg = *(const f32x4*)(vgain + h * 128 + c);
        const float o0 = bf_lo(uu.x) * (vg[0] * acc[0] + bsi), o1 = bf_hi(uu.x) * (vg[1] * acc[1] + bsi), o2 = bf_lo(uu.y) * (vg[2] * acc[2] + bsi), o3 = bf_hi(uu.y) * (vg[3] * acc[3] + bsi);
        ss += (o0 * o0 + o1 * o1) + (o2 * o2 + o3 * o3);
        u32x2 wv; wv.x = cvt_pk_bf16(o0, o1); wv.y = cvt_pk_bf16(o2, o3);
        *(u32x2*)(Y + tok * DM + DSSM + h * 128 + c) = wv;
    }
    ss += __shfl_xor(ss, 16); ss += __shfl_xor(ss, 32);
    if (fq == 0) PB[tok * 8 + h] = ss;
    __syncthreads();
}

__device__ __forceinline__ void carry_task(const Params& p, int g, int tid) {
    const int b = tid >> 6, n = tid & 63;
    const float* S = (const float*)(p.ws + WS_S); bf16_t* Ap = (bf16_t*)(p.ws + WS_AP);
    const f32x2 a16 = *(const f32x2*)((const float*)(p.ws + WS_A16) + (size_t)(g * 64 + n) * 2);
    float hr = 0.f, hi = 0.f; const size_t row0 = (size_t)g * 1024 + b * 128;
#pragma unroll 8
    for (int c = 0; c < NCH; ++c) {
        const size_t row = row0 + c; const float sr = S[row * 128 + n], si = S[row * 128 + 64 + n];
        const unsigned w = cvt_pk_bf16(hr, hi);
        Ap[row * KA + 256 + n] = (bf16_t)(w & 0xffffu); Ap[row * KA + 320 + n] = (bf16_t)(w >> 16);
        const float nr = a16.x * hr - a16.y * hi + sr, ni = a16.x * hi + a16.y * hr + si; hr = nr; hi = ni;
    }
}

__device__ __forceinline__ void convert_share(const Params& p, LAS unsigned char* lds, int sel, int gw, int NGW, int wave, int lane) {
    LAS float* scr = (LAS float*)(lds + wave * 16384); unsigned char* ws = p.ws;
    constexpr int I_OUT = (DM / 64) * (DM / 32), I_1 = (DM / 64) * (DFF / 32), I_2 = (DFF / 64) * (DM / 32);
    if (sel == 0) {
        for (int it = gw; it < I_OUT + I_1; it += NGW) {
            if (it < I_OUT) p0_transpose_item(p.in[15], DM, DM, (bf16_t*)(ws + WS_WOUT), p.in[13], p.in[14], scr, it, lane);
            else p0_transpose_item(p.in[18], DM, DFF, (bf16_t*)(ws + WS_W1), p.in[17], nullptr, scr, it - I_OUT, lane);
        }
    } else {
        for (int it = gw; it < I_2; it += NGW) p0_transpose_item(p.in[19], DFF, DM, (bf16_t*)(ws + WS_W2P), nullptr, nullptr, scr, it, lane, LDH);
    }
}

__global__ void __launch_bounds__(NTHR, 2) fwd_megakernel(Params p) {
    extern __shared__ __attribute__((aligned(16))) unsigned char lds_raw[];
    LAS unsigned char* lds = (LAS unsigned char*)lds_raw;
    cg::grid_group grid = cg::this_grid();
    const int tid = threadIdx.x, lane = tid & 63, wave = __builtin_amdgcn_readfirstlane(tid >> 6);
    const int G = gridDim.x, bx = blockIdx.x;
    const int lo = p.ph_lo, hi = p.ph_hi;
    unsigned char* ws = p.ws;
#ifndef PH_MASK
#define PH_MASK 0x7f
#endif
#define IN(k) (((PH_MASK >> (k)) & 1) && lo <= (k) && (k) < hi)
    volatile LAS unsigned* MISC = (volatile LAS unsigned*)(lds + MISC_OFF);
    if (tid < 64) MISC[tid] = 0u;
    __syncthreads();
    XcdBarrier xbar = xcd_barrier_post((unsigned*)ws, MISC);
#define SEAM(k) do { if (IN(k) && IN((k) + 1)) xcd_barrier(xbar); } while (0)
    if (hi > 64) grid.sync();

    if (IN(0)) {
        for (int t = bx; t < NG * 16; t += G) p0_ssm_task(p, lds, t >> 4, t & 15, tid);
        LAS float* scr = (LAS float*)(lds + wave * 16384);
        const int gw = bx * NWAVES + wave, NGW = G * NWAVES;
        constexpr int I_IN = (DM / 64) * (DIN / 32);
        for (int it = gw; it < I_IN; it += NGW) p0_transpose_item(p.in[1], DM, DIN, (bf16_t*)(ws + WS_WIN), nullptr, nullptr, scr, it, lane);
        const float* x = p.in[0]; const float* mg = p.in[16]; bf16_t* XN = (bf16_t*)(ws + WS_XN);
        for (int m = gw; m < M; m += NGW) {
            const f32x4* xr = (const f32x4*)(x + (size_t)m * DM) + lane; f32x4 v[8]; float s = 0.f;
#pragma unroll
            for (int j = 0; j < 8; ++j) { v[j] = xr[64 * j]; s += (v[j][0] * v[j][0] + v[j][1] * v[j][1]) + (v[j][2] * v[j][2] + v[j][3] * v[j][3]); }
            const float r = 1.0f / sqrtf(wave_sum(s) * (1.0f / DM) + EPS);
            u32x2* o = (u32x2*)(XN + (size_t)m * DM) + lane;
#pragma unroll
            for (int j = 0; j < 8; ++j) { const f32x4 gg = *((const f32x4*)mg + 64 * j + lane); u32x2 w; w.x = cvt_pk_bf16(v[j][0] * r * gg[0], v[j][1] * r * gg[1]); w.y = cvt_pk_bf16(v[j][2] * r * gg[2], v[j][3] * r * gg[3]); o[64 * j] = w; }
        }
    }
    SEAM(0);
    if (IN(1)) {
        pg8::Gemm g{(const bf16_t*)(ws + WS_XN), (const bf16_t*)(ws + WS_WIN), DM, DM, DM}; pg8::StaticOrder S; S.init(M, DIN, G, bx);
        EpiProj E{(bf16_t*)(ws + WS_AP), (bf16_t*)(ws + WS_SG), (bf16_t*)(ws + WS_UB), (bf16_t*)(ws + WS_VB), (float*)(ws + WS_PV)};
        const bool late = ((bx >> 3) & 1) != 0; const int gw = bx * NWAVES + wave, NGW = G * NWAVES;
        if (late) { convert_share(p, lds, 0, gw, NGW, wave, lane); __syncthreads(); }
        pg8::gemm_phase<EpiProj, pg8::StaticOrder, true>(lds, g, S, E);
        if (!late) convert_share(p, lds, 0, gw, NGW, wave, lane);
    }
    SEAM(1);
    if (IN(2)) {
        pg8::GroupOrder GO; GO.init(G, bx);
        for (int i = 0;; ++i) {
            Unit u; if (!GO.next(i, u)) break;
            pg8::OneUnit S1{u.pm, u.pn};
            { pg8::Gemm g{(const bf16_t*)(ws + WS_AP), (const bf16_t*)(ws + WS_FT), KA, 256, 256}; EpiS E{};
              pg8::gemm_phase<EpiS, pg8::OneUnit, false>(lds, g, S1, E); }
            __syncthreads();
            if (tid < 128) {
                const int b2 = tid >> 6, n = tid & 63; const LAS float* S = (const LAS float*)lds + (b2 * 128) * 132 + n;
                bf16_t* hp = (bf16_t*)(ws + WS_AP) + ((size_t)u.pm * 256 + b2 * 128) * KA + 256 + n;
                const f32x2 a16 = *(const f32x2*)((const float*)(ws + WS_A16) + (size_t)(u.pn * 64 + n) * 2);
                float hr = 0.f, hi = 0.f;
#pragma unroll 8
                for (int c = 0; c < NCH; ++c) {
                    const float sr = S[c * 132], si = S[c * 132 + 64];
                    const unsigned w = cvt_pk_bf16(hr, hi);
                    hp[(size_t)c * KA] = (bf16_t)(w & 0xffffu); hp[(size_t)c * KA + 64] = (bf16_t)(w >> 16);
                    const float nr = a16.x * hr - a16.y * hi + sr, ni = a16.x * hi + a16.y * hr + si; hr = nr; hi = ni;
                }
            }
            asm volatile("s_waitcnt vmcnt(0)" ::: "memory");
            __syncthreads();
            { pg8::Gemm g{(const bf16_t*)(ws + WS_AP), (const bf16_t*)(ws + WS_TME), KA, KA, KA};
              EpiSsm E{(const bf16_t*)(ws + WS_AP), (const bf16_t*)(ws + WS_SG), p.in[9], (bf16_t*)(ws + WS_Y), (float*)(ws + WS_PA)};
              pg8::gemm_phase<EpiSsm, pg8::OneUnit, true>(lds, g, S1, E); }
        }
        for (int uu = bx; uu < 1024; uu += G) sgu_unit(p, lds, uu, tid);
    }
    SEAM(2);
    if (IN(3)) {
        pg8::StaticOrder S; S.init(M, DM, G, bx);
        LAS f32x2* tab = (LAS f32x2*)(lds + TAB_OFF);
        const float* PA = (const float*)(ws + WS_PA); const float* PB = (const float*)(ws + WS_PB);
        for (int idx = tid; idx < TAB_BYTES / 8; idx += NTHR) {
            Unit u; if (!S.next(idx >> 8, u)) break;
            const int row = u.pm * 256 + (idx & 255); const f32x4* pa = (const f32x4*)(PA + (size_t)row * 64); float sa = 0.f;
#pragma unroll
            for (int j = 0; j < 16; ++j) { const f32x4 v = pa[j]; sa += (v[0] + v[1]) + (v[2] + v[3]); }
            const f32x4* pb = (const f32x4*)(PB + (size_t)row * 8); const f32x4 b0 = pb[0], b1 = pb[1]; const float sbb = ((b0[0] + b0[1]) + (b0[2] + b0[3])) + ((b1[0] + b1[1]) + (b1[2] + b1[3]));
            const float ra = 1.0f / sqrtf(sa * (1.0f / 1024.0f) + EPS), rb = 1.0f / sqrtf(sbb * (1.0f / 1024.0f) + EPS);
            tab[idx] = (f32x2){ra / rb, rb};
        }
        __syncthreads();
        pg8::Gemm g{(const bf16_t*)(ws + WS_Y), (const bf16_t*)(ws + WS_WOUT), DM, DM, DM};
        EpiOut E{p.in[0], (bf16_t*)(ws + WS_H1B), (float*)(ws + WS_P2), tab};
        pg8::gemm_phase<EpiOut, pg8::StaticOrder, true>(lds, g, S, E);
    }
    SEAM(3);
    if (IN(4)) {
        pg8::StaticOrder S; S.init(M, DFF, G, bx);
        LAS float* tab = (LAS float*)(lds + TAB_OFF);
        const float* P2 = (const float*)(ws + WS_P2);
        for (int idx = tid; idx < TAB_BYTES / 4; idx += NTHR) {
            Unit u; if (!S.next(idx >> 8, u)) break;
            const int row = u.pm * 256 + (idx & 255); const f32x4* pp = (const f32x4*)(P2 + (size_t)row * 32); float s = 0.f;
#pragma unroll
            for (int j = 0; j < 8; ++j) { const f32x4 v = pp[j]; s += (v[0] + v[1]) + (v[2] + v[3]); }
            tab[idx] = 1.0f / sqrtf(s * (1.0f / DM) + EPS);
        }
        __syncthreads();
        pg8::Gemm g{(const bf16_t*)(ws + WS_H1B), (const bf16_t*)(ws + WS_W1), DM, DM, DM};
        EpiFF1 E{(bf16_t*)(ws + WS_HID), tab};
        const bool late = ((bx >> 3) & 1) != 0; const int gw = bx * NWAVES + wave, NGW = G * NWAVES;
        if (late) { convert_share(p, lds, 1, gw, NGW, wave, lane); __syncthreads(); }
        pg8::gemm_phase<EpiFF1, pg8::StaticOrder, true>(lds, g, S, E);
        if (!late) convert_share(p, lds, 1, gw, NGW, wave, lane);
    }
    SEAM(4);
    const bool fused_norm = (G == 256);
    if (IN(5)) {
        pg8::Gemm g{(const bf16_t*)(ws + WS_HID), (const bf16_t*)(ws + WS_W2P), LDH, LDH, DFF};
        if (fused_norm) {
            PanelOrder S{bx};
            EpiFF2N E{(const bf16_t*)(ws + WS_H1B), p.out, p.in[20], (float*)(ws + WS_P3), (unsigned*)ws + 4096};
            pg8::gemm_phase<EpiFF2N, PanelOrder, true>(lds, g, S, E);
        } else {
            pg8::StaticOrder S; S.init(M, DM, G, bx);
            EpiFF2 E{(bf16_t*)(ws + WS_H1B), (float*)(ws + WS_P3)};
            pg8::gemm_phase<EpiFF2, pg8::StaticOrder, true>(lds, g, S, E);
        }
    }
    if (!fused_norm) SEAM(5);
    if (IN(6) && !fused_norm) {
        const int gw = bx * NWAVES + wave, NGW = G * NWAVES; const float* P3 = (const float*)(ws + WS_P3); const float* fg = p.in[20]; const bf16_t* H2 = (const bf16_t*)(ws + WS_H1B);
        for (int m = gw; m < M; m += NGW) {
            const float ps = (lane < 32) ? P3[(size_t)m * 32 + lane] : 0.f;
            const u32x4* hr = (const u32x4*)(H2 + (size_t)m * DM) + lane; u32x4 hv[4];
#pragma unroll
            for (int j = 0; j < 4; ++j) hv[j] = hr[64 * j];
            const float r = 1.0f / sqrtf(wave_sum(ps) * (1.0f / DM) + EPS);
            f32x4* orow = (f32x4*)(p.out + (size_t)m * DM) + 2 * lane;
#pragma unroll
            for (int j = 0; j < 4; ++j) { const f32x4 g0 = *((const f32x4*)fg + 128 * j + 2 * lane), g1 = *((const f32x4*)fg + 128 * j + 2 * lane + 1);
                f32x4 o0 = {bf_lo(hv[j].x), bf_hi(hv[j].x), bf_lo(hv[j].y), bf_hi(hv[j].y)}, o1 = {bf_lo(hv[j].z), bf_hi(hv[j].z), bf_lo(hv[j].w), bf_hi(hv[j].w)};
                orow[128 * j] = o0 * r * g0; orow[128 * j + 1] = o1 * r * g1; }
        }
    }
#ifdef DBG_STOP
    grid.sync();
    {
        const size_t NT = (size_t)M * DM; const size_t gt = (size_t)bx * NTHR + tid, gs = (size_t)G * NTHR;
        const bf16_t* XN = (const bf16_t*)(ws + WS_XN); const bf16_t* WINp = (const bf16_t*)(ws + WS_WIN); const bf16_t* WOUTp = (const bf16_t*)(ws + WS_WOUT);
        const bf16_t* W1p = (const bf16_t*)(ws + WS_W1); const bf16_t* W2p = (const bf16_t*)(ws + WS_W2); const bf16_t* TMEp = (const bf16_t*)(ws + WS_TME); const bf16_t* FTp = (const bf16_t*)(ws + WS_FT);
        const bf16_t* SGp = (const bf16_t*)(ws + WS_SG); const bf16_t* UBp = (const bf16_t*)(ws + WS_UB); const bf16_t* VBp = (const bf16_t*)(ws + WS_VB); const bf16_t* APp = (const bf16_t*)(ws + WS_AP);
        const bf16_t* Yp = (const bf16_t*)(ws + WS_Y); const bf16_t* H1Bp = (const bf16_t*)(ws + WS_H1B); const bf16_t* HIDp = (const bf16_t*)(ws + WS_HID);
        const float* Sp = (const float*)(ws + WS_S); const float* PVp = (const float*)(ws + WS_PV); const float* PAp = (const float*)(ws + WS_PA); const float* PBp = (const float*)(ws + WS_PB);
        const float* P2p = (const float*)(ws + WS_P2); const float* P3p = (const float*)(ws + WS_P3);
#define BFV(p, i) __uint_as_float(((unsigned)(p)[(i)]) << 16)
        for (size_t i = gt; i < NT; i += gs) {
            float v = 0.f;
            if (DBG_STOP == 0) v = BFV(XN, i) + BFV(WINp, i % (size_t)(DIN * DM)) + BFV(WOUTp, i % (size_t)(DM * DM)) + BFV(W1p, i % (size_t)(DFF * DM)) + BFV(W2p, i % (size_t)(DFF * DM)) + BFV(TMEp, i % (size_t)(64 * 256 * KA)) + BFV(FTp, i % (size_t)(64 * 256 * 256));
            if (DBG_STOP == 1) { const size_t e = i % (size_t)(65536 * 256); v = BFV(SGp, i % (size_t)(M * 1024)) + 0.f * (float)(e & 1); }
            if (DBG_STOP == 2) v = Sp[i % (size_t)(65536 * 128)];
            if (DBG_STOP == 3) { const size_t e = i % (size_t)(65536 * 128), y = i % (size_t)(M * 1024); v = BFV(APp, (e >> 7) * KA + 256 + (e & 127)) + BFV(Yp, (y >> 10) * DM + 1024 + (y & 1023)) + PBp[i % (size_t)(M * 8)]; }
            if (DBG_STOP == 4) { const size_t y = i % (size_t)(M * 1024); v = BFV(Yp, (y >> 10) * DM + (y & 1023)) + PAp[i % (size_t)(M * 64)]; }
            if (DBG_STOP == 5) v = p.out[i] + BFV(H1Bp, i) + P2p[i % (size_t)(M * 32)];
            if (DBG_STOP == 6) v = BFV(HIDp, i) + BFV(HIDp, i + NT) + BFV(HIDp, i + 2 * NT) + BFV(HIDp, i + 3 * NT);
            if (DBG_STOP == 7) v = p.out[i] + P3p[i % (size_t)(M * 32)];
            p.out[i] = v;
        }
    }
#endif
#undef IN
#undef SEAM
}

extern "C" void kernel_launch(void* const* d_in, const int* in_sizes, int n_in, void* d_out, int out_size, void* d_ws, size_t ws_size, hipStream_t stream) {
    static int grid = 0;
    if (grid == 0) {
        if (n_in != 21 || out_size != M * DM || ws_size < WS_END) { fprintf(stderr, "kernel_launch: unexpected shapes (n_in %d, out %d, ws %zu)\n", n_in, out_size, ws_size); grid = -1; return; }
        int dev = 0, cus = 0, per_cu = 0;
        hipGetDevice(&dev); hipDeviceGetAttribute(&cus, hipDeviceAttributeMultiprocessorCount, dev);
        if (hipFuncSetAttribute((const void*)fwd_megakernel, hipFuncAttributeMaxDynamicSharedMemorySize, LDS_BYTES) != hipSuccess) { fprintf(stderr, "kernel_launch: hipFuncSetAttribute failed\n"); grid = -1; return; }
        if (hipOccupancyMaxActiveBlocksPerMultiprocessor(&per_cu, (const void*)fwd_megakernel, NTHR, LDS_BYTES) != hipSuccess || per_cu < 1) { fprintf(stderr, "kernel_launch: occupancy query failed (%d)\n", per_cu); (void)hipGetLastError(); per_cu = 1; }
        grid = cus * per_cu;
        if (grid > 256) grid = 256;
    }
    if (grid < 0) return;
#ifdef DIAG_POISON_WS
    (void)hipMemsetAsync((unsigned char*)d_ws, 0xAA, WS_END, stream);
#endif
    Params p{};
    for (int i = 0; i < 21; ++i) p.in[i] = (const float*)d_in[i];
    p.out = (float*)d_out; p.ws = (unsigned char*)d_ws;
#if MK_MULTI
    for (int ph = 0; ph < 7; ++ph) { p.ph_lo = ph; p.ph_hi = ph + 1; hipLaunchKernelGGL(fwd_megakernel, dim3(grid), dim3(NTHR), LDS_BYTES, stream, p); }
#else
#ifdef DBG_STOP
    p.ph_lo = 0; p.ph_hi = DBG_STOP + 1;
#else
    p.ph_lo = 0; p.ph_hi = 7;
#endif
    (void)hipMemsetAsync(d_ws, 0, 32768, stream);
    void* args[] = {&p};
    hipError_t e = hipLaunchCooperativeKernel((const void*)fwd_megakernel, dim3(grid), dim3(NTHR), args, LDS_BYTES, stream);
    if (e != hipSuccess) fprintf(stderr, "cooperative launch failed: %s (grid %d)\n", hipGetErrorString(e), grid);
#endif
}
```

```cpp
#include <hip/hip_runtime.h>
#include <hip/hip_cooperative_groups.h>
#include <cstdio>
#include <cstdint>
namespace cg = cooperative_groups;

#ifndef MK_MULTI
#define MK_MULTI 0
#endif

#define LAS __attribute__((address_space(3)))
typedef unsigned short bf16_t;
typedef short bf16x8 __attribute__((ext_vector_type(8)));
typedef float f32x4 __attribute__((ext_vector_type(4)));
typedef float f32x2 __attribute__((ext_vector_type(2)));
typedef unsigned u32x4 __attribute__((ext_vector_type(4)));
typedef unsigned u32x2 __attribute__((ext_vector_type(2)));

typedef __bf16 bf16x2_t __attribute__((ext_vector_type(2)));
__device__ __forceinline__ unsigned cvt_pk_bf16(float lo, float hi) { const f32x2 v = {lo, hi}; const bf16x2_t b = __builtin_convertvector(v, bf16x2_t); return __builtin_bit_cast(unsigned, b); }
__device__ __forceinline__ float bf_lo(unsigned w) { return __uint_as_float(w << 16); }
__device__ __forceinline__ float bf_hi(unsigned w) { return __uint_as_float(w & 0xffff0000u); }
__device__ __forceinline__ float gelu_tanh(float x) {
    const float t = x * (1.0f + 0.044715f * x * x);
    const float e = __builtin_amdgcn_exp2f(-2.3022081984f * t);
    return x * __builtin_amdgcn_rcpf(1.0f + e);
}
__device__ __forceinline__ float sigmoid_f(float x) { return __builtin_amdgcn_rcpf(1.0f + __builtin_amdgcn_exp2f(-1.4426950409f * x)); }

namespace pg8 {
constexpr int BM = 256, BK = 64, HALF = 128, HTB = HALF * BK * 2, STAGE_BYTES = 8 * HTB, NXCD = 8, WGM = 8;
__host__ __device__ __forceinline__ int lds_byte(int r, int c) { const int st = (r >> 4) * 2 + (c >> 5), rr = r & 15, cc = c & 31, ob = rr * 64 + cc * 2; return st * 1024 + (ob ^ (((ob >> 9) & 1) << 5)); }
__host__ __device__ __forceinline__ void stage_rc(int b, int& R, int& C) { const int st = b / 1024, sb = b % 1024, swz = sb ^ (((sb >> 9) & 1) << 5); R = (st >> 1) * 16 + swz / 64; C = (st & 1) * 32 + (swz % 64) / 2; }
__host__ __device__ __forceinline__ int perm32(int rho) { const int n = rho >> 4, i = rho & 15; return 8 * (i >> 2) + 4 * n + (i & 3); }

struct Unit { int pm, pn; };
struct Gemm { const bf16_t* A; const bf16_t* Bt; int lda, ldb, K; };

struct StaticOrder {
    int nM, nN, nwg, G, c;
    __device__ void init(int M, int N, int G_, int c_) { nM = M / BM; nN = N / BM; nwg = nM * nN; G = G_; c = c_; }
    __device__ bool next(int i, Unit& u) const {
        const long L = (long)i * G + c; if (L >= nwg) return false;
        int wgid = (int)L; { const int q = nwg / NXCD, r = nwg % NXCD, xcd = wgid % NXCD, off = wgid / NXCD; wgid = (xcd < r ? xcd * (q + 1) : r * (q + 1) + (xcd - r) * q) + off; }
        const int nig = WGM * nN, gid = wgid / nig, fm = gid * WGM, gsz = (nM - fm) < WGM ? (nM - fm) : WGM;
        u.pm = fm + ((wgid % nig) % gsz); u.pn = (wgid % nig) / gsz; return true;
    }
};
struct GroupOrder {
    int G, c;
    __device__ void init(int G_, int c_) { G = G_; c = c_; }
    __device__ bool next(int i, Unit& u) const {
        const int L = i * G + c; if (L >= 256) return false;
        const int Lr = (L & 7) * 32 + (L >> 3); u.pm = Lr; u.pn = Lr >> 2; return true;
    }
};

struct OneUnit { int pm, pn; __device__ bool next(int i, Unit& u) const { if (i != 0) return false; u.pm = pm; u.pn = pn; return true; } };

template <class Epi, class Sched, bool ALIGN_EPI>
__device__ __forceinline__ void gemm_phase(LAS unsigned char* lds, const Gemm g, const Sched& S, const Epi& E) {
    const int tid = threadIdx.x, wid = __builtin_amdgcn_readfirstlane(tid >> 6), lane = tid & 63, wr = wid >> 2, wc = wid & 3, fr = lane & 15, fq = lane >> 4;
    int nt = g.K / BK; asm volatile("" : "+s"(nt));
    unsigned voffA[2], voffB[2];
#pragma unroll
    for (int i = 0; i < 2; ++i) { int R, C; stage_rc(tid * 16 + i * 8192, R, C); const int Rb = Epi::PERM ? ((R & ~31) + perm32(R & 31)) : R;
        voffA[i] = (unsigned)(R * g.lda + C) * 2u; voffB[i] = (unsigned)(Rb * g.ldb + C) * 2u; }
    const size_t kstep = (size_t)(BK * 2);
    const size_t hstepA = (size_t)HALF * g.lda * 2, hstepB = (size_t)HALF * g.ldb * 2;
    const size_t tstepA = 2 * hstepA, tstepB = 2 * hstepB;
    const unsigned ldsw = (unsigned)wid * 1024u;
    const int aoff = lds_byte(wr * 64 + fr, fq * 8), boff = lds_byte(wc * 32 + fr, fq * 8);
#define PG8_SA(b, h) (((b) * 2 + (h)) * HTB)
#define PG8_SB(b, h) ((4 + (b) * 2 + (h)) * HTB)
#define PG8_STAGE(bufoff, gbase, voff) do { _Pragma("unroll") for (int _i = 0; _i < 2; ++_i) \
        __builtin_amdgcn_global_load_lds((const unsigned*)((const char*)(gbase) + (voff)[_i]), (LAS unsigned*)(lds + (bufoff) + ldsw + _i * 8192), 16, 0, 0); } while (0)
#define PG8_LDA(dst, b, h) do { _Pragma("unroll") for (int m = 0; m < 4; ++m) _Pragma("unroll") for (int k = 0; k < 2; ++k) dst[m][k] = *(const LAS bf16x8*)(lds + PG8_SA(b, h) + aoff + m * 2048 + k * 1024); } while (0)
#define PG8_LDB(dst, b, h) do { _Pragma("unroll") for (int n = 0; n < 2; ++n) _Pragma("unroll") for (int k = 0; k < 2; ++k) dst[n][k] = *(const LAS bf16x8*)(lds + PG8_SB(b, h) + boff + n * 2048 + k * 1024); } while (0)
#define PG8_MMA(ai, bj, At, Bt) do { __builtin_amdgcn_s_setprio(1); _Pragma("unroll") for (int m = 0; m < 4; ++m) _Pragma("unroll") for (int n = 0; n < 2; ++n) _Pragma("unroll") for (int k = 0; k < 2; ++k) \
        acc[ai][bj][m][n] = __builtin_amdgcn_mfma_f32_16x16x32_bf16(Bt[n][k], At[m][k], acc[ai][bj][m][n], 0, 0, 0); __builtin_amdgcn_s_setprio(0); } while (0)
#define PG8_WAIT_V(n) asm volatile("s_waitcnt vmcnt(" #n ")" ::: "memory")
#define PG8_WAIT_L(n) asm volatile("s_waitcnt lgkmcnt(" #n ")" ::: "memory")
#define PG8_BAR __builtin_amdgcn_s_barrier()
#define PG8_SCHED __builtin_amdgcn_sched_barrier(0)
    Unit cur, nxt; int ui = 0;
    if (!S.next(0, cur)) return;
    f32x4 acc[2][2][4][2];
#pragma unroll
    for (int a = 0; a < 2; ++a)
#pragma unroll
        for (int b = 0; b < 2; ++b)
#pragma unroll
            for (int m = 0; m < 4; ++m)
#pragma unroll
                for (int n = 0; n < 2; ++n) acc[a][b][m][n] = (f32x4){0.f, 0.f, 0.f, 0.f};
    bf16x8 At[4][2], B0[2][2], B1[2][2];
    const char* cA = (const char*)g.A + (size_t)cur.pm * tstepA; const char* cB = (const char*)g.Bt + (size_t)cur.pn * tstepB;
    PG8_STAGE(PG8_SB(0, 0), cB, voffB); PG8_STAGE(PG8_SB(0, 1), cB + hstepB, voffB); PG8_STAGE(PG8_SA(0, 0), cA, voffA); PG8_STAGE(PG8_SA(0, 1), cA + hstepA, voffA);
    if (wr == 1) PG8_BAR;
    PG8_WAIT_V(2); PG8_BAR;
    PG8_STAGE(PG8_SB(1, 0), cB + kstep, voffB); PG8_STAGE(PG8_SA(1, 0), cA + kstep, voffA); PG8_STAGE(PG8_SB(1, 1), cB + hstepB + kstep, voffB);
    PG8_WAIT_V(6); PG8_BAR;
    for (;;) {
        const bool has_next = S.next(ui + 1, nxt);
        const char* nA = has_next ? (const char*)g.A + (size_t)nxt.pm * tstepA : cA; const char* nB = has_next ? (const char*)g.Bt + (size_t)nxt.pn * tstepB : cB;
#pragma nounroll
        for (int t = 0; t < nt; t += 2) {
            const bool last = (t == nt - 2);
            const char* a1 = cA + (size_t)(t + 1) * kstep;
            const char* a2 = last ? nA : cA + (size_t)(t + 2) * kstep; const char* b2 = last ? nB : cB + (size_t)(t + 2) * kstep;
            const char* a3 = a2 + kstep; const char* b3 = b2 + kstep;
            if constexpr (Epi::HAS_MID) { if (t == (nt >> 1)) E.mid(acc, ui, wr, fr); }
            PG8_LDB(B0, 0, 0); PG8_LDB(B1, 0, 1); PG8_SCHED; PG8_LDA(At, 0, 0); PG8_STAGE(PG8_SA(1, 1), a1 + hstepA, voffA);
            PG8_WAIT_V(8); PG8_WAIT_L(0); PG8_BAR; PG8_MMA(0, 0, At, B0); PG8_MMA(0, 1, At, B1); PG8_BAR; PG8_SCHED;
            PG8_LDA(At, 0, 1); PG8_STAGE(PG8_SB(0, 0), b2, voffB); PG8_STAGE(PG8_SB(0, 1), b2 + hstepB, voffB); PG8_STAGE(PG8_SA(0, 0), a2, voffA);
            PG8_WAIT_V(8); PG8_WAIT_L(0); PG8_BAR; PG8_MMA(1, 0, At, B0); PG8_MMA(1, 1, At, B1); PG8_BAR; PG8_SCHED;
            PG8_LDB(B0, 1, 0); PG8_LDB(B1, 1, 1); PG8_SCHED; PG8_LDA(At, 1, 0); PG8_STAGE(PG8_SA(0, 1), a2 + hstepA, voffA);
            PG8_WAIT_V(8); PG8_WAIT_L(0); PG8_BAR; PG8_MMA(0, 0, At, B0); PG8_MMA(0, 1, At, B1); PG8_BAR; PG8_SCHED;
            PG8_LDA(At, 1, 1); PG8_STAGE(PG8_SB(1, 0), b3, voffB); PG8_STAGE(PG8_SB(1, 1), b3 + hstepB, voffB); PG8_STAGE(PG8_SA(1, 0), a3, voffA);
            PG8_WAIT_V(8); PG8_WAIT_L(0); PG8_BAR; PG8_MMA(1, 0, At, B0); PG8_MMA(1, 1, At, B1); PG8_BAR; PG8_SCHED;
        }
        if constexpr (ALIGN_EPI) { if (wr == 0) PG8_BAR; }
        if constexpr (!Epi::AFTER_DRAIN) E(acc, cur, ui, wr, wc, fr, fq);
        if (!has_next) break;
#pragma unroll
        for (int a = 0; a < 2; ++a)
#pragma unroll
            for (int b = 0; b < 2; ++b)
#pragma unroll
                for (int m = 0; m < 4; ++m)
#pragma unroll
                    for (int n = 0; n < 2; ++n) acc[a][b][m][n] = (f32x4){0.f, 0.f, 0.f, 0.f};
        cur = nxt; cA = nA; cB = nB; ++ui;
        if constexpr (ALIGN_EPI) { if (wr == 1) PG8_BAR; }
    }
    PG8_WAIT_V(0);
    if constexpr (!ALIGN_EPI) { if (wr == 0) PG8_BAR; }
    PG8_BAR;
    if constexpr (Epi::AFTER_DRAIN) E.after(acc, cur, wr, wc, fr, fq, lds);
#undef PG8_SA
#undef PG8_SB
#undef PG8_STAGE
#undef PG8_LDA
#undef PG8_LDB
#undef PG8_MMA
#undef PG8_WAIT_V
#undef PG8_WAIT_L
#undef PG8_BAR
#undef PG8_SCHED
}
}
using pg8::Unit;

constexpr int BATCH = 8, SEQ = 2048, DM = 2048, M = BATCH * SEQ;
constexpr int DSSM = 1024, DSGU = 1024, DIN = 4096, DFF = 8192;
constexpr int LDH = DFF + 64;
constexpr int NG = 64, GS = 16, NS = 64;
constexpr int LC = 16, NCH = SEQ / LC;
constexpr int KA = LC * GS + 2 * NS;
constexpr float EPS = 1e-5f;
constexpr int NWAVES = 8, NTHR = 512;

constexpr size_t MiB = 1u << 20;
constexpr size_t WS_WIN = 1 * MiB, WS_WOUT = 17 * MiB, WS_W1 = 25 * MiB, WS_W2 = 57 * MiB;
constexpr size_t WS_TME = 89 * MiB;
constexpr size_t WS_FT = 101 * MiB;
constexpr size_t WS_A16 = 109 * MiB;
constexpr size_t WS_PV = 110 * MiB;
constexpr size_t WS_PA = 111 * MiB;
constexpr size_t WS_PB = 115 * MiB;
constexpr size_t WS_P2 = 116 * MiB;
constexpr size_t WS_P3 = 118 * MiB;
constexpr size_t WS_H1B = 120 * MiB;
constexpr size_t WS_R1 = 184 * MiB;
constexpr size_t WS_XN = WS_R1;
constexpr size_t WS_S = WS_R1;
constexpr size_t WS_Y = WS_R1 + 64 * MiB;
constexpr size_t WS_AP = WS_R1 + 128 * MiB;
constexpr size_t WS_SG = WS_R1 + 176 * MiB;
constexpr size_t WS_UB = WS_R1 + 208 * MiB;
constexpr size_t WS_VB = WS_R1 + 240 * MiB;
constexpr size_t WS_HID = WS_R1;
constexpr size_t WS_W2P = WS_R1 + 272 * MiB;
constexpr size_t WS_END = WS_W2P + 33 * MiB;

constexpr int RING_BYTES = 131072, TAB_OFF = RING_BYTES, TAB_BYTES = 16384, MISC_OFF = TAB_OFF + TAB_BYTES, LDS_BYTES = MISC_OFF + 256;

struct EpiProj {
    static constexpr bool PERM = true, HAS_MID = false, AFTER_DRAIN = false;
    bf16_t *Ap, *SG, *UB, *VB; float* PV;
    template <int SECT> __device__ __forceinline__ void body(const f32x4 (&acc)[2][2][4][2], const Unit& u, int wr, int wc, int fr, int fq) const {
        const int colt = (u.pn & 3) * 256 + wc * 32 + 8 * fq;
        const int row0 = u.pm * 256 + wr * 64 + fr;
#pragma unroll
        for (int ai = 0; ai < 2; ++ai)
#pragma unroll
            for (int m = 0; m < 4; ++m) {
                const int row = row0 + ai * 128 + m * 16; float ss = 0.f;
#pragma unroll
                for (int bj = 0; bj < 2; ++bj) {
                    const int col8 = colt + bj * 128;
                    f32x4 v0 = acc[ai][bj][m][0], v1 = acc[ai][bj][m][1];
                    if (SECT == 1) {
#pragma unroll
                        for (int j = 0; j < 4; ++j) { v0[j] = sigmoid_f(v0[j]); v1[j] = sigmoid_f(v1[j]); }
                    }
                    if (SECT >= 2) {
#pragma unroll
                        for (int j = 0; j < 4; ++j) { v0[j] = gelu_tanh(v0[j]); v1[j] = gelu_tanh(v1[j]); }
                    }
                    if (SECT == 3) ss += (v0[0] * v0[0] + v0[1] * v0[1]) + (v0[2] * v0[2] + v0[3] * v0[3]) + (v1[0] * v1[0] + v1[1] * v1[1]) + (v1[2] * v1[2] + v1[3] * v1[3]);
                    u32x4 w; w.x = cvt_pk_bf16(v0[0], v0[1]); w.y = cvt_pk_bf16(v0[2], v0[3]); w.z = cvt_pk_bf16(v1[0], v1[1]); w.w = cvt_pk_bf16(v1[2], v1[3]);
                    bf16_t* dst;
                    if (SECT == 0) dst = Ap + ((size_t)((col8 >> 4) * 1024 + (row >> 4)) * KA + (row & 15) * 16 + (col8 & 15));
                    else if (SECT == 1) dst = SG + (size_t)row * 1024 + col8;
                    else if (SECT == 2) dst = UB + (size_t)row * 1024 + col8;
                    else dst = VB + (size_t)row * 1024 + col8;
                    *(u32x4*)dst = w;
                }
                if (SECT == 3) { ss += __shfl_xor(ss, 16); ss += __shfl_xor(ss, 32); if (fq == 0) PV[(size_t)row * 16 + (u.pn & 3) * 4 + wc] = ss; }
            }
    }
    __device__ __forceinline__ void operator()(const f32x4 (&acc)[2][2][4][2], const Unit& u, int ui, int wr, int wc, int fr, int fq) const {
        const int sect = u.pn >> 2;
        if (sect == 0) body<0>(acc, u, wr, wc, fr, fq); else if (sect == 1) body<1>(acc, u, wr, wc, fr, fq);
        else if (sect == 2) body<2>(acc, u, wr, wc, fr, fq); else body<3>(acc, u, wr, wc, fr, fq);
    }
};
struct EpiS {
    static constexpr bool PERM = false, HAS_MID = false, AFTER_DRAIN = true;
    __device__ __forceinline__ void operator()(const f32x4 (&acc)[2][2][4][2], const Unit& u, int ui, int wr, int wc, int fr, int fq) const {}
    __device__ __forceinline__ void after(const f32x4 (&acc)[2][2][4][2], const Unit& u, int wr, int wc, int fr, int fq, LAS unsigned char* lds) const {
        LAS float* S = (LAS float*)lds; const int row0 = wr * 64 + fr, col0 = wc * 32 + 4 * fq;
#pragma unroll
        for (int ai = 0; ai < 2; ++ai)
#pragma unroll
            for (int m = 0; m < 4; ++m) { LAS float* rp = S + (row0 + ai * 128 + m * 16) * 132 + col0;
#pragma unroll
                for (int n = 0; n < 2; ++n) *(LAS f32x4*)(rp + n * 16) = acc[ai][0][m][n]; }
    }
};
struct EpiSsm {
    static constexpr bool PERM = true, HAS_MID = false, AFTER_DRAIN = false;
    const bf16_t *Ap, *SG; const float* dsk; bf16_t* Y; float* PA;
    __device__ __forceinline__ void operator()(const f32x4 (&acc)[2][2][4][2], const Unit& u, int ui, int wr, int wc, int fr, int fq) const {
        asm volatile("" : "+v"(fr), "+v"(fq));
        const int g = u.pn;
#pragma unroll
        for (int bj = 0; bj < 2; ++bj) {
            const int col8 = bj * 128 + wc * 32 + 8 * fq, t = col8 >> 4, hh = col8 & 15, ch = g * 16 + hh;
            const f32x4 d0 = *(const f32x4*)(dsk + ch), d1 = *(const f32x4*)(dsk + ch + 4);
#pragma unroll
            for (int ai = 0; ai < 2; ++ai)
#pragma unroll
                for (int m = 0; m < 4; ++m) {
                    const int R = u.pm * 256 + ai * 128 + wr * 64 + m * 16 + fr, rg = R & 1023, token = (rg >> 7) * SEQ + (rg & 127) * LC + t;
                    const u32x4 uu = *(const u32x4*)(Ap + (size_t)R * KA + t * 16 + hh);
                    const u32x4 sg = *(const u32x4*)(SG + (size_t)token * 1024 + ch);
                    const f32x4 a0 = acc[ai][bj][m][0], a1 = acc[ai][bj][m][1];
                    float o[8];
                    o[0] = gelu_tanh(a0[0] + d0[0] * bf_lo(uu.x)) * bf_lo(sg.x); o[1] = gelu_tanh(a0[1] + d0[1] * bf_hi(uu.x)) * bf_hi(sg.x);
                    o[2] = gelu_tanh(a0[2] + d0[2] * bf_lo(uu.y)) * bf_lo(sg.y); o[3] = gelu_tanh(a0[3] + d0[3] * bf_hi(uu.y)) * bf_hi(sg.y);
                    o[4] = gelu_tanh(a1[0] + d1[0] * bf_lo(uu.z)) * bf_lo(sg.z); o[5] = gelu_tanh(a1[1] + d1[1] * bf_hi(uu.z)) * bf_hi(sg.z);
                    o[6] = gelu_tanh(a1[2] + d1[2] * bf_lo(uu.w)) * bf_lo(sg.w); o[7] = gelu_tanh(a1[3] + d1[3] * bf_hi(uu.w)) * bf_hi(sg.w);
                    float ss = (o[0] * o[0] + o[1] * o[1]) + (o[2] * o[2] + o[3] * o[3]) + (o[4] * o[4] + o[5] * o[5]) + (o[6] * o[6] + o[7] * o[7]);
                    u32x4 w; w.x = cvt_pk_bf16(o[0], o[1]); w.y = cvt_pk_bf16(o[2], o[3]); w.z = cvt_pk_bf16(o[4], o[5]); w.w = cvt_pk_bf16(o[6], o[7]);
                    *(u32x4*)(Y + (size_t)token * DM + ch) = w;
                    ss += __shfl_xor(ss, 16);
                    if ((fq & 1) == 0) PA[(size_t)token * 64 + g] = ss;
                    asm volatile("" ::: "memory"); __builtin_amdgcn_sched_barrier(0);
                }
        }
    }
};
struct EpiOut {
    static constexpr bool PERM = true, HAS_MID = true, AFTER_DRAIN = false;
    const float* x; bf16_t* H1B; float* P2; const LAS f32x2* tab;
    __device__ __forceinline__ void mid(f32x4 (&acc)[2][2][4][2], int ui, int wr, int fr) const {
#pragma unroll
        for (int ai = 0; ai < 2; ++ai)
#pragma unroll
            for (int m = 0; m < 4; ++m) { const float s = tab[ui * 256 + ai * 128 + wr * 64 + m * 16 + fr].x;
#pragma unroll
                for (int bj = 0; bj < 2; ++bj)
#pragma unroll
                    for (int n = 0; n < 2; ++n) acc[ai][bj][m][n] *= s; }
    }
    __device__ __forceinline__ void operator()(const f32x4 (&acc)[2][2][4][2], const Unit& u, int ui, int wr, int wc, int fr, int fq) const {
        asm volatile("" : "+v"(fr), "+v"(fq));
        const int colw = u.pn * 256 + wc * 32 + 8 * fq;
#pragma unroll
        for (int ai = 0; ai < 2; ++ai) {
            f32x4 xr[4][2][2];
#pragma unroll
            for (int m = 0; m < 4; ++m) { const float* xp = x + (size_t)(u.pm * 256 + ai * 128 + wr * 64 + m * 16 + fr) * DM + colw;
#pragma unroll
                for (int bj = 0; bj < 2; ++bj) { xr[m][bj][0] = *(const f32x4*)(xp + bj * 128); xr[m][bj][1] = *(const f32x4*)(xp + bj * 128 + 4); } }
#pragma unroll
            for (int m = 0; m < 4; ++m) {
                const int rl = ai * 128 + wr * 64 + m * 16 + fr, row = u.pm * 256 + rl; const float rb = tab[ui * 256 + rl].y; float ss = 0.f;
#pragma unroll
                for (int bj = 0; bj < 2; ++bj) {
                    const size_t off = (size_t)row * DM + colw + bj * 128;
                    const f32x4 h0 = xr[m][bj][0] + acc[ai][bj][m][0] * rb, hv1 = xr[m][bj][1] + acc[ai][bj][m][1] * rb;
                    ss += (h0[0] * h0[0] + h0[1] * h0[1]) + (h0[2] * h0[2] + h0[3] * h0[3]) + (hv1[0] * hv1[0] + hv1[1] * hv1[1]) + (hv1[2] * hv1[2] + hv1[3] * hv1[3]);
                    u32x4 w; w.x = cvt_pk_bf16(h0[0], h0[1]); w.y = cvt_pk_bf16(h0[2], h0[3]); w.z = cvt_pk_bf16(hv1[0], hv1[1]); w.w = cvt_pk_bf16(hv1[2], hv1[3]);
                    *(u32x4*)(H1B + off) = w;
                }
                ss += __shfl_xor(ss, 16); ss += __shfl_xor(ss, 32);
                if (fq == 0) P2[(size_t)row * 32 + u.pn * 4 + wc] = ss;
            }
            asm volatile("" ::: "memory");
        }
    }
};
struct EpiFF1 {
    static constexpr bool PERM = true, HAS_MID = false, AFTER_DRAIN = false;
    bf16_t* HID; const LAS float* tab;
    __device__ __forceinline__ void operator()(const f32x4 (&acc)[2][2][4][2], const Unit& u, int ui, int wr, int wc, int fr, int fq) const {
#pragma unroll
        for (int ai = 0; ai < 2; ++ai)
#pragma unroll
            for (int m = 0; m < 4; ++m) {
                const int rl = ai * 128 + wr * 64 + m * 16 + fr, row = u.pm * 256 + rl; const float r2 = tab[ui * 256 + rl];
#pragma unroll
                for (int bj = 0; bj < 2; ++bj) {
                    f32x4 v0 = acc[ai][bj][m][0] * r2, v1 = acc[ai][bj][m][1] * r2;
#pragma unroll
                    for (int j = 0; j < 4; ++j) { const float a = fmaxf(v0[j], 0.f), b = fmaxf(v1[j], 0.f); v0[j] = a * a; v1[j] = b * b; }
                    u32x4 w; w.x = cvt_pk_bf16(v0[0], v0[1]); w.y = cvt_pk_bf16(v0[2], v0[3]); w.z = cvt_pk_bf16(v1[0], v1[1]); w.w = cvt_pk_bf16(v1[2], v1[3]);
                    *(u32x4*)(HID + (size_t)row * LDH + u.pn * 256 + bj * 128 + wc * 32 + 8 * fq) = w;
                }
            }
    }
};
struct EpiFF2 {
    static constexpr bool PERM = true, HAS_MID = false, AFTER_DRAIN = false;
    bf16_t* h; float* P3;
    __device__ __forceinline__ void operator()(const f32x4 (&acc)[2][2][4][2], const Unit& u, int ui, int wr, int wc, int fr, int fq) const {
#pragma unroll
        for (int ai = 0; ai < 2; ++ai)
#pragma unroll
            for (int m = 0; m < 4; ++m) {
                const int row = u.pm * 256 + ai * 128 + wr * 64 + m * 16 + fr; float ss = 0.f;
#pragma unroll
                for (int bj = 0; bj < 2; ++bj) {
                    const size_t off = (size_t)row * DM + u.pn * 256 + bj * 128 + wc * 32 + 8 * fq;
                    const u32x4 hb = *(const u32x4*)(h + off); const f32x4 a0 = acc[ai][bj][m][0], a1 = acc[ai][bj][m][1];
                    const float o0 = bf_lo(hb.x) + a0[0], o1 = bf_hi(hb.x) + a0[1], o2 = bf_lo(hb.y) + a0[2], o3 = bf_hi(hb.y) + a0[3];
                    const float o4 = bf_lo(hb.z) + a1[0], o5 = bf_hi(hb.z) + a1[1], o6 = bf_lo(hb.w) + a1[2], o7 = bf_hi(hb.w) + a1[3];
                    ss += (o0 * o0 + o1 * o1) + (o2 * o2 + o3 * o3) + (o4 * o4 + o5 * o5) + (o6 * o6 + o7 * o7);
                    u32x4 w; w.x = cvt_pk_bf16(o0, o1); w.y = cvt_pk_bf16(o2, o3); w.z = cvt_pk_bf16(o4, o5); w.w = cvt_pk_bf16(o6, o7);
                    *(u32x4*)(h + off) = w;
                }
                ss += __shfl_xor(ss, 16); ss += __shfl_xor(ss, 32);
                if (fq == 0) P3[(size_t)row * 32 + u.pn * 4 + wc] = ss;
            }
    }
};

struct PanelOrder {
    int c;
    __device__ bool next(int i, Unit& u) const { if (i >= 2) return false; const int x = c & 7, j = c >> 3; u.pm = i * 32 + x * 4 + (j >> 3); u.pn = j & 7; return true; }
};
struct EpiFF2N {
    static constexpr bool PERM = true, HAS_MID = false, AFTER_DRAIN = false;
    const bf16_t* h1; float* out; const float* gain; float* P3; unsigned* cnt;
    __device__ __forceinline__ void operator()(f32x4 (&acc)[2][2][4][2], const Unit& u, int ui, int wr, int wc, int fr, int fq) const {
        asm volatile("" : "+v"(fr), "+v"(fq));
        const int colw = u.pn * 256 + wc * 32 + 8 * fq;
#pragma unroll
        for (int ai = 0; ai < 2; ++ai)
#pragma unroll
            for (int m = 0; m < 4; ++m) {
                const int row = u.pm * 256 + ai * 128 + wr * 64 + m * 16 + fr; float ss = 0.f;
#pragma unroll
                for (int bj = 0; bj < 2; ++bj) {
                    const u32x4 hb = *(const u32x4*)(h1 + (size_t)row * DM + colw + bj * 128);
                    f32x4& a0 = acc[ai][bj][m][0]; f32x4& a1 = acc[ai][bj][m][1];
                    a0[0] += bf_lo(hb.x); a0[1] += bf_hi(hb.x); a0[2] += bf_lo(hb.y); a0[3] += bf_hi(hb.y);
                    a1[0] += bf_lo(hb.z); a1[1] += bf_hi(hb.z); a1[2] += bf_lo(hb.w); a1[3] += bf_hi(hb.w);
                    ss += (a0[0] * a0[0] + a0[1] * a0[1]) + (a0[2] * a0[2] + a0[3] * a0[3]) + (a1[0] * a1[0] + a1[1] * a1[1]) + (a1[2] * a1[2] + a1[3] * a1[3]);
                }
                ss += __shfl_xor(ss, 16); ss += __shfl_xor(ss, 32);
                if (fq == 0) __hip_atomic_store(P3 + (size_t)row * 32 + u.pn * 4 + wc, ss, __ATOMIC_RELAXED, __HIP_MEMORY_SCOPE_AGENT);
            }
        asm volatile("s_waitcnt vmcnt(0)" ::: "memory");
        unsigned* cp = cnt + 64 * u.pm;
        if ((fr | fq) == 0) __hip_atomic_fetch_add(cp, 1u, __ATOMIC_RELAXED, __HIP_MEMORY_SCOPE_AGENT);
        { unsigned sp = 0;
          while ((unsigned)__builtin_amdgcn_readfirstlane(__hip_atomic_load(cp, __ATOMIC_RELAXED, __HIP_MEMORY_SCOPE_AGENT)) < 64u) { __builtin_amdgcn_s_sleep(2); if (++sp > (1u << 22)) break; } }
        __builtin_amdgcn_fence(__ATOMIC_ACQUIRE, "agent");
        f32x4 g[2][2];
#pragma unroll
        for (int bj = 0; bj < 2; ++bj) { g[bj][0] = *(const f32x4*)(gain + colw + bj * 128); g[bj][1] = *(const f32x4*)(gain + colw + bj * 128 + 4); }
#pragma unroll
        for (int ai = 0; ai < 2; ++ai)
#pragma unroll
            for (int m = 0; m < 4; ++m) {
                const int row = u.pm * 256 + ai * 128 + wr * 64 + m * 16 + fr;
                const unsigned long long* pr = (const unsigned long long*)(P3 + (size_t)row * 32 + fq * 8); float s = 0.f;
#pragma unroll
                for (int k = 0; k < 4; ++k) { const unsigned long long w = __hip_atomic_load(pr + k, __ATOMIC_RELAXED, __HIP_MEMORY_SCOPE_AGENT); s += __uint_as_float((unsigned)w) + __uint_as_float((unsigned)(w >> 32)); }
                s += __shfl_xor(s, 16); s += __shfl_xor(s, 32);
                const float r = 1.0f / sqrtf(s * (1.0f / DM) + EPS);
#pragma unroll
                for (int bj = 0; bj < 2; ++bj) { float* op = out + (size_t)row * DM + colw + bj * 128;
                    *(f32x4*)op = acc[ai][bj][m][0] * r * g[bj][0]; *(f32x4*)(op + 4) = acc[ai][bj][m][1] * r * g[bj][1]; }
                asm volatile("" ::: "memory");
            }
    }
};

__device__ __forceinline__ float wave_sum(float v) {
#pragma unroll
    for (int o = 1; o < 64; o <<= 1) v += __shfl_xor(v, o);
    return v;
}
__device__ __forceinline__ void p0_transpose_item(const float* W, int K, int N, bf16_t* WT, const float* gain, const float* gain_hi, LAS float* scr, int item, int lane, int ldw = 0) {
    if (ldw == 0) ldw = K;
    const int nblk = N / 32, kb = item / nblk, nb = item % nblk, k0 = 64 * kb, n0 = 32 * nb;
    const float* gk = gain ? ((gain_hi && k0 >= 1024) ? gain_hi + (k0 - 1024) : gain + k0) : nullptr;
    float wv[32];
#pragma unroll
    for (int i = 0; i < 32; ++i) wv[i] = W[(size_t)(k0 + 2 * i + (lane >> 5)) * N + n0 + (lane & 31)];
#pragma unroll
    for (int i = 0; i < 32; ++i) { const int kk = 2 * i + (lane >> 5); float v = wv[i]; if (gk) v *= gk[kk]; scr[kk * 33 + (lane & 31)] = v; }
    asm volatile("s_waitcnt lgkmcnt(0)" ::: "memory");
    const int c = lane & 7;
#pragma unroll
    for (int j = 0; j < 4; ++j) { const int n = (lane >> 3) + 8 * j; const LAS float* s = scr + (8 * c) * 33 + n;
        u32x4 o; o.x = cvt_pk_bf16(s[0 * 33], s[1 * 33]); o.y = cvt_pk_bf16(s[2 * 33], s[3 * 33]); o.z = cvt_pk_bf16(s[4 * 33], s[5 * 33]); o.w = cvt_pk_bf16(s[6 * 33], s[7 * 33]);
        *(u32x4*)(WT + (size_t)(n0 + n) * ldw + k0 + 8 * c) = o; }
    asm volatile("s_waitcnt lgkmcnt(0)" ::: "memory");
}
__device__ __forceinline__ f32x2 cpow_k(float lre, float lim, float dt, int k) {
    const float mag = expf((float)k * lre * dt);
    const double rev = (double)k * (double)lim * (double)dt * 0.15915494309189535;
    const float fr = (float)(rev - rint(rev));
    return (f32x2){mag * __builtin_amdgcn_cosf(fr), mag * __builtin_amdgcn_sinf(fr)};
}

#define RLX_AGENT __ATOMIC_RELAXED, __HIP_MEMORY_SCOPE_AGENT
#define XB_TMO      128
#define XB_XCNT(j)  (256  + 64 * (j))
#define XB_XSUB(j)  (1280 + 64 * (j))
#define XB_XGEN(j)  (2304 + 64 * (j))
#define XB_TOP      3328
#define XB_TOPGEN   3392
#define XCD_BAR_WORDS 3456
#define XB_SPIN_CAP (1u << 22)
__device__ __forceinline__ unsigned xb_ld(unsigned* p)              { return __hip_atomic_load(p, __ATOMIC_RELAXED, __HIP_MEMORY_SCOPE_AGENT); }
__device__ __forceinline__ unsigned xb_add(unsigned* p, unsigned v) { return __hip_atomic_fetch_add(p, v, __ATOMIC_RELAXED, __HIP_MEMORY_SCOPE_AGENT); }
__device__ __forceinline__ unsigned xb_xcc_id() { return (unsigned)__builtin_amdgcn_s_getreg((3 << 11) | 20) & 0xFu; }
#define XB_SPIN(cond, bar) do { unsigned _sp = 0; while (cond) { __builtin_amdgcn_s_sleep(1); \
    if ((++_sp & 255u) == 0u) { if (xb_ld(&(bar)[XB_TMO])) break; if (_sp > XB_SPIN_CAP) { atomicAdd(&(bar)[XB_TMO], 1u); break; } } } } while (0)
struct XcdBarrier { unsigned* bar; unsigned x; volatile LAS unsigned* st; };
__device__ __forceinline__ XcdBarrier xcd_barrier_post(unsigned* bar, volatile LAS unsigned* st) {
    XcdBarrier b; b.bar = bar; b.x = xb_xcc_id(); b.st = st;
    if (threadIdx.x == 0) (void)xb_add(&bar[XB_XCNT(b.x)], 1u);
    return b;
}
__device__ __forceinline__ void xcd_barrier_complete(unsigned* bar, unsigned x, unsigned& nloc, unsigned& nx) {
    const unsigned G = gridDim.x * gridDim.y * gridDim.z;
    unsigned sum, cnt, mine, sp = 0u;
    for (;;) {
        sum = 0u; cnt = 0u; mine = 0u;
#pragma unroll
        for (unsigned j = 0; j < 16; ++j) { const unsigned c = xb_ld(&bar[XB_XCNT(j)]); sum += c; cnt += (c > 0u) ? 1u : 0u; mine = (j == x) ? c : mine; }
        if (sum == G) break;
        __builtin_amdgcn_s_sleep(1);
        if ((++sp & 255u) == 0u) { if (xb_ld(&bar[XB_TMO])) break; if (sp > XB_SPIN_CAP) { atomicAdd(&bar[XB_TMO], 1u); break; } }
    }
    nloc = mine > 0u ? mine : 1u; nx = cnt > 0u ? cnt : 1u;
}
__device__ __forceinline__ void xcd_barrier(const XcdBarrier& b) {
    asm volatile("s_waitcnt vmcnt(0)" ::: "memory");
    __syncthreads();
    if (threadIdx.x == 0) {
        unsigned* bar = b.bar;
        __builtin_amdgcn_s_waitcnt(0);
        unsigned nloc = b.st[0], nx = b.st[1];
        if (nloc == 0u) { xcd_barrier_complete(bar, b.x, nloc, nx); b.st[0] = nloc; b.st[1] = nx; }
        const unsigned old = xb_add(&bar[XB_XSUB(b.x)], 1u);
        const unsigned gen = old / nloc;
        if (old + 1u == (gen + 1u) * nloc) {
            __builtin_amdgcn_fence(__ATOMIC_RELEASE, "agent");
            asm volatile("s_waitcnt vmcnt(0)" ::: "memory");
            const unsigned og = xb_add(&bar[XB_TOP], 1u);
            const unsigned tg = og / nx;
            if (og + 1u == (tg + 1u) * nx) xb_add(&bar[XB_TOPGEN], 1u);
            else XB_SPIN(xb_ld(&bar[XB_TOPGEN]) == tg, bar);
            __builtin_amdgcn_fence(__ATOMIC_ACQUIRE, "agent");
            xb_add(&bar[XB_XGEN(b.x)], 1u);
            asm volatile("s_waitcnt vmcnt(0)" ::: "memory");
        } else {
            XB_SPIN(xb_ld(&bar[XB_XGEN(b.x)]) == gen, bar);
            __builtin_amdgcn_fence(__ATOMIC_ACQUIRE, "agent");
            asm volatile("s_waitcnt vmcnt(0)" ::: "memory");
        }
    }
    __syncthreads();
}

struct Params { const float* in[21]; float* out; unsigned char* ws; int ph_lo, ph_hi; };

__device__ __forceinline__ void p0_ssm_task(const Params& p, LAS unsigned char* lds, int g, int d, int tid) {
    LAS float* coef = (LAS float*)lds;
    LAS float* pd = coef + 128;
    LAS float* pd1 = pd + 128;
    LAS float* wre = pd1 + 128;
    LAS float* wim = wre + 1024;
    LAS float* cre = wim + 1024;
    LAS float* cim = cre + 1024;
    const float* a_re = p.in[2]; const float* a_im = p.in[3]; const float* log_dt = p.in[4];
    const float* b_re = p.in[5]; const float* b_im = p.in[6]; const float* c_re = p.in[7]; const float* c_im = p.in[8];
    bf16_t* TmE = (bf16_t*)(p.ws + WS_TME) + (size_t)g * 256 * KA;
    bf16_t* Ft = (bf16_t*)(p.ws + WS_FT) + (size_t)g * 256 * 256;
    if (tid < 64) {
        const int n = tid; const float dt = expf(log_dt[g]); const float lre = fminf(a_re[g * 64 + n], -1e-4f), lim = a_im[g * 64 + n];
        const f32x2 ab = cpow_k(lre, lim, dt, 1);
        const float den = lre * lre + lim * lim, nre = ab.x - 1.0f;
        coef[2 * n] = (nre * lre + ab.y * lim) / den; coef[2 * n + 1] = (ab.y * lre - nre * lim) / den;
        const f32x2 q = cpow_k(lre, lim, dt, d), q1 = cpow_k(lre, lim, dt, d + 1);
        pd[2 * n] = q.x; pd[2 * n + 1] = q.y; pd1[2 * n] = q1.x; pd1[2 * n + 1] = q1.y;
        if (d == 0) { const f32x2 q16 = cpow_k(lre, lim, dt, 16); *(f32x2*)((float*)(p.ws + WS_A16) + (size_t)(g * 64 + n) * 2) = q16; }
    }
    __syncthreads();
    for (int idx = tid; idx < 1024; idx += NTHR) {
        const int n = idx >> 4;
        const float br = b_re[(size_t)g * 1024 + idx], bi = b_im[(size_t)g * 1024 + idx], cr = coef[2 * n], ci = coef[2 * n + 1];
        const float bbr = cr * br - ci * bi, bbi = cr * bi + ci * br, pr = pd[2 * n], pi = pd[2 * n + 1];
        wre[idx] = pr * bbr - pi * bbi; wim[idx] = pr * bbi + pi * bbr;
        cre[idx] = c_re[(size_t)g * 1024 + idx]; cim[idx] = c_im[(size_t)g * 1024 + idx];
    }
    __syncthreads();
    if (tid < 256) {
        const int h = tid >> 4, h2 = tid & 15; float s = 0.f;
#pragma unroll 8
        for (int n = 0; n < 64; ++n) s += cre[h * 64 + n] * wre[n * 16 + h2] - cim[h * 64 + n] * wim[n * 16 + h2];
        const bf16_t kb = (bf16_t)(cvt_pk_bf16(s, 0.f) & 0xffffu);
        for (int t = d; t < 16; ++t) TmE[(size_t)(t * 16 + h) * KA + (t - d) * 16 + h2] = kb;
        if (d > 0) for (int t = 0; t < 16 - d; ++t) TmE[(size_t)(t * 16 + h) * KA + (t + d) * 16 + h2] = 0;
    } else {
        const int q = tid - 256;
#pragma unroll
        for (int r = 0; r < 4; ++r) {
            const int idx = q + 256 * r;
            { const int h = idx >> 6, n = idx & 63; const float pr = pd1[2 * n], pi = pd1[2 * n + 1], cr = cre[h * 64 + n], ci = cim[h * 64 + n];
              const unsigned w = cvt_pk_bf16(cr * pr - ci * pi, -(cr * pi + ci * pr));
              bf16_t* rowp = TmE + (size_t)(d * 16 + h) * KA + 256; rowp[n] = (bf16_t)(w & 0xffffu); rowp[64 + n] = (bf16_t)(w >> 16); }
            { const int n = idx >> 4, h2 = idx & 15, col = (15 - d) * 16 + h2; const unsigned w = cvt_pk_bf16(wre[idx], wim[idx]);
              Ft[(size_t)n * 256 + col] = (bf16_t)(w & 0xffffu); Ft[(size_t)(64 + n) * 256 + col] = (bf16_t)(w >> 16);
              Ft[(size_t)(128 + n) * 256 + col] = 0; Ft[(size_t)(192 + n) * 256 + col] = 0; }
        }
    }
    __syncthreads();
}

__device__ __forceinline__ void sgu_unit(const Params& p, LAS unsigned char* lds, int unit, int tid) {
    constexpr int LDT = 136;
    LAS bf16_t* At = (LAS bf16_t*)lds;
    LAS bf16_t* Bt = (LAS bf16_t*)(lds + 128 * LDT * 2);
    LAS float* rvs = (LAS float*)(lds + 2 * 128 * LDT * 2);
    const int h = unit & 7, bnb = unit >> 3, tok0 = bnb * 128;
    const float* PV = (const float*)(p.ws + WS_PV); const bf16_t* VB = (const bf16_t*)(p.ws + WS_VB); const bf16_t* UB = (const bf16_t*)(p.ws + WS_UB);
    bf16_t* Y = (bf16_t*)(p.ws + WS_Y); float* PB = (float*)(p.ws + WS_PB);
    const float* vgain = p.in[10]; const float* sw = p.in[11] + (size_t)h * 128 * 128; const float* sb = p.in[12] + h * 128;
    if (tid < 128) { const f32x4* pp = (const f32x4*)(PV + (size_t)(tok0 + tid) * 16); const f32x4 a = pp[0], b = pp[1], c = pp[2], d = pp[3];
        const float s = ((a[0] + a[1]) + (a[2] + a[3])) + ((b[0] + b[1]) + (b[2] + b[3])) + ((c[0] + c[1]) + (c[2] + c[3])) + ((d[0] + d[1]) + (d[2] + d[3]));
        rvs[tid] = 1.0f / sqrtf(s * (1.0f / 1024.0f) + EPS); }
    __syncthreads();
#pragma unroll
    for (int q = 0; q < 4; ++q) {
        const int pc = tid + NTHR * q, r = pc >> 4, c0 = (pc & 15) * 8;
        {
            const bool on = (c0 >> 6) <= (r >> 6);
            const f32x4 w0 = *(const f32x4*)(sw + r * 128 + c0), w1 = *(const f32x4*)(sw + r * 128 + c0 + 4);
            const f32x4 r0 = *(const LAS f32x4*)(rvs + c0), r1 = *(const LAS f32x4*)(rvs + c0 + 4);
            u32x4 o;
            if (on) { o.x = cvt_pk_bf16(w0[0] * r0[0], w0[1] * r0[1]); o.y = cvt_pk_bf16(w0[2] * r0[2], w0[3] * r0[3]); o.z = cvt_pk_bf16(w1[0] * r1[0], w1[1] * r1[1]); o.w = cvt_pk_bf16(w1[2] * r1[2], w1[3] * r1[3]); }
            else { o = (u32x4){0u, 0u, 0u, 0u}; }
            *(LAS u32x4*)(At + r * LDT + c0) = o;
        }
        {
            const int rt = pc & 127, ct0 = (pc >> 7) * 8;
            const u32x4 vv = *(const u32x4*)(VB + (size_t)(tok0 + rt) * 1024 + h * 128 + ct0);
            Bt[(ct0 + 0) * LDT + rt] = (bf16_t)(vv.x & 0xffffu); Bt[(ct0 + 1) * LDT + rt] = (bf16_t)(vv.x >> 16);
            Bt[(ct0 + 2) * LDT + rt] = (bf16_t)(vv.y & 0xffffu); Bt[(ct0 + 3) * LDT + rt] = (bf16_t)(vv.y >> 16);
            Bt[(ct0 + 4) * LDT + rt] = (bf16_t)(vv.z & 0xffffu); Bt[(ct0 + 5) * LDT + rt] = (bf16_t)(vv.z >> 16);
            Bt[(ct0 + 6) * LDT + rt] = (bf16_t)(vv.w & 0xffffu); Bt[(ct0 + 7) * LDT + rt] = (bf16_t)(vv.w >> 16);
        }
    }
    __syncthreads();
    const int w = tid >> 6, lane = tid & 63, fr = lane & 15, fq = lane >> 4;
    bf16x8 wf[4];
#pragma unroll
    for (int ks = 0; ks < 4; ++ks) wf[ks] = *(const LAS bf16x8*)(At + (16 * w + fr) * LDT + ks * 32 + fq * 8);
    const int i = 16 * w + fr; const size_t tok = (size_t)(tok0 + i); const float bsi = sb[i]; float ss = 0.f;
#pragma unroll
    for (int ct = 0; ct < 8; ++ct) {
        f32x4 acc = (f32x4){0.f, 0.f, 0.f, 0.f};
#pragma unroll
        for (int ks = 0; ks < 4; ++ks) { const bf16x8 vf = *(const LAS bf16x8*)(Bt + (16 * ct + fr) * LDT + ks * 32 + fq * 8); acc = __builtin_amdgcn_mfma_f32_16x16x32_bf16(vf, wf[ks], acc, 0, 0, 0); }
        const int c = 16 * ct + 4 * fq;
        const u32x2 uu = *(const u32x2*)(UB + tok * 1024 + h * 128 + c); const f32x4 vg = *(const f32x4*)(vgain + h * 128 + c);
        const float o0 = bf_lo(uu.x) * (vg[0] * acc[0] + bsi), o1 = bf_hi(uu.x) * (vg[1] * acc[1] + bsi), o2 = bf_lo(uu.y) * (vg[2] * acc[2] + bsi), o3 = bf_hi(uu.y) * (vg[3] * acc[3] + bsi);
        ss += (o0 * o0 + o1 * o1) + (o2 * o2 + o3 * o3);
        u32x2 wv; wv.x = cvt_pk_bf16(o0, o1); wv.y = cvt_pk_bf16(o2, o3);
        *(u32x2*)(Y + tok * DM + DSSM + h * 128 + c) = wv;
    }
    ss += __shfl_xor(ss, 16); ss += __shfl_xor(ss, 32);
    if (fq == 0) PB[tok * 8 + h] = ss;
    __syncthreads();
}

__device__ __forceinline__ void carry_task(const Params& p, int g, int tid) {
    const int b = tid >> 6, n = tid & 63;
    const float* S = (const float*)(p.ws + WS_S); bf16_t* Ap = (bf16_t*)(p.ws + WS_AP);
    const f32x2 a16 = *(const f32x2*)((const float*)(p.ws + WS_A16) + (size_t)(g * 64 + n) * 2);
    float hr = 0.f, hi = 0.f; const size_t row0 = (size_t)g * 1024 + b * 128;
#pragma unroll 8
    for (int c = 0; c < NCH; ++c) {
        const size_t row = row0 + c; const float sr = S[row * 128 + n], si = S[row * 128 + 64 + n];
        const unsigned w = cvt_pk_bf16(hr, hi);
        Ap[row * KA + 256 + n] = (bf16_t)(w & 0xffffu); Ap[row * KA + 320 + n] = (bf16_t)(w >> 16);
        const float nr = a16.x * hr - a16.y * hi + sr, ni = a16.x * hi + a16.y * hr + si; hr = nr; hi = ni;
    }
}

__device__ __forceinline__ void convert_share(const Params& p, LAS unsigned char* lds, int sel, int gw, int NGW, int wave, int lane) {
    LAS float* scr = (LAS float*)(lds + wave * 16384); unsigned char* ws = p.ws;
    constexpr int I_OUT = (DM / 64) * (DM / 32), I_1 = (DM / 64) * (DFF / 32), I_2 = (DFF / 64) * (DM / 32);
    if (sel == 0) {
        for (int it = gw; it < I_OUT + I_1; it += NGW) {
            if (it < I_OUT) p0_transpose_item(p.in[15], DM, DM, (bf16_t*)(ws + WS_WOUT), p.in[13], p.in[14], scr, it, lane);
            else p0_transpose_item(p.in[18], DM, DFF, (bf16_t*)(ws + WS_W1), p.in[17], nullptr, scr, it - I_OUT, lane);
        }
    } else {
        for (int it = gw; it < I_2; it += NGW) p0_transpose_item(p.in[19], DFF, DM, (bf16_t*)(ws + WS_W2P), nullptr, nullptr, scr, it, lane, LDH);
    }
}

__global__ void __launch_bounds__(NTHR, 2) fwd_megakernel(Params p) {
    extern __shared__ __attribute__((aligned(16))) unsigned char lds_raw[];
    LAS unsigned char* lds = (LAS unsigned char*)lds_raw;
    cg::grid_group grid = cg::this_grid();
    const int tid = threadIdx.x, lane = tid & 63, wave = __builtin_amdgcn_readfirstlane(tid >> 6);
    const int G = gridDim.x, bx = blockIdx.x;
    const int lo = p.ph_lo, hi = p.ph_hi;
    unsigned char* ws = p.ws;
#ifndef PH_MASK
#define PH_MASK 0x7f
#endif
#define IN(k) (((PH_MASK >> (k)) & 1) && lo <= (k) && (k) < hi)
    volatile LAS unsigned* MISC = (volatile LAS unsigned*)(lds + MISC_OFF);
    if (tid < 64) MISC[tid] = 0u;
    __syncthreads();
    XcdBarrier xbar = xcd_barrier_post((unsigned*)ws, MISC);
#define SEAM(k) do { if (IN(k) && IN((k) + 1)) xcd_barrier(xbar); } while (0)
    if (hi > 64) grid.sync();

    if (IN(0)) {
        for (int t = bx; t < NG * 16; t += G) p0_ssm_task(p, lds, t >> 4, t & 15, tid);
        LAS float* scr = (LAS float*)(lds + wave * 16384);
        const int gw = bx * NWAVES + wave, NGW = G * NWAVES;
        constexpr int I_IN = (DM / 64) * (DIN / 32);
        for (int it = gw; it < I_IN; it += NGW) p0_transpose_item(p.in[1], DM, DIN, (bf16_t*)(ws + WS_WIN), nullptr, nullptr, scr, it, lane);
        const float* x = p.in[0]; const float* mg = p.in[16]; bf16_t* XN = (bf16_t*)(ws + WS_XN);
        for (int m = gw; m < M; m += NGW) {
            const f32x4* xr = (const f32x4*)(x + (size_t)m * DM) + lane; f32x4 v[8]; float s = 0.f;
#pragma unroll
            for (int j = 0; j < 8; ++j) { v[j] = xr[64 * j]; s += (v[j][0] * v[j][0] + v[j][1] * v[j][1]) + (v[j][2] * v[j][2] + v[j][3] * v[j][3]); }
            const float r = 1.0f / sqrtf(wave_sum(s) * (1.0f / DM) + EPS);
            u32x2* o = (u32x2*)(XN + (size_t)m * DM) + lane;
#pragma unroll
            for (int j = 0; j < 8; ++j) { const f32x4 gg = *((const f32x4*)mg + 64 * j + lane); u32x2 w; w.x = cvt_pk_bf16(v[j][0] * r * gg[0], v[j][1] * r * gg[1]); w.y = cvt_pk_bf16(v[j][2] * r * gg[2], v[j][3] * r * gg[3]); o[64 * j] = w; }
        }
    }
    SEAM(0);
    if (IN(1)) {
        pg8::Gemm g{(const bf16_t*)(ws + WS_XN), (const bf16_t*)(ws + WS_WIN), DM, DM, DM}; pg8::StaticOrder S; S.init(M, DIN, G, bx);
        EpiProj E{(bf16_t*)(ws + WS_AP), (bf16_t*)(ws + WS_SG), (bf16_t*)(ws + WS_UB), (bf16_t*)(ws + WS_VB), (float*)(ws + WS_PV)};
        const bool late = ((bx >> 3) & 1) != 0; const int gw = bx * NWAVES + wave, NGW = G * NWAVES;
        if (late) { convert_share(p, lds, 0, gw, NGW, wave, lane); __syncthreads(); }
        pg8::gemm_phase<EpiProj, pg8::StaticOrder, false>(lds, g, S, E);
        if (!late) convert_share(p, lds, 0, gw, NGW, wave, lane);
    }
    SEAM(1);
    if (IN(2)) {
        pg8::GroupOrder GO; GO.init(G, bx);
        for (int i = 0;; ++i) {
            Unit u; if (!GO.next(i, u)) break;
            pg8::OneUnit S1{u.pm, u.pn};
            { pg8::Gemm g{(const bf16_t*)(ws + WS_AP), (const bf16_t*)(ws + WS_FT), KA, 256, 256}; EpiS E{};
              pg8::gemm_phase<EpiS, pg8::OneUnit, false>(lds, g, S1, E); }
            __syncthreads();
            if (tid < 128) {
                const int b2 = tid >> 6, n = tid & 63; const LAS float* S = (const LAS float*)lds + (b2 * 128) * 132 + n;
                bf16_t* hp = (bf16_t*)(ws + WS_AP) + ((size_t)u.pm * 256 + b2 * 128) * KA + 256 + n;
                const f32x2 a16 = *(const f32x2*)((const float*)(ws + WS_A16) + (size_t)(u.pn * 64 + n) * 2);
                float hr = 0.f, hi = 0.f;
#pragma unroll 8
                for (int c = 0; c < NCH; ++c) {
                    const float sr = S[c * 132], si = S[c * 132 + 64];
                    const unsigned w = cvt_pk_bf16(hr, hi);
                    hp[(size_t)c * KA] = (bf16_t)(w & 0xffffu); hp[(size_t)c * KA + 64] = (bf16_t)(w >> 16);
                    const float nr = a16.x * hr - a16.y * hi + sr, ni = a16.x * hi + a16.y * hr + si; hr = nr; hi = ni;
                }
            }
            asm volatile("s_waitcnt vmcnt(0)" ::: "memory");
            __syncthreads();
            { pg8::Gemm g{(const bf16_t*)(ws + WS_AP), (const bf16_t*)(ws + WS_TME), KA, KA, KA};
              EpiSsm E{(const bf16_t*)(ws + WS_AP), (const bf16_t*)(ws + WS_SG), p.in[9], (bf16_t*)(ws + WS_Y), (float*)(ws + WS_PA)};
              pg8::gemm_phase<EpiSsm, pg8::OneUnit, true>(lds, g, S1, E); }
        }
        for (int uu = bx; uu < 1024; uu += G) sgu_unit(p, lds, uu, tid);
    }
    SEAM(2);
    if (IN(3)) {
        pg8::StaticOrder S; S.init(M, DM, G, bx);
        LAS f32x2* tab = (LAS f32x2*)(lds + TAB_OFF);
        const float* PA = (const float*)(ws + WS_PA); const float* PB = (const float*)(ws + WS_PB);
        for (int idx = tid; idx < TAB_BYTES / 8; idx += NTHR) {
            Unit u; if (!S.next(idx >> 8, u)) break;
            const int row = u.pm * 256 + (idx & 255); const f32x4* pa = (const f32x4*)(PA + (size_t)row * 64); float sa = 0.f;
#pragma unroll
            for (int j = 0; j < 16; ++j) { const f32x4 v = pa[j]; sa += (v[0] + v[1]) + (v[2] + v[3]); }
            const f32x4* pb = (const f32x4*)(PB + (size_t)row * 8); const f32x4 b0 = pb[0], b1 = pb[1]; const float sbb = ((b0[0] + b0[1]) + (b0[2] + b0[3])) + ((b1[0] + b1[1]) + (b1[2] + b1[3]));
            const float ra = 1.0f / sqrtf(sa * (1.0f / 1024.0f) + EPS), rb = 1.0f / sqrtf(sbb * (1.0f / 1024.0f) + EPS);
            tab[idx] = (f32x2){ra / rb, rb};
        }
        __syncthreads();
        pg8::Gemm g{(const bf16_t*)(ws + WS_Y), (const bf16_t*)(ws + WS_WOUT), DM, DM, DM};
        EpiOut E{p.in[0], (bf16_t*)(ws + WS_H1B), (float*)(ws + WS_P2), tab};
        pg8::gemm_phase<EpiOut, pg8::StaticOrder, false>(lds, g, S, E);
    }
    SEAM(3);
    if (IN(4)) {
        pg8::StaticOrder S; S.init(M, DFF, G, bx);
        LAS float* tab = (LAS float*)(lds + TAB_OFF);
        const float* P2 = (const float*)(ws + WS_P2);
        for (int idx = tid; idx < TAB_BYTES / 4; idx += NTHR) {
            Unit u; if (!S.next(idx >> 8, u)) break;
            const int row = u.pm * 256 + (idx & 255); const f32x4* pp = (const f32x4*)(P2 + (size_t)row * 32); float s = 0.f;
#pragma unroll
            for (int j = 0; j < 8; ++j) { const f32x4 v = pp[j]; s += (v[0] + v[1]) + (v[2] + v[3]); }
            tab[idx] = 1.0f / sqrtf(s * (1.0f / DM) + EPS);
        }
        __syncthreads();
        pg8::Gemm g{(const bf16_t*)(ws + WS_H1B), (const bf16_t*)(ws + WS_W1), DM, DM, DM};
        EpiFF1 E{(bf16_t*)(ws + WS_HID), tab};
        const bool late = ((bx >> 3) & 1) != 0; const int gw = bx * NWAVES + wave, NGW = G * NWAVES;
        if (late) { convert_share(p, lds, 1, gw, NGW, wave, lane); __syncthreads(); }
        pg8::gemm_phase<EpiFF1, pg8::StaticOrder, false>(lds, g, S, E);
        if (!late) convert_share(p, lds, 1, gw, NGW, wave, lane);
    }
    SEAM(4);
    const bool fused_norm = (G == 256);
    if (IN(5)) {
        pg8::Gemm g{(const bf16_t*)(ws + WS_HID), (const bf16_t*)(ws + WS_W2P), LDH, LDH, DFF};
        if (fused_norm) {
            PanelOrder S{bx};
            EpiFF2N E{(const bf16_t*)(ws + WS_H1B), p.out, p.in[20], (float*)(ws + WS_P3), (unsigned*)ws + 4096};
            pg8::gemm_phase<EpiFF2N, PanelOrder, true>(lds, g, S, E);
        } else {
            pg8::StaticOrder S; S.init(M, DM, G, bx);
            EpiFF2 E{(bf16_t*)(ws + WS_H1B), (float*)(ws + WS_P3)};
            pg8::gemm_phase<EpiFF2, pg8::StaticOrder, true>(lds, g, S, E);
        }
    }
    if (!fused_norm) SEAM(5);
    if (IN(6) && !fused_norm) {
        const int gw = bx * NWAVES + wave, NGW = G * NWAVES; const float* P3 = (const float*)(ws + WS_P3); const float* fg = p.in[20]; const bf16_t* H2 = (const bf16_t*)(ws + WS_H1B);
        for (int m = gw; m < M; m += NGW) {
            const float ps = (lane < 32) ? P3[(size_t)m * 32 + lane] : 0.f;
            const u32x4* hr = (const u32x4*)(H2 + (size_t)m * DM) + lane; u32x4 hv[4];
#pragma unroll
            for (int j = 0; j < 4; ++j) hv[j] = hr[64 * j];
            const float r = 1.0f / sqrtf(wave_sum(ps) * (1.0f / DM) + EPS);
            f32x4* orow = (f32x4*)(p.out + (size_t)m * DM) + 2 * lane;
#pragma unroll
            for (int j = 0; j < 4; ++j) { const f32x4 g0 = *((const f32x4*)fg + 128 * j + 2 * lane), g1 = *((const f32x4*)fg + 128 * j + 2 * lane + 1);
                f32x4 o0 = {bf_lo(hv[j].x), bf_hi(hv[j].x), bf_lo(hv[j].y), bf_hi(hv[j].y)}, o1 = {bf_lo(hv[j].z), bf_hi(hv[j].z), bf_lo(hv[j].w), bf_hi(hv[j].w)};
                orow[128 * j] = o0 * r * g0; orow[128 * j + 1] = o1 * r * g1; }
        }
    }
#ifdef DBG_STOP
    grid.sync();
    {
        const size_t NT = (size_t)M * DM; const size_t gt = (size_t)bx * NTHR + tid, gs = (size_t)G * NTHR;
        const bf16_t* XN = (const bf16_t*)(ws + WS_XN); const bf16_t* WINp = (const bf16_t*)(ws + WS_WIN); const bf16_t* WOUTp = (const bf16_t*)(ws + WS_WOUT);
        const bf16_t* W1p = (const bf16_t*)(ws + WS_W1); const bf16_t* W2p = (const bf16_t*)(ws + WS_W2); const bf16_t* TMEp = (const bf16_t*)(ws + WS_TME); const bf16_t* FTp = (const bf16_t*)(ws + WS_FT);
        const bf16_t* SGp = (const bf16_t*)(ws + WS_SG); const bf16_t* UBp = (const bf16_t*)(ws + WS_UB); const bf16_t* VBp = (const bf16_t*)(ws + WS_VB); const bf16_t* APp = (const bf16_t*)(ws + WS_AP);
        const bf16_t* Yp = (const bf16_t*)(ws + WS_Y); const bf16_t* H1Bp = (const bf16_t*)(ws + WS_H1B); const bf16_t* HIDp = (const bf16_t*)(ws + WS_HID);
        const float* Sp = (const float*)(ws + WS_S); const float* PVp = (const float*)(ws + WS_PV); const float* PAp = (const float*)(ws + WS_PA); const float* PBp = (const float*)(ws + WS_PB);
        const float* P2p = (const float*)(ws + WS_P2); const float* P3p = (const float*)(ws + WS_P3);
#define BFV(p, i) __uint_as_float(((unsigned)(p)[(i)]) << 16)
        for (size_t i = gt; i < NT; i += gs) {
            float v = 0.f;
            if (DBG_STOP == 0) v = BFV(XN, i) + BFV(WINp, i % (size_t)(DIN * DM)) + BFV(WOUTp, i % (size_t)(DM * DM)) + BFV(W1p, i % (size_t)(DFF * DM)) + BFV(W2p, i % (size_t)(DFF * DM)) + BFV(TMEp, i % (size_t)(64 * 256 * KA)) + BFV(FTp, i % (size_t)(64 * 256 * 256));
            if (DBG_STOP == 1) { const size_t e = i % (size_t)(65536 * 256); v = BFV(SGp, i % (size_t)(M * 1024)) + 0.f * (float)(e & 1); }
            if (DBG_STOP == 2) v = Sp[i % (size_t)(65536 * 128)];
            if (DBG_STOP == 3) { const size_t e = i % (size_t)(65536 * 128), y = i % (size_t)(M * 1024); v = BFV(APp, (e >> 7) * KA + 256 + (e & 127)) + BFV(Yp, (y >> 10) * DM + 1024 + (y & 1023)) + PBp[i % (size_t)(M * 8)]; }
            if (DBG_STOP == 4) { const size_t y = i % (size_t)(M * 1024); v = BFV(Yp, (y >> 10) * DM + (y & 1023)) + PAp[i % (size_t)(M * 64)]; }
            if (DBG_STOP == 5) v = p.out[i] + BFV(H1Bp, i) + P2p[i % (size_t)(M * 32)];
            if (DBG_STOP == 6) v = BFV(HIDp, i) + BFV(HIDp, i + NT) + BFV(HIDp, i + 2 * NT) + BFV(HIDp, i + 3 * NT);
            if (DBG_STOP == 7) v = p.out[i] + P3p[i % (size_t)(M * 32)];
            p.out[i] = v;
        }
    }
#endif
#undef IN
#undef SEAM
}

extern "C" void kernel_launch(void* const* d_in, const int* in_sizes, int n_in, void* d_out, int out_size, void* d_ws, size_t ws_size, hipStream_t stream) {
    static int grid = 0;
    if (grid == 0) {
        if (n_in != 21 || out_size != M * DM || ws_size < WS_END) { fprintf(stderr, "kernel_launch: unexpected shapes (n_in %d, out %d, ws %zu)\n", n_in, out_size, ws_size); grid = -1; return; }
        int dev = 0, cus = 0, per_cu = 0;
        hipGetDevice(&dev); hipDeviceGetAttribute(&cus, hipDeviceAttributeMultiprocessorCount, dev);
        if (hipFuncSetAttribute((const void*)fwd_megakernel, hipFuncAttributeMaxDynamicSharedMemorySize, LDS_BYTES) != hipSuccess) { fprintf(stderr, "kernel_launch: hipFuncSetAttribute failed\n"); grid = -1; return; }
        if (hipOccupancyMaxActiveBlocksPerMultiprocessor(&per_cu, (const void*)fwd_megakernel, NTHR, LDS_BYTES) != hipSuccess || per_cu < 1) { fprintf(stderr, "kernel_launch: occupancy query failed (%d)\n", per_cu); (void)hipGetLastError(); per_cu = 1; }
        grid = cus * per_cu;
        if (grid > 256) grid = 256;
    }
    if (grid < 0) return;
#ifdef DIAG_POISON_WS
    (void)hipMemsetAsync((unsigned char*)d_ws, 0xAA, WS_END, stream);
#endif
    Params p{};
    for (int i = 0; i < 21; ++i) p.in[i] = (const float*)d_in[i];
    p.out = (float*)d_out; p.ws = (unsigned char*)d_ws;
#if MK_MULTI
    for (int ph = 0; ph < 7; ++ph) { p.ph_lo = ph; p.ph_hi = ph + 1; hipLaunchKernelGGL(fwd_megakernel, dim3(grid), dim3(NTHR), LDS_BYTES, stream, p); }
#else
#ifdef DBG_STOP
    p.ph_lo = 0; p.ph_hi = DBG_STOP + 1;
#else
    p.ph_lo = 0; p.ph_hi = 7;
#endif
    (void)hipMemsetAsync(d_ws, 0, 32768, stream);
    void* args[] = {&p};
    hipError_t e = hipLaunchCooperativeKernel((const void*)fwd_megakernel, dim3(grid), dim3(NTHR), args, LDS_BYTES, stream);
    if (e != hipSuccess) fprintf(stderr, "cooperative launch failed: %s (grid %d)\n", hipGetErrorString(e), grid);
#endif
}
```

```cpp
#include <hip/hip_runtime.h>
#include <hip/hip_cooperative_groups.h>
#include <cstdio>
#include <cstdint>
namespace cg = cooperative_groups;

#ifndef MK_MULTI
#define MK_MULTI 0
#endif

#define LAS __attribute__((address_space(3)))
typedef unsigned short bf16_t;
typedef short bf16x8 __attribute__((ext_vector_type(8)));
typedef float f32x4 __attribute__((ext_vector_type(4)));
typedef float f32x2 __attribute__((ext_vector_type(2)));
typedef unsigned u32x4 __attribute__((ext_vector_type(4)));
typedef unsigned u32x2 __attribute__((ext_vector_type(2)));

typedef __bf16 bf16x2_t __attribute__((ext_vector_type(2)));
__device__ __forceinline__ unsigned cvt_pk_bf16(float lo, float hi) { const f32x2 v = {lo, hi}; const bf16x2_t b = __builtin_convertvector(v, bf16x2_t); return __builtin_bit_cast(unsigned, b); }
__device__ __forceinline__ float bf_lo(unsigned w) { return __uint_as_float(w << 16); }
__device__ __forceinline__ float bf_hi(unsigned w) { return __uint_as_float(w & 0xffff0000u); }
__device__ __forceinline__ float gelu_tanh(float x) {
    const float t = x * (1.0f + 0.044715f * x * x);
    const float e = __builtin_amdgcn_exp2f(-2.3022081984f * t);
    return x * __builtin_amdgcn_rcpf(1.0f + e);
}
__device__ __forceinline__ float sigmoid_f(float x) { return __builtin_amdgcn_rcpf(1.0f + __builtin_amdgcn_exp2f(-1.4426950409f * x)); }

namespace pg8 {
constexpr int BM = 256, BK = 64, HALF = 128, HTB = HALF * BK * 2, STAGE_BYTES = 8 * HTB, NXCD = 8, WGM = 8;
__host__ __device__ __forceinline__ int lds_byte(int r, int c) { const int st = (r >> 4) * 2 + (c >> 5), rr = r & 15, cc = c & 31, ob = rr * 64 + cc * 2; return st * 1024 + (ob ^ (((ob >> 9) & 1) << 5)); }
__host__ __device__ __forceinline__ void stage_rc(int b, int& R, int& C) { const int st = b / 1024, sb = b % 1024, swz = sb ^ (((sb >> 9) & 1) << 5); R = (st >> 1) * 16 + swz / 64; C = (st & 1) * 32 + (swz % 64) / 2; }
__host__ __device__ __forceinline__ int perm32(int rho) { const int n = rho >> 4, i = rho & 15; return 8 * (i >> 2) + 4 * n + (i & 3); }

struct Unit { int pm, pn; };
struct Gemm { const bf16_t* A; const bf16_t* Bt; int lda, ldb, K; };

struct StaticOrder {
    int nM, nN, nwg, G, c;
    __device__ void init(int M, int N, int G_, int c_) { nM = M / BM; nN = N / BM; nwg = nM * nN; G = G_; c = c_; }
    __device__ bool next(int i, Unit& u) const {
        const long L = (long)i * G + c; if (L >= nwg) return false;
        int wgid = (int)L; { const int q = nwg / NXCD, r = nwg % NXCD, xcd = wgid % NXCD, off = wgid / NXCD; wgid = (xcd < r ? xcd * (q + 1) : r * (q + 1) + (xcd - r) * q) + off; }
        const int nig = WGM * nN, gid = wgid / nig, fm = gid * WGM, gsz = (nM - fm) < WGM ? (nM - fm) : WGM;
        u.pm = fm + ((wgid % nig) % gsz); u.pn = (wgid % nig) / gsz; return true;
    }
};
struct GroupOrder {
    int G, c;
    __device__ void init(int G_, int c_) { G = G_; c = c_; }
    __device__ bool next(int i, Unit& u) const {
        const int L = i * G + c; if (L >= 256) return false;
        const int Lr = (L & 7) * 32 + (L >> 3); u.pm = Lr; u.pn = Lr >> 2; return true;
    }
};

struct OneUnit { int pm, pn; __device__ bool next(int i, Unit& u) const { if (i != 0) return false; u.pm = pm; u.pn = pn; return true; } };

template <class Epi, class Sched, bool ALIGN_EPI>
__device__ __forceinline__ void gemm_phase(LAS unsigned char* lds, const Gemm g, const Sched& S, const Epi& E) {
    const int tid = threadIdx.x, wid = __builtin_amdgcn_readfirstlane(tid >> 6), lane = tid & 63, wr = wid >> 2, wc = wid & 3, fr = lane & 15, fq = lane >> 4;
    int nt = g.K / BK; asm volatile("" : "+s"(nt));
    unsigned voffA[2], voffB[2];
#pragma unroll
    for (int i = 0; i < 2; ++i) { int R, C; stage_rc(tid * 16 + i * 8192, R, C); const int Rb = Epi::PERM ? ((R & ~31) + perm32(R & 31)) : R;
        voffA[i] = (unsigned)(R * g.lda + C) * 2u; voffB[i] = (unsigned)(Rb * g.ldb + C) * 2u; }
    const size_t kstep = (size_t)(BK * 2);
    const size_t hstepA = (size_t)HALF * g.lda * 2, hstepB = (size_t)HALF * g.ldb * 2;
    const size_t tstepA = 2 * hstepA, tstepB = 2 * hstepB;
    const unsigned ldsw = (unsigned)wid * 1024u;
    const int aoff = lds_byte(wr * 64 + fr, fq * 8), boff = lds_byte(wc * 32 + fr, fq * 8);
#define PG8_SA(b, h) (((b) * 2 + (h)) * HTB)
#define PG8_SB(b, h) ((4 + (b) * 2 + (h)) * HTB)
#define PG8_STAGE(bufoff, gbase, voff) do { _Pragma("unroll") for (int _i = 0; _i < 2; ++_i) \
        __builtin_amdgcn_global_load_lds((const unsigned*)((const char*)(gbase) + (voff)[_i]), (LAS unsigned*)(lds + (bufoff) + ldsw + _i * 8192), 16, 0, 0); } while (0)
#define PG8_LDA(dst, b, h) do { _Pragma("unroll") for (int m = 0; m < 4; ++m) _Pragma("unroll") for (int k = 0; k < 2; ++k) dst[m][k] = *(const LAS bf16x8*)(lds + PG8_SA(b, h) + aoff + m * 2048 + k * 1024); } while (0)
#define PG8_LDB(dst, b, h) do { _Pragma("unroll") for (int n = 0; n < 2; ++n) _Pragma("unroll") for (int k = 0; k < 2; ++k) dst[n][k] = *(const LAS bf16x8*)(lds + PG8_SB(b, h) + boff + n * 2048 + k * 1024); } while (0)
#define PG8_MMA(ai, bj, At, Bt) do { __builtin_amdgcn_s_setprio(1); _Pragma("unroll") for (int m = 0; m < 4; ++m) _Pragma("unroll") for (int n = 0; n < 2; ++n) _Pragma("unroll") for (int k = 0; k < 2; ++k) \
        acc[ai][bj][m][n] = __builtin_amdgcn_mfma_f32_16x16x32_bf16(Bt[n][k], At[m][k], acc[ai][bj][m][n], 0, 0, 0); __builtin_amdgcn_s_setprio(0); } while (0)
#define PG8_WAIT_V(n) asm volatile("s_waitcnt vmcnt(" #n ")" ::: "memory")
#define PG8_WAIT_L(n) asm volatile("s_waitcnt lgkmcnt(" #n ")" ::: "memory")
#define PG8_BAR __builtin_amdgcn_s_barrier()
#define PG8_SCHED __builtin_amdgcn_sched_barrier(0)
    Unit cur, nxt; int ui = 0;
    if (!S.next(0, cur)) return;
    f32x4 acc[2][2][4][2];
#pragma unroll
    for (int a = 0; a < 2; ++a)
#pragma unroll
        for (int b = 0; b < 2; ++b)
#pragma unroll
            for (int m = 0; m < 4; ++m)
#pragma unroll
                for (int n = 0; n < 2; ++n) acc[a][b][m][n] = (f32x4){0.f, 0.f, 0.f, 0.f};
    bf16x8 At[4][2], B0[2][2], B1[2][2];
    const char* cA = (const char*)g.A + (size_t)cur.pm * tstepA; const char* cB = (const char*)g.Bt + (size_t)cur.pn * tstepB;
    PG8_STAGE(PG8_SB(0, 0), cB, voffB); PG8_STAGE(PG8_SB(0, 1), cB + hstepB, voffB); PG8_STAGE(PG8_SA(0, 0), cA, voffA); PG8_STAGE(PG8_SA(0, 1), cA + hstepA, voffA);
    if (wr == 1) PG8_BAR;
    PG8_WAIT_V(2); PG8_BAR;
    PG8_STAGE(PG8_SB(1, 0), cB + kstep, voffB); PG8_STAGE(PG8_SA(1, 0), cA + kstep, voffA); PG8_STAGE(PG8_SB(1, 1), cB + hstepB + kstep, voffB);
    PG8_WAIT_V(6); PG8_BAR;
    for (;;) {
        const bool has_next = S.next(ui + 1, nxt);
        const char* nA = has_next ? (const char*)g.A + (size_t)nxt.pm * tstepA : cA; const char* nB = has_next ? (const char*)g.Bt + (size_t)nxt.pn * tstepB : cB;
#pragma nounroll
        for (int t = 0; t < nt; t += 2) {
            const bool last = (t == nt - 2);
            const char* a1 = cA + (size_t)(t + 1) * kstep;
            const char* a2 = last ? nA : cA + (size_t)(t + 2) * kstep; const char* b2 = last ? nB : cB + (size_t)(t + 2) * kstep;
            const char* a3 = a2 + kstep; const char* b3 = b2 + kstep;
            if constexpr (Epi::HAS_MID) { if (t == (nt >> 1)) E.mid(acc, ui, wr, fr); }
            PG8_LDB(B0, 0, 0); PG8_LDB(B1, 0, 1); PG8_SCHED; PG8_LDA(At, 0, 0); PG8_STAGE(PG8_SA(1, 1), a1 + hstepA, voffA);
            PG8_WAIT_V(8); PG8_WAIT_L(0); PG8_BAR; PG8_MMA(0, 0, At, B0); PG8_MMA(0, 1, At, B1); PG8_BAR; PG8_SCHED;
            PG8_LDA(At, 0, 1); PG8_STAGE(PG8_SB(0, 0), b2, voffB); PG8_STAGE(PG8_SB(0, 1), b2 + hstepB, voffB); PG8_STAGE(PG8_SA(0, 0), a2, voffA);
            PG8_WAIT_V(8); PG8_WAIT_L(0); PG8_BAR; PG8_MMA(1, 0, At, B0); PG8_MMA(1, 1, At, B1); PG8_BAR; PG8_SCHED;
            PG8_LDB(B0, 1, 0); PG8_LDB(B1, 1, 1); PG8_SCHED; PG8_LDA(At, 1, 0); PG8_STAGE(PG8_SA(0, 1), a2 + hstepA, voffA);
            PG8_WAIT_V(8); PG8_WAIT_L(0); PG8_BAR; PG8_MMA(0, 0, At, B0); PG8_MMA(0, 1, At, B1); PG8_BAR; PG8_SCHED;
            PG8_LDA(At, 1, 1); PG8_STAGE(PG8_SB(1, 0), b3, voffB); PG8_STAGE(PG8_SB(1, 1), b3 + hstepB, voffB); PG8_STAGE(PG8_SA(1, 0), a3, voffA);
            PG8_WAIT_V(8); PG8_WAIT_L(0); PG8_BAR; PG8_MMA(1, 0, At, B0); PG8_MMA(1, 1, At, B1); PG8_BAR; PG8_SCHED;
        }
        if constexpr (ALIGN_EPI) { if (wr == 0) PG8_BAR; }
        if constexpr (!Epi::AFTER_DRAIN) E(acc, cur, ui, wr, wc, fr, fq);
        if (!has_next) break;
#pragma unroll
        for (int a = 0; a < 2; ++a)
#pragma unroll
            for (int b = 0; b < 2; ++b)
#pragma unroll
                for (int m = 0; m < 4; ++m)
#pragma unroll
                    for (int n = 0; n < 2; ++n) acc[a][b][m][n] = (f32x4){0.f, 0.f, 0.f, 0.f};
        cur = nxt; cA = nA; cB = nB; ++ui;
        if constexpr (ALIGN_EPI) { if (wr == 1) PG8_BAR; }
    }
    PG8_WAIT_V(0);
    if constexpr (!ALIGN_EPI) { if (wr == 0) PG8_BAR; }
    PG8_BAR;
    if constexpr (Epi::AFTER_DRAIN) E.after(acc, cur, wr, wc, fr, fq, lds);
#undef PG8_SA
#undef PG8_SB
#undef PG8_STAGE
#undef PG8_LDA
#undef PG8_LDB
#undef PG8_MMA
#undef PG8_WAIT_V
#undef PG8_WAIT_L
#undef PG8_BAR
#undef PG8_SCHED
}
}
using pg8::Unit;

constexpr int BATCH = 8, SEQ = 2048, DM = 2048, M = BATCH * SEQ;
constexpr int DSSM = 1024, DSGU = 1024, DIN = 4096, DFF = 8192;
constexpr int LDH = DFF + 64;
constexpr int NG = 64, GS = 16, NS = 64;
constexpr int LC = 16, NCH = SEQ / LC;
constexpr int KA = LC * GS + 2 * NS;
constexpr float EPS = 1e-5f;
constexpr int NWAVES = 8, NTHR = 512;

constexpr size_t MiB = 1u << 20;
constexpr size_t WS_WIN = 1 * MiB, WS_WOUT = 17 * MiB, WS_W1 = 25 * MiB, WS_W2 = 57 * MiB;
constexpr size_t WS_TME = 89 * MiB;
constexpr size_t WS_FT = 101 * MiB;
constexpr size_t WS_A16 = 109 * MiB;
constexpr size_t WS_PV = 110 * MiB;
constexpr size_t WS_PA = 111 * MiB;
constexpr size_t WS_PB = 115 * MiB;
constexpr size_t WS_P2 = 116 * MiB;
constexpr size_t WS_P3 = 118 * MiB;
constexpr size_t WS_H1B = 120 * MiB;
constexpr size_t WS_R1 = 184 * MiB;
constexpr size_t WS_XN = WS_R1;
constexpr size_t WS_S = WS_R1;
constexpr size_t WS_Y = WS_R1 + 64 * MiB;
constexpr size_t WS_AP = WS_R1 + 128 * MiB;
constexpr size_t WS_SG = WS_R1 + 176 * MiB;
constexpr size_t WS_UB = WS_R1 + 208 * MiB;
constexpr size_t WS_VB = WS_R1 + 240 * MiB;
constexpr size_t WS_HID = WS_R1;
constexpr size_t WS_W2P = WS_R1 + 272 * MiB;
constexpr size_t WS_END = WS_W2P + 33 * MiB;

constexpr int RING_BYTES = 131072, TAB_OFF = RING_BYTES, TAB_BYTES = 16384, MISC_OFF = TAB_OFF + TAB_BYTES, LDS_BYTES = MISC_OFF + 256;

struct EpiProj {
    static constexpr bool PERM = true, HAS_MID = false, AFTER_DRAIN = false;
    bf16_t *Ap, *SG, *UB, *VB; float* PV;
    template <int SECT> __device__ __forceinline__ void body(const f32x4 (&acc)[2][2][4][2], const Unit& u, int wr, int wc, int fr, int fq) const {
        const int colt = (u.pn & 3) * 256 + wc * 32 + 8 * fq;
        const int row0 = u.pm * 256 + wr * 64 + fr;
#pragma unroll
        for (int ai = 0; ai < 2; ++ai)
#pragma unroll
            for (int m = 0; m < 4; ++m) {
                const int row = row0 + ai * 128 + m * 16; float ss = 0.f;
#pragma unroll
                for (int bj = 0; bj < 2; ++bj) {
                    const int col8 = colt + bj * 128;
                    f32x4 v0 = acc[ai][bj][m][0], v1 = acc[ai][bj][m][1];
                    if (SECT == 1) {
#pragma unroll
                        for (int j = 0; j < 4; ++j) { v0[j] = sigmoid_f(v0[j]); v1[j] = sigmoid_f(v1[j]); }
                    }
                    if (SECT >= 2) {
#pragma unroll
                        for (int j = 0; j < 4; ++j) { v0[j] = gelu_tanh(v0[j]); v1[j] = gelu_tanh(v1[j]); }
                    }
                    if (SECT == 3) ss += (v0[0] * v0[0] + v0[1] * v0[1]) + (v0[2] * v0[2] + v0[3] * v0[3]) + (v1[0] * v1[0] + v1[1] * v1[1]) + (v1[2] * v1[2] + v1[3] * v1[3]);
                    u32x4 w; w.x = cvt_pk_bf16(v0[0], v0[1]); w.y = cvt_pk_bf16(v0[2], v0[3]); w.z = cvt_pk_bf16(v1[0], v1[1]); w.w = cvt_pk_bf16(v1[2], v1[3]);
                    bf16_t* dst;
                    if (SECT == 0) dst = Ap + ((size_t)((col8 >> 4) * 1024 + (row >> 4)) * KA + (row & 15) * 16 + (col8 & 15));
                    else if (SECT == 1) dst = SG + (size_t)row * 1024 + col8;
                    else if (SECT == 2) dst = UB + (size_t)row * 1024 + col8;
                    else dst = VB + (size_t)row * 1024 + col8;
                    *(u32x4*)dst = w;
                }
                if (SECT == 3) { ss += __shfl_xor(ss, 16); ss += __shfl_xor(ss, 32); if (fq == 0) PV[(size_t)row * 16 + (u.pn & 3) * 4 + wc] = ss; }
            }
    }
    __device__ __forceinline__ void operator()(const f32x4 (&acc)[2][2][4][2], const Unit& u, int ui, int wr, int wc, int fr, int fq) const {
        const int sect = u.pn >> 2;
        if (sect == 0) body<0>(acc, u, wr, wc, fr, fq); else if (sect == 1) body<1>(acc, u, wr, wc, fr, fq);
        else if (sect == 2) body<2>(acc, u, wr, wc, fr, fq); else body<3>(acc, u, wr, wc, fr, fq);
    }
};
struct EpiS {
    static constexpr bool PERM = false, HAS_MID = false, AFTER_DRAIN = true;
    __device__ __forceinline__ void operator()(const f32x4 (&acc)[2][2][4][2], const Unit& u, int ui, int wr, int wc, int fr, int fq) const {}
    __device__ __forceinline__ void after(const f32x4 (&acc)[2][2][4][2], const Unit& u, int wr, int wc, int fr, int fq, LAS unsigned char* lds) const {
        LAS float* S = (LAS float*)lds; const int row0 = wr * 64 + fr, col0 = wc * 32 + 4 * fq;
#pragma unroll
        for (int ai = 0; ai < 2; ++ai)
#pragma unroll
            for (int m = 0; m < 4; ++m) { LAS float* rp = S + (row0 + ai * 128 + m * 16) * 132 + col0;
#pragma unroll
                for (int n = 0; n < 2; ++n) *(LAS f32x4*)(rp + n * 16) = acc[ai][0][m][n]; }
    }
};
struct EpiSsm {
    static constexpr bool PERM = true, HAS_MID = false, AFTER_DRAIN = false;
    const bf16_t *Ap, *SG; const float* dsk; bf16_t* Y; float* PA;
    __device__ __forceinline__ void operator()(const f32x4 (&acc)[2][2][4][2], const Unit& u, int ui, int wr, int wc, int fr, int fq) const {
        asm volatile("" : "+v"(fr), "+v"(fq));
        const int g = u.pn;
#pragma unroll
        for (int bj = 0; bj < 2; ++bj) {
            const int col8 = bj * 128 + wc * 32 + 8 * fq, t = col8 >> 4, hh = col8 & 15, ch = g * 16 + hh;
            const f32x4 d0 = *(const f32x4*)(dsk + ch), d1 = *(const f32x4*)(dsk + ch + 4);
#pragma unroll
            for (int ai = 0; ai < 2; ++ai)
#pragma unroll
                for (int m = 0; m < 4; ++m) {
                    const int R = u.pm * 256 + ai * 128 + wr * 64 + m * 16 + fr, rg = R & 1023, token = (rg >> 7) * SEQ + (rg & 127) * LC + t;
                    const u32x4 uu = *(const u32x4*)(Ap + (size_t)R * KA + t * 16 + hh);
                    const u32x4 sg = *(const u32x4*)(SG + (size_t)token * 1024 + ch);
                    const f32x4 a0 = acc[ai][bj][m][0], a1 = acc[ai][bj][m][1];
                    float o[8];
                    o[0] = gelu_tanh(a0[0] + d0[0] * bf_lo(uu.x)) * bf_lo(sg.x); o[1] = gelu_tanh(a0[1] + d0[1] * bf_hi(uu.x)) * bf_hi(sg.x);
                    o[2] = gelu_tanh(a0[2] + d0[2] * bf_lo(uu.y)) * bf_lo(sg.y); o[3] = gelu_tanh(a0[3] + d0[3] * bf_hi(uu.y)) * bf_hi(sg.y);
                    o[4] = gelu_tanh(a1[0] + d1[0] * bf_lo(uu.z)) * bf_lo(sg.z); o[5] = gelu_tanh(a1[1] + d1[1] * bf_hi(uu.z)) * bf_hi(sg.z);
                    o[6] = gelu_tanh(a1[2] + d1[2] * bf_lo(uu.w)) * bf_lo(sg.w); o[7] = gelu_tanh(a1[3] + d1[3] * bf_hi(uu.w)) * bf_hi(sg.w);
                    float ss = (o[0] * o[0] + o[1] * o[1]) + (o[2] * o[2] + o[3] * o[3]) + (o[4] * o[4] + o[5] * o[5]) + (o[6] * o[6] + o[7] * o[7]);
                    u32x4 w; w.x = cvt_pk_bf16(o[0], o[1]); w.y = cvt_pk_bf16(o[2], o[3]); w.z = cvt_pk_bf16(o[4], o[5]); w.w = cvt_pk_bf16(o[6], o[7]);
                    *(u32x4*)(Y + (size_t)token * DM + ch) = w;
                    ss += __shfl_xor(ss, 16);
                    if ((fq & 1) == 0) PA[(size_t)token * 64 + g] = ss;
                    asm volatile("" ::: "memory"); __builtin_amdgcn_sched_barrier(0);
                }
        }
    }
};
struct EpiOut {
    static constexpr bool PERM = true, HAS_MID = true, AFTER_DRAIN = false;
    const float* x; bf16_t* H1B; float* P2; const LAS f32x2* tab;
    __device__ __forceinline__ void mid(f32x4 (&acc)[2][2][4][2], int ui, int wr, int fr) const {
#pragma unroll
        for (int ai = 0; ai < 2; ++ai)
#pragma unroll
            for (int m = 0; m < 4; ++m) { const float s = tab[ui * 256 + ai * 128 + wr * 64 + m * 16 + fr].x;
#pragma unroll
                for (int bj = 0; bj < 2; ++bj)
#pragma unroll
                    for (int n = 0; n < 2; ++n) acc[ai][bj][m][n] *= s; }
    }
    __device__ __forceinline__ void operator()(const f32x4 (&acc)[2][2][4][2], const Unit& u, int ui, int wr, int wc, int fr, int fq) const {
        asm volatile("" : "+v"(fr), "+v"(fq));
        const int colw = u.pn * 256 + wc * 32 + 8 * fq;
#pragma unroll
        for (int ai = 0; ai < 2; ++ai) {
            f32x4 xr[4][2][2];
#pragma unroll
            for (int m = 0; m < 4; ++m) { const float* xp = x + (size_t)(u.pm * 256 + ai * 128 + wr * 64 + m * 16 + fr) * DM + colw;
#pragma unroll
                for (int bj = 0; bj < 2; ++bj) { xr[m][bj][0] = *(const f32x4*)(xp + bj * 128); xr[m][bj][1] = *(const f32x4*)(xp + bj * 128 + 4); } }
#pragma unroll
            for (int m = 0; m < 4; ++m) {
                const int rl = ai * 128 + wr * 64 + m * 16 + fr, row = u.pm * 256 + rl; const float rb = tab[ui * 256 + rl].y; float ss = 0.f;
#pragma unroll
                for (int bj = 0; bj < 2; ++bj) {
                    const size_t off = (size_t)row * DM + colw + bj * 128;
                    const f32x4 h0 = xr[m][bj][0] + acc[ai][bj][m][0] * rb, hv1 = xr[m][bj][1] + acc[ai][bj][m][1] * rb;
                    ss += (h0[0] * h0[0] + h0[1] * h0[1]) + (h0[2] * h0[2] + h0[3] * h0[3]) + (hv1[0] * hv1[0] + hv1[1] * hv1[1]) + (hv1[2] * hv1[2] + hv1[3] * hv1[3]);
                    u32x4 w; w.x = cvt_pk_bf16(h0[0], h0[1]); w.y = cvt_pk_bf16(h0[2], h0[3]); w.z = cvt_pk_bf16(hv1[0], hv1[1]); w.w = cvt_pk_bf16(hv1[2], hv1[3]);
                    *(u32x4*)(H1B + off) = w;
                }
                ss += __shfl_xor(ss, 16); ss += __shfl_xor(ss, 32);
                if (fq == 0) P2[(size_t)row * 32 + u.pn * 4 + wc] = ss;
            }
            asm volatile("" ::: "memory");
        }
    }
};
struct EpiFF1 {
    static constexpr bool PERM = true, HAS_MID = false, AFTER_DRAIN = false;
    bf16_t* HID; const LAS float* tab;
    __device__ __forceinline__ void operator()(const f32x4 (&acc)[2][2][4][2], const Unit& u, int ui, int wr, int wc, int fr, int fq) const {
#pragma unroll
        for (int ai = 0; ai < 2; ++ai)
#pragma unroll
            for (int m = 0; m < 4; ++m) {
                const int rl = ai * 128 + wr * 64 + m * 16 + fr, row = u.pm * 256 + rl; const float r2 = tab[ui * 256 + rl];
#pragma unroll
                for (int bj = 0; bj < 2; ++bj) {
                    f32x4 v0 = acc[ai][bj][m][0] * r2, v1 = acc[ai][bj][m][1] * r2;
#pragma unroll
                    for (int j = 0; j < 4; ++j) { const float a = fmaxf(v0[j], 0.f), b = fmaxf(v1[j], 0.f); v0[j] = a * a; v1[j] = b * b; }
                    u32x4 w; w.x = cvt_pk_bf16(v0[0], v0[1]); w.y = cvt_pk_bf16(v0[2], v0[3]); w.z = cvt_pk_bf16(v1[0], v1[1]); w.w = cvt_pk_bf16(v1[2], v1[3]);
                    *(u32x4*)(HID + (size_t)row * LDH + u.pn * 256 + bj * 128 + wc * 32 + 8 * fq) = w;
                }
            }
    }
};
struct EpiFF2 {
    static constexpr bool PERM = true, HAS_MID = false, AFTER_DRAIN = false;
    bf16_t* h; float* P3;
    __device__ __forceinline__ void operator()(const f32x4 (&acc)[2][2][4][2], const Unit& u, int ui, int wr, int wc, int fr, int fq) const {
#pragma unroll
        for (int ai = 0; ai < 2; ++ai)
#pragma unroll
            for (int m = 0; m < 4; ++m) {
                const int row = u.pm * 256 + ai * 128 + wr * 64 + m * 16 + fr; float ss = 0.f;
#pragma unroll
                for (int bj = 0; bj < 2; ++bj) {
                    const size_t off = (size_t)row * DM + u.pn * 256 + bj * 128 + wc * 32 + 8 * fq;
                    const u32x4 hb = *(const u32x4*)(h + off); const f32x4 a0 = acc[ai][bj][m][0], a1 = acc[ai][bj][m][1];
                    const float o0 = bf_lo(hb.x) + a0[0], o1 = bf_hi(hb.x) + a0[1], o2 = bf_lo(hb.y) + a0[2], o3 = bf_hi(hb.y) + a0[3];
                    const float o4 = bf_lo(hb.z) + a1[0], o5 = bf_hi(hb.z) + a1[1], o6 = bf_lo(hb.w) + a1[2], o7 = bf_hi(hb.w) + a1[3];
                    ss += (o0 * o0 + o1 * o1) + (o2 * o2 + o3 * o3) + (o4 * o4 + o5 * o5) + (o6 * o6 + o7 * o7);
                    u32x4 w; w.x = cvt_pk_bf16(o0, o1); w.y = cvt_pk_bf16(o2, o3); w.z = cvt_pk_bf16(o4, o5); w.w = cvt_pk_bf16(o6, o7);
                    *(u32x4*)(h + off) = w;
                }
                ss += __shfl_xor(ss, 16); ss += __shfl_xor(ss, 32);
                if (fq == 0) P3[(size_t)row * 32 + u.pn * 4 + wc] = ss;
            }
    }
};

struct PanelOrder {
    int c;
    __device__ bool next(int i, Unit& u) const { if (i >= 2) return false; const int x = c & 7, j = c >> 3; u.pm = i * 32 + x * 4 + (j >> 3); u.pn = j & 7; return true; }
};
struct EpiFF2N {
    static constexpr bool PERM = true, HAS_MID = false, AFTER_DRAIN = false;
    const bf16_t* h1; float* out; const float* gain; float* P3; unsigned* cnt;
    __device__ __forceinline__ void operator()(f32x4 (&acc)[2][2][4][2], const Unit& u, int ui, int wr, int wc, int fr, int fq) const {
        asm volatile("" : "+v"(fr), "+v"(fq));
        const int colw = u.pn * 256 + wc * 32 + 8 * fq;
#pragma unroll
        for (int ai = 0; ai < 2; ++ai)
#pragma unroll
            for (int m = 0; m < 4; ++m) {
                const int row = u.pm * 256 + ai * 128 + wr * 64 + m * 16 + fr; float ss = 0.f;
#pragma unroll
                for (int bj = 0; bj < 2; ++bj) {
                    const u32x4 hb = *(const u32x4*)(h1 + (size_t)row * DM + colw + bj * 128);
                    f32x4& a0 = acc[ai][bj][m][0]; f32x4& a1 = acc[ai][bj][m][1];
                    a0[0] += bf_lo(hb.x); a0[1] += bf_hi(hb.x); a0[2] += bf_lo(hb.y); a0[3] += bf_hi(hb.y);
                    a1[0] += bf_lo(hb.z); a1[1] += bf_hi(hb.z); a1[2] += bf_lo(hb.w); a1[3] += bf_hi(hb.w);
                    ss += (a0[0] * a0[0] + a0[1] * a0[1]) + (a0[2] * a0[2] + a0[3] * a0[3]) + (a1[0] * a1[0] + a1[1] * a1[1]) + (a1[2] * a1[2] + a1[3] * a1[3]);
                }
                ss += __shfl_xor(ss, 16); ss += __shfl_xor(ss, 32);
                if (fq == 0) __hip_atomic_store(P3 + (size_t)row * 32 + u.pn * 4 + wc, ss, __ATOMIC_RELAXED, __HIP_MEMORY_SCOPE_AGENT);
            }
        asm volatile("s_waitcnt vmcnt(0)" ::: "memory");
        unsigned* cp = cnt + 64 * u.pm;
        if ((fr | fq) == 0) __hip_atomic_fetch_add(cp, 1u, __ATOMIC_RELAXED, __HIP_MEMORY_SCOPE_AGENT);
        { unsigned sp = 0;
          while ((unsigned)__builtin_amdgcn_readfirstlane(__hip_atomic_load(cp, __ATOMIC_RELAXED, __HIP_MEMORY_SCOPE_AGENT)) < 64u) { __builtin_amdgcn_s_sleep(2); if (++sp > (1u << 22)) break; } }
        __builtin_amdgcn_fence(__ATOMIC_ACQUIRE, "agent");
        f32x4 g[2][2];
#pragma unroll
        for (int bj = 0; bj < 2; ++bj) { g[bj][0] = *(const f32x4*)(gain + colw + bj * 128); g[bj][1] = *(const f32x4*)(gain + colw + bj * 128 + 4); }
#pragma unroll
        for (int ai = 0; ai < 2; ++ai)
#pragma unroll
            for (int m = 0; m < 4; ++m) {
                const int row = u.pm * 256 + ai * 128 + wr * 64 + m * 16 + fr;
                const unsigned long long* pr = (const unsigned long long*)(P3 + (size_t)row * 32 + fq * 8); float s = 0.f;
#pragma unroll
                for (int k = 0; k < 4; ++k) { const unsigned long long w = __hip_atomic_load(pr + k, __ATOMIC_RELAXED, __HIP_MEMORY_SCOPE_AGENT); s += __uint_as_float((unsigned)w) + __uint_as_float((unsigned)(w >> 32)); }
                s += __shfl_xor(s, 16); s += __shfl_xor(s, 32);
                const float r = 1.0f / sqrtf(s * (1.0f / DM) + EPS);
#pragma unroll
                for (int bj = 0; bj < 2; ++bj) { float* op = out + (size_t)row * DM + colw + bj * 128;
                    *(f32x4*)op = acc[ai][bj][m][0] * r * g[bj][0]; *(f32x4*)(op + 4) = acc[ai][bj][m][1] * r * g[bj][1]; }
                asm volatile("" ::: "memory");
            }
    }
};

__device__ __forceinline__ float wave_sum(float v) {
#pragma unroll
    for (int o = 1; o < 64; o <<= 1) v += __shfl_xor(v, o);
    return v;
}
__device__ __forceinline__ void p0_transpose_item(const float* W, int K, int N, bf16_t* WT, const float* gain, const float* gain_hi, LAS float* scr, int item, int lane, int ldw = 0) {
    if (ldw == 0) ldw = K;
    const int nblk = N / 32, kb = item / nblk, nb = item % nblk, k0 = 64 * kb, n0 = 32 * nb;
    const float* gk = gain ? ((gain_hi && k0 >= 1024) ? gain_hi + (k0 - 1024) : gain + k0) : nullptr;
    float wv[32];
#pragma unroll
    for (int i = 0; i < 32; ++i) wv[i] = W[(size_t)(k0 + 2 * i + (lane >> 5)) * N + n0 + (lane & 31)];
#pragma unroll
    for (int i = 0; i < 32; ++i) { const int kk = 2 * i + (lane >> 5); float v = wv[i]; if (gk) v *= gk[kk]; scr[kk * 33 + (lane & 31)] = v; }
    asm volatile("s_waitcnt lgkmcnt(0)" ::: "memory");
    const int c = lane & 7;
#pragma unroll
    for (int j = 0; j < 4; ++j) { const int n = (lane >> 3) + 8 * j; const LAS float* s = scr + (8 * c) * 33 + n;
        u32x4 o; o.x = cvt_pk_bf16(s[0 * 33], s[1 * 33]); o.y = cvt_pk_bf16(s[2 * 33], s[3 * 33]); o.z = cvt_pk_bf16(s[4 * 33], s[5 * 33]); o.w = cvt_pk_bf16(s[6 * 33], s[7 * 33]);
        *(u32x4*)(WT + (size_t)(n0 + n) * ldw + k0 + 8 * c) = o; }
    asm volatile("s_waitcnt lgkmcnt(0)" ::: "memory");
}
__device__ __forceinline__ f32x2 cpow_k(float lre, float lim, float dt, int k) {
    const float mag = expf((float)k * lre * dt);
    const double rev = (double)k * (double)lim * (double)dt * 0.15915494309189535;
    const float fr = (float)(rev - rint(rev));
    return (f32x2){mag * __builtin_amdgcn_cosf(fr), mag * __builtin_amdgcn_sinf(fr)};
}

#define RLX_AGENT __ATOMIC_RELAXED, __HIP_MEMORY_SCOPE_AGENT
#define XB_TMO      128
#define XB_XCNT(j)  (256  + 64 * (j))
#define XB_XSUB(j)  (1280 + 64 * (j))
#define XB_XGEN(j)  (2304 + 64 * (j))
#define XB_TOP      3328
#define XB_TOPGEN   3392
#define XCD_BAR_WORDS 3456
#define XB_SPIN_CAP (1u << 22)
__device__ __forceinline__ unsigned xb_ld(unsigned* p)              { return __hip_atomic_load(p, __ATOMIC_RELAXED, __HIP_MEMORY_SCOPE_AGENT); }
__device__ __forceinline__ unsigned xb_add(unsigned* p, unsigned v) { return __hip_atomic_fetch_add(p, v, __ATOMIC_RELAXED, __HIP_MEMORY_SCOPE_AGENT); }
__device__ __forceinline__ unsigned xb_xcc_id() { return (unsigned)__builtin_amdgcn_s_getreg((3 << 11) | 20) & 0xFu; }
#define XB_SPIN(cond, bar) do { unsigned _sp = 0; while (cond) { __builtin_amdgcn_s_sleep(1); \
    if ((++_sp & 255u) == 0u) { if (xb_ld(&(bar)[XB_TMO])) break; if (_sp > XB_SPIN_CAP) { atomicAdd(&(bar)[XB_TMO], 1u); break; } } } } while (0)
struct XcdBarrier { unsigned* bar; unsigned x; volatile LAS unsigned* st; };
__device__ __forceinline__ XcdBarrier xcd_barrier_post(unsigned* bar, volatile LAS unsigned* st) {
    XcdBarrier b; b.bar = bar; b.x = xb_xcc_id(); b.st = st;
    if (threadIdx.x == 0) (void)xb_add(&bar[XB_XCNT(b.x)], 1u);
    return b;
}
__device__ __forceinline__ void xcd_barrier_complete(unsigned* bar, unsigned x, unsigned& nloc, unsigned& nx) {
    const unsigned G = gridDim.x * gridDim.y * gridDim.z;
    unsigned sum, cnt, mine, sp = 0u;
    for (;;) {
        sum = 0u; cnt = 0u; mine = 0u;
#pragma unroll
        for (unsigned j = 0; j < 16; ++j) { const unsigned c = xb_ld(&bar[XB_XCNT(j)]); sum += c; cnt += (c > 0u) ? 1u : 0u; mine = (j == x) ? c : mine; }
        if (sum == G) break;
        __builtin_amdgcn_s_sleep(1);
        if ((++sp & 255u) == 0u) { if (xb_ld(&bar[XB_TMO])) break; if (sp > XB_SPIN_CAP) { atomicAdd(&bar[XB_TMO], 1u); break; } }
    }
    nloc = mine > 0u ? mine : 1u; nx = cnt > 0u ? cnt : 1u;
}
__device__ __forceinline__ void xcd_barrier(const XcdBarrier& b) {
    asm volatile("s_waitcnt vmcnt(0)" ::: "memory");
    __syncthreads();
    if (threadIdx.x == 0) {
        unsigned* bar = b.bar;
        __builtin_amdgcn_s_waitcnt(0);
        unsigned nloc = b.st[0], nx = b.st[1];
        if (nloc == 0u) { xcd_barrier_complete(bar, b.x, nloc, nx); b.st[0] = nloc; b.st[1] = nx; }
        const unsigned old = xb_add(&bar[XB_XSUB(b.x)], 1u);
        const unsigned gen = old / nloc;
        if (old + 1u == (gen + 1u) * nloc) {
            __builtin_amdgcn_fence(__ATOMIC_RELEASE, "agent");
            asm volatile("s_waitcnt vmcnt(0)" ::: "memory");
            const unsigned og = xb_add(&bar[XB_TOP], 1u);
            const unsigned tg = og / nx;
            if (og + 1u == (tg + 1u) * nx) xb_add(&bar[XB_TOPGEN], 1u);
            else XB_SPIN(xb_ld(&bar[XB_TOPGEN]) == tg, bar);
            __builtin_amdgcn_fence(__ATOMIC_ACQUIRE, "agent");
            xb_add(&bar[XB_XGEN(b.x)], 1u);
            asm volatile("s_waitcnt vmcnt(0)" ::: "memory");
        } else {
            XB_SPIN(xb_ld(&bar[XB_XGEN(b.x)]) == gen, bar);
            __builtin_amdgcn_fence(__ATOMIC_ACQUIRE, "agent");
            asm volatile("s_waitcnt vmcnt(0)" ::: "memory");
        }
    }
    __syncthreads();
}

struct Params { const float* in[21]; float* out; unsigned char* ws; int ph_lo, ph_hi; };

__device__ __forceinline__ void p0_ssm_task(const Params& p, LAS unsigned char* lds, int g, int d, int tid) {
    LAS float* coef = (LAS float*)lds;
    LAS float* pd = coef + 128;
    LAS float* pd1 = pd + 128;
    LAS float* wre = pd1 + 128;
    LAS float* wim = wre + 1024;
    LAS float* cre = wim + 1024;
    LAS float* cim = cre + 1024;
    const float* a_re = p.in[2]; const float* a_im = p.in[3]; const float* log_dt = p.in[4];
    const float* b_re = p.in[5]; const float* b_im = p.in[6]; const float* c_re = p.in[7]; const float* c_im = p.in[8];
    bf16_t* TmE = (bf16_t*)(p.ws + WS_TME) + (size_t)g * 256 * KA;
    bf16_t* Ft = (bf16_t*)(p.ws + WS_FT) + (size_t)g * 256 * 256;
    if (tid < 64) {
        const int n = tid; const float dt = expf(log_dt[g]); const float lre = fminf(a_re[g * 64 + n], -1e-4f), lim = a_im[g * 64 + n];
        const f32x2 ab = cpow_k(lre, lim, dt, 1);
        const float den = lre * lre + lim * lim, nre = ab.x - 1.0f;
        coef[2 * n] = (nre * lre + ab.y * lim) / den; coef[2 * n + 1] = (ab.y * lre - nre * lim) / den;
        const f32x2 q = cpow_k(lre, lim, dt, d), q1 = cpow_k(lre, lim, dt, d + 1);
        pd[2 * n] = q.x; pd[2 * n + 1] = q.y; pd1[2 * n] = q1.x; pd1[2 * n + 1] = q1.y;
        if (d == 0) { const f32x2 q16 = cpow_k(lre, lim, dt, 16); *(f32x2*)((float*)(p.ws + WS_A16) + (size_t)(g * 64 + n) * 2) = q16; }
    }
    __syncthreads();
    for (int idx = tid; idx < 1024; idx += NTHR) {
        const int n = idx >> 4;
        const float br = b_re[(size_t)g * 1024 + idx], bi = b_im[(size_t)g * 1024 + idx], cr = coef[2 * n], ci = coef[2 * n + 1];
        const float bbr = cr * br - ci * bi, bbi = cr * bi + ci * br, pr = pd[2 * n], pi = pd[2 * n + 1];
        wre[idx] = pr * bbr - pi * bbi; wim[idx] = pr * bbi + pi * bbr;
        cre[idx] = c_re[(size_t)g * 1024 + idx]; cim[idx] = c_im[(size_t)g * 1024 + idx];
    }
    __syncthreads();
    if (tid < 256) {
        const int h = tid >> 4, h2 = tid & 15; float s = 0.f;
#pragma unroll 8
        for (int n = 0; n < 64; ++n) s += cre[h * 64 + n] * wre[n * 16 + h2] - cim[h * 64 + n] * wim[n * 16 + h2];
        const bf16_t kb = (bf16_t)(cvt_pk_bf16(s, 0.f) & 0xffffu);
        for (int t = d; t < 16; ++t) TmE[(size_t)(t * 16 + h) * KA + (t - d) * 16 + h2] = kb;
        if (d > 0) for (int t = 0; t < 16 - d; ++t) TmE[(size_t)(t * 16 + h) * KA + (t + d) * 16 + h2] = 0;
    } else {
        const int q = tid - 256;
#pragma unroll
        for (int r = 0; r < 4; ++r) {
            const int idx = q + 256 * r;
            { const int h = idx >> 6, n = idx & 63; const float pr = pd1[2 * n], pi = pd1[2 * n + 1], cr = cre[h * 64 + n], ci = cim[h * 64 + n];
              const unsigned w = cvt_pk_bf16(cr * pr - ci * pi, -(cr * pi + ci * pr));
              bf16_t* rowp = TmE + (size_t)(d * 16 + h) * KA + 256; rowp[n] = (bf16_t)(w & 0xffffu); rowp[64 + n] = (bf16_t)(w >> 16); }
            { const int n = idx >> 4, h2 = idx & 15, col = (15 - d) * 16 + h2; const unsigned w = cvt_pk_bf16(wre[idx], wim[idx]);
              Ft[(size_t)n * 256 + col] = (bf16_t)(w & 0xffffu); Ft[(size_t)(64 + n) * 256 + col] = (bf16_t)(w >> 16);
              Ft[(size_t)(128 + n) * 256 + col] = 0; Ft[(size_t)(192 + n) * 256 + col] = 0; }
        }
    }
    __syncthreads();
}

__device__ __forceinline__ void sgu_unit(const Params& p, LAS unsigned char* lds, int unit, int tid) {
    constexpr int LDT = 136;
    LAS bf16_t* At = (LAS bf16_t*)lds;
    LAS bf16_t* Bt = (LAS bf16_t*)(lds + 128 * LDT * 2);
    LAS float* rvs = (LAS float*)(lds + 2 * 128 * LDT * 2);
    const int h = unit & 7, bnb = unit >> 3, tok0 = bnb * 128;
    const float* PV = (const float*)(p.ws + WS_PV); const bf16_t* VB = (const bf16_t*)(p.ws + WS_VB); const bf16_t* UB = (const bf16_t*)(p.ws + WS_UB);
    bf16_t* Y = (bf16_t*)(p.ws + WS_Y); float* PB = (float*)(p.ws + WS_PB);
    const float* vgain = p.in[10]; const float* sw = p.in[11] + (size_t)h * 128 * 128; const float* sb = p.in[12] + h * 128;
    if (tid < 128) { const f32x4* pp = (const f32x4*)(PV + (size_t)(tok0 + tid) * 16); const f32x4 a = pp[0], b = pp[1], c = pp[2], d = pp[3];
        const float s = ((a[0] + a[1]) + (a[2] + a[3])) + ((b[0] + b[1]) + (b[2] + b[3])) + ((c[0] + c[1]) + (c[2] + c[3])) + ((d[0] + d[1]) + (d[2] + d[3]));
        rvs[tid] = 1.0f / sqrtf(s * (1.0f / 1024.0f) + EPS); }
    __syncthreads();
#pragma unroll
    for (int q = 0; q < 4; ++q) {
        const int pc = tid + NTHR * q, r = pc >> 4, c0 = (pc & 15) * 8;
        {
            const bool on = (c0 >> 6) <= (r >> 6);
            const f32x4 w0 = *(const f32x4*)(sw + r * 128 + c0), w1 = *(const f32x4*)(sw + r * 128 + c0 + 4);
            const f32x4 r0 = *(const LAS f32x4*)(rvs + c0), r1 = *(const LAS f32x4*)(rvs + c0 + 4);
            u32x4 o;
            if (on) { o.x = cvt_pk_bf16(w0[0] * r0[0], w0[1] * r0[1]); o.y = cvt_pk_bf16(w0[2] * r0[2], w0[3] * r0[3]); o.z = cvt_pk_bf16(w1[0] * r1[0], w1[1] * r1[1]); o.w = cvt_pk_bf16(w1[2] * r1[2], w1[3] * r1[3]); }
            else { o = (u32x4){0u, 0u, 0u, 0u}; }
            *(LAS u32x4*)(At + r * LDT + c0) = o;
        }
        {
            const int rt = pc & 127, ct0 = (pc >> 7) * 8;
            const u32x4 vv = *(const u32x4*)(VB + (size_t)(tok0 + rt) * 1024 + h * 128 + ct0);
            Bt[(ct0 + 0) * LDT + rt] = (bf16_t)(vv.x & 0xffffu); Bt[(ct0 + 1) * LDT + rt] = (bf16_t)(vv.x >> 16);
            Bt[(ct0 + 2) * LDT + rt] = (bf16_t)(vv.y & 0xffffu); Bt[(ct0 + 3) * LDT + rt] = (bf16_t)(vv.y >> 16);
            Bt[(ct0 + 4) * LDT + rt] = (bf16_t)(vv.z & 0xffffu); Bt[(ct0 + 5) * LDT + rt] = (bf16_t)(vv.z >> 16);
            Bt[(ct0 + 6) * LDT + rt] = (bf16_t)(vv.w & 0xffffu); Bt[(ct0 + 7) * LDT + rt] = (bf16_t)(vv.w >> 16);
        }
    }
    __syncthreads();
    const int w = tid >> 6, lane = tid & 63, fr = lane & 15, fq = lane >> 4;
    bf16x8 wf[4];
#pragma unroll
    for (int ks = 0; ks < 4; ++ks) wf[ks] = *(const LAS bf16x8*)(At + (16 * w + fr) * LDT + ks * 32 + fq * 8);
    const int i = 16 * w + fr; const size_t tok = (size_t)(tok0 + i); const float bsi = sb[i]; float ss = 0.f;
#pragma unroll
    for (int ct = 0; ct < 8; ++ct) {
        f32x4 acc = (f32x4){0.f, 0.f, 0.f, 0.f};
#pragma unroll
        for (int ks = 0; ks < 4; ++ks) { const bf16x8 vf = *(const LAS bf16x8*)(Bt + (16 * ct + fr) * LDT + ks * 32 + fq * 8); acc = __builtin_amdgcn_mfma_f32_16x16x32_bf16(vf, wf[ks], acc, 0, 0, 0); }
        const int c = 16 * ct + 4 * fq;
        const u32x2 uu = *(const u32x2*)(UB + tok * 1024 + h * 128 + c); const f32x4 vg = *(const f32x4*)(vgain + h * 128 + c);
        const float o0 = bf_lo(uu.x) * (vg[0] * acc[0] + bsi), o1 = bf_hi(uu.x) * (vg[1] * acc[1] + bsi), o2 = bf_lo(uu.y) * (vg[2] * acc[2] + bsi), o3 = bf_hi(uu.y) * (vg[3] * acc[3] + bsi);
        ss += (o0 * o0 + o1 * o1) + (o2 * o2 + o3 * o3);
        u32x2 wv; wv.x = cvt_pk_bf16(o0, o1); wv.y = cvt_pk_bf16(o2, o3);
        *(u32x2*)(Y + tok * DM + DSSM + h * 128 + c) = wv;
    }
    ss += __shfl_xor(ss, 16); ss += __shfl_xor(ss, 32);
    if (fq == 0) PB[tok * 8 + h] = ss;
    __syncthreads();
}

__device__ __forceinline__ void carry_task(const Params& p, int g, int tid) {
    const int b = tid >> 6, n = tid & 63;
    const float* S = (const float*)(p.ws + WS_S); bf16_t* Ap = (bf16_t*)(p.ws + WS_AP);
    const f32x2 a16 = *(const f32x2*)((const float*)(p.ws + WS_A16) + (size_t)(g * 64 + n) * 2);
    float hr = 0.f, hi = 0.f; const size_t row0 = (size_t)g * 1024 + b * 128;
#pragma unroll 8
    for (int c = 0; c < NCH; ++c) {
        const size_t row = row0 + c; const float sr = S[row * 128 + n], si = S[row * 128 + 64 + n];
        const unsigned w = cvt_pk_bf16(hr, hi);
        Ap[row * KA + 256 + n] = (bf16_t)(w & 0xffffu); Ap[row * KA + 320 + n] = (bf16_t)(w >> 16);
        const float nr = a16.x * hr - a16.y * hi + sr, ni = a16.x * hi + a16.y * hr + si; hr = nr; hi = ni;
    }
}

__device__ __forceinline__ void convert_share(const Params& p, LAS unsigned char* lds, int sel, int gw, int NGW, int wave, int lane) {
    LAS float* scr = (LAS float*)(lds + wave * 16384); unsigned char* ws = p.ws;
    constexpr int I_OUT = (DM / 64) * (DM / 32), I_1 = (DM / 64) * (DFF / 32), I_2 = (DFF / 64) * (DM / 32);
    if (sel == 0) { for (int it = gw; it < I_OUT; it += NGW) p0_transpose_item(p.in[15], DM, DM, (bf16_t*)(ws + WS_WOUT), p.in[13], p.in[14], scr, it, lane); }
    else if (sel == 2) { for (int it = gw; it < I_1; it += NGW) p0_transpose_item(p.in[18], DM, DFF, (bf16_t*)(ws + WS_W1), p.in[17], nullptr, scr, it, lane); }
    else { for (int it = gw; it < I_2; it += NGW) p0_transpose_item(p.in[19], DFF, DM, (bf16_t*)(ws + WS_W2P), nullptr, nullptr, scr, it, lane, LDH); }
}

__global__ void __launch_bounds__(NTHR, 2) fwd_megakernel(Params p) {
    extern __shared__ __attribute__((aligned(16))) unsigned char lds_raw[];
    LAS unsigned char* lds = (LAS unsigned char*)lds_raw;
    cg::grid_group grid = cg::this_grid();
    const int tid = threadIdx.x, lane = tid & 63, wave = __builtin_amdgcn_readfirstlane(tid >> 6);
    const int G = gridDim.x, bx = blockIdx.x;
    const int lo = p.ph_lo, hi = p.ph_hi;
    unsigned char* ws = p.ws;
#ifndef PH_MASK
#define PH_MASK 0x7f
#endif
#define IN(k) (((PH_MASK >> (k)) & 1) && lo <= (k) && (k) < hi)
    volatile LAS unsigned* MISC = (volatile LAS unsigned*)(lds + MISC_OFF);
    if (tid < 64) MISC[tid] = 0u;
    __syncthreads();
    XcdBarrier xbar = xcd_barrier_post((unsigned*)ws, MISC);
#define SEAM(k) do { if (IN(k) && IN((k) + 1)) xcd_barrier(xbar); } while (0)
    if (hi > 64) grid.sync();

    if (IN(0)) {
        LAS float* scr = (LAS float*)(lds + wave * 16384);
        const int gw = bx * NWAVES + wave, NGW = G * NWAVES;
        constexpr int I_IN = (DM / 64) * (DIN / 32);
        for (int it = gw; it < I_IN; it += NGW) p0_transpose_item(p.in[1], DM, DIN, (bf16_t*)(ws + WS_WIN), nullptr, nullptr, scr, it, lane);
        const float* x = p.in[0]; const float* mg = p.in[16]; bf16_t* XN = (bf16_t*)(ws + WS_XN);
        for (int m = gw; m < M; m += NGW) {
            const f32x4* xr = (const f32x4*)(x + (size_t)m * DM) + lane; f32x4 v[8]; float s = 0.f;
#pragma unroll
            for (int j = 0; j < 8; ++j) { v[j] = xr[64 * j]; s += (v[j][0] * v[j][0] + v[j][1] * v[j][1]) + (v[j][2] * v[j][2] + v[j][3] * v[j][3]); }
            const float r = 1.0f / sqrtf(wave_sum(s) * (1.0f / DM) + EPS);
            u32x2* o = (u32x2*)(XN + (size_t)m * DM) + lane;
#pragma unroll
            for (int j = 0; j < 8; ++j) { const f32x4 gg = *((const f32x4*)mg + 64 * j + lane); u32x2 w; w.x = cvt_pk_bf16(v[j][0] * r * gg[0], v[j][1] * r * gg[1]); w.y = cvt_pk_bf16(v[j][2] * r * gg[2], v[j][3] * r * gg[3]); o[64 * j] = w; }
        }
    }
    SEAM(0);
    if (IN(1)) {
        pg8::Gemm g{(const bf16_t*)(ws + WS_XN), (const bf16_t*)(ws + WS_WIN), DM, DM, DM}; pg8::StaticOrder S; S.init(M, DIN, G, bx);
        EpiProj E{(bf16_t*)(ws + WS_AP), (bf16_t*)(ws + WS_SG), (bf16_t*)(ws + WS_UB), (bf16_t*)(ws + WS_VB), (float*)(ws + WS_PV)};
        const bool late = ((bx >> 3) & 1) != 0; const int gw = bx * NWAVES + wave, NGW = G * NWAVES;
        if (late) { for (int t = bx; t < NG * 16; t += G) p0_ssm_task(p, lds, t >> 4, t & 15, tid); convert_share(p, lds, 0, gw, NGW, wave, lane); __syncthreads(); }
        pg8::gemm_phase<EpiProj, pg8::StaticOrder, false>(lds, g, S, E);
        if (!late) { for (int t = bx; t < NG * 16; t += G) p0_ssm_task(p, lds, t >> 4, t & 15, tid); convert_share(p, lds, 0, gw, NGW, wave, lane); }
    }
    SEAM(1);
    if (IN(2)) {
        pg8::GroupOrder GO; GO.init(G, bx);
        for (int i = 0;; ++i) {
            Unit u; if (!GO.next(i, u)) break;
            pg8::OneUnit S1{u.pm, u.pn};
            { pg8::Gemm g{(const bf16_t*)(ws + WS_AP), (const bf16_t*)(ws + WS_FT), KA, 256, 256}; EpiS E{};
              pg8::gemm_phase<EpiS, pg8::OneUnit, false>(lds, g, S1, E); }
            __syncthreads();
            if (tid < 128) {
                const int b2 = tid >> 6, n = tid & 63; const LAS float* S = (const LAS float*)lds + (b2 * 128) * 132 + n;
                bf16_t* hp = (bf16_t*)(ws + WS_AP) + ((size_t)u.pm * 256 + b2 * 128) * KA + 256 + n;
                const f32x2 a16 = *(const f32x2*)((const float*)(ws + WS_A16) + (size_t)(u.pn * 64 + n) * 2);
                float hr = 0.f, hi = 0.f;
#pragma unroll 8
                for (int c = 0; c < NCH; ++c) {
                    const float sr = S[c * 132], si = S[c * 132 + 64];
                    const unsigned w = cvt_pk_bf16(hr, hi);
                    hp[(size_t)c * KA] = (bf16_t)(w & 0xffffu); hp[(size_t)c * KA + 64] = (bf16_t)(w >> 16);
                    const float nr = a16.x * hr - a16.y * hi + sr, ni = a16.x * hi + a16.y * hr + si; hr = nr; hi = ni;
                }
            }
            asm volatile("s_waitcnt vmcnt(0)" ::: "memory");
            __syncthreads();
            { pg8::Gemm g{(const bf16_t*)(ws + WS_AP), (const bf16_t*)(ws + WS_TME), KA, KA, KA};
              EpiSsm E{(const bf16_t*)(ws + WS_AP), (const bf16_t*)(ws + WS_SG), p.in[9], (bf16_t*)(ws + WS_Y), (float*)(ws + WS_PA)};
              pg8::gemm_phase<EpiSsm, pg8::OneUnit, true>(lds, g, S1, E); }
        }
        for (int uu = bx; uu < 1024; uu += G) sgu_unit(p, lds, uu, tid);
    }
    SEAM(2);
    if (IN(3)) {
        pg8::StaticOrder S; S.init(M, DM, G, bx);
        LAS f32x2* tab = (LAS f32x2*)(lds + TAB_OFF);
        const float* PA = (const float*)(ws + WS_PA); const float* PB = (const float*)(ws + WS_PB);
        for (int idx = tid; idx < TAB_BYTES / 8; idx += NTHR) {
            Unit u; if (!S.next(idx >> 8, u)) break;
            const int row = u.pm * 256 + (idx & 255); const f32x4* pa = (const f32x4*)(PA + (size_t)row * 64); float sa = 0.f;
#pragma unroll
            for (int j = 0; j < 16; ++j) { const f32x4 v = pa[j]; sa += (v[0] + v[1]) + (v[2] + v[3]); }
            const f32x4* pb = (const f32x4*)(PB + (size_t)row * 8); const f32x4 b0 = pb[0], b1 = pb[1]; const float sbb = ((b0[0] + b0[1]) + (b0[2] + b0[3])) + ((b1[0] + b1[1]) + (b1[2] + b1[3]));
            const float ra = 1.0f / sqrtf(sa * (1.0f / 1024.0f) + EPS), rb = 1.0f / sqrtf(sbb * (1.0f / 1024.0f) + EPS);
            tab[idx] = (f32x2){ra / rb, rb};
        }
        __syncthreads();
        pg8::Gemm g{(const bf16_t*)(ws + WS_Y), (const bf16_t*)(ws + WS_WOUT), DM, DM, DM};
        EpiOut E{p.in[0], (bf16_t*)(ws + WS_H1B), (float*)(ws + WS_P2), tab};
        const bool late = ((bx >> 3) & 1) != 0; const int gw = bx * NWAVES + wave, NGW = G * NWAVES;
        if (late) { convert_share(p, lds, 2, gw, NGW, wave, lane); __syncthreads(); }
        pg8::gemm_phase<EpiOut, pg8::StaticOrder, false>(lds, g, S, E);
        if (!late) convert_share(p, lds, 2, gw, NGW, wave, lane);
    }
    SEAM(3);
    if (IN(4)) {
        pg8::StaticOrder S; S.init(M, DFF, G, bx);
        LAS float* tab = (LAS float*)(lds + TAB_OFF);
        const float* P2 = (const float*)(ws + WS_P2);
        for (int idx = tid; idx < TAB_BYTES / 4; idx += NTHR) {
            Unit u; if (!S.next(idx >> 8, u)) break;
            const int row = u.pm * 256 + (idx & 255); const f32x4* pp = (const f32x4*)(P2 + (size_t)row * 32); float s = 0.f;
#pragma unroll
            for (int j = 0; j < 8; ++j) { const f32x4 v = pp[j]; s += (v[0] + v[1]) + (v[2] + v[3]); }
            tab[idx] = 1.0f / sqrtf(s * (1.0f / DM) + EPS);
        }
        __syncthreads();
        pg8::Gemm g{(const bf16_t*)(ws + WS_H1B), (const bf16_t*)(ws + WS_W1), DM, DM, DM};
        EpiFF1 E{(bf16_t*)(ws + WS_HID), tab};
        const bool late = ((bx >> 3) & 1) != 0; const int gw = bx * NWAVES + wave, NGW = G * NWAVES;
        if (late) { convert_share(p, lds, 1, gw, NGW, wave, lane); __syncthreads(); }
        pg8::gemm_phase<EpiFF1, pg8::StaticOrder, false>(lds, g, S, E);
        if (!late) convert_share(p, lds, 1, gw, NGW, wave, lane);
    }
    SEAM(4);
    const bool fused_norm = (G == 256);
    if (IN(5)) {
        pg8::Gemm g{(const bf16_t*)(ws + WS_HID), (const bf16_t*)(ws + WS_W2P), LDH, LDH, DFF};
        if (fused_norm) {
            PanelOrder S{bx};
            EpiFF2N E{(const bf16_t*)(ws + WS_H1B), p.out, p.in[20], (float*)(ws + WS_P3), (unsigned*)ws + 4096};
            pg8::gemm_phase<EpiFF2N, PanelOrder, true>(lds, g, S, E);
        } else {
            pg8::StaticOrder S; S.init(M, DM, G, bx);
            EpiFF2 E{(bf16_t*)(ws + WS_H1B), (float*)(ws + WS_P3)};
            pg8::gemm_phase<EpiFF2, pg8::StaticOrder, true>(lds, g, S, E);
        }
    }
    if (!fused_norm) SEAM(5);
    if (IN(6) && !fused_norm) {
        const int gw = bx * NWAVES + wave, NGW = G * NWAVES; const float* P3 = (const float*)(ws + WS_P3); const float* fg = p.in[20]; const bf16_t* H2 = (const bf16_t*)(ws + WS_H1B);
        for (int m = gw; m < M; m += NGW) {
            const float ps = (lane < 32) ? P3[(size_t)m * 32 + lane] : 0.f;
            const u32x4* hr = (const u32x4*)(H2 + (size_t)m * DM) + lane; u32x4 hv[4];
#pragma unroll
            for (int j = 0; j < 4; ++j) hv[j] = hr[64 * j];
            const float r = 1.0f / sqrtf(wave_sum(ps) * (1.0f / DM) + EPS);
            f32x4* orow = (f32x4*)(p.out + (size_t)m * DM) + 2 * lane;
#pragma unroll
            for (int j = 0; j < 4; ++j) { const f32x4 g0 = *((const f32x4*)fg + 128 * j + 2 * lane), g1 = *((const f32x4*)fg + 128 * j + 2 * lane + 1);
                f32x4 o0 = {bf_lo(hv[j].x), bf_hi(hv[j].x), bf_lo(hv[j].y), bf_hi(hv[j].y)}, o1 = {bf_lo(hv[j].z), bf_hi(hv[j].z), bf_lo(hv[j].w), bf_hi(hv[j].w)};
                orow[128 * j] = o0 * r * g0; orow[128 * j + 1] = o1 * r * g1; }
        }
    }
#ifdef DBG_STOP
    grid.sync();
    {
        const size_t NT = (size_t)M * DM; const size_t gt = (size_t)bx * NTHR + tid, gs = (size_t)G * NTHR;
        const bf16_t* XN = (const bf16_t*)(ws + WS_XN); const bf16_t* WINp = (const bf16_t*)(ws + WS_WIN); const bf16_t* WOUTp = (const bf16_t*)(ws + WS_WOUT);
        const bf16_t* W1p = (const bf16_t*)(ws + WS_W1); const bf16_t* W2p = (const bf16_t*)(ws + WS_W2); const bf16_t* TMEp = (const bf16_t*)(ws + WS_TME); const bf16_t* FTp = (const bf16_t*)(ws + WS_FT);
        const bf16_t* SGp = (const bf16_t*)(ws + WS_SG); const bf16_t* UBp = (const bf16_t*)(ws + WS_UB); const bf16_t* VBp = (const bf16_t*)(ws + WS_VB); const bf16_t* APp = (const bf16_t*)(ws + WS_AP);
        const bf16_t* Yp = (const bf16_t*)(ws + WS_Y); const bf16_t* H1Bp = (const bf16_t*)(ws + WS_H1B); const bf16_t* HIDp = (const bf16_t*)(ws + WS_HID);
        const float* Sp = (const float*)(ws + WS_S); const float* PVp = (const float*)(ws + WS_PV); const float* PAp = (const float*)(ws + WS_PA); const float* PBp = (const float*)(ws + WS_PB);
        const float* P2p = (const float*)(ws + WS_P2); const float* P3p = (const float*)(ws + WS_P3);
#define BFV(p, i) __uint_as_float(((unsigned)(p)[(i)]) << 16)
        for (size_t i = gt; i < NT; i += gs) {
            float v = 0.f;
            if (DBG_STOP == 0) v = BFV(XN, i) + BFV(WINp, i % (size_t)(DIN * DM)) + BFV(WOUTp, i % (size_t)(DM * DM)) + BFV(W1p, i % (size_t)(DFF * DM)) + BFV(W2p, i % (size_t)(DFF * DM)) + BFV(TMEp, i % (size_t)(64 * 256 * KA)) + BFV(FTp, i % (size_t)(64 * 256 * 256));
            if (DBG_STOP == 1) { const size_t e = i % (size_t)(65536 * 256); v = BFV(SGp, i % (size_t)(M * 1024)) + 0.f * (float)(e & 1); }
            if (DBG_STOP == 2) v = Sp[i % (size_t)(65536 * 128)];
            if (DBG_STOP == 3) { const size_t e = i % (size_t)(65536 * 128), y = i % (size_t)(M * 1024); v = BFV(APp, (e >> 7) * KA + 256 + (e & 127)) + BFV(Yp, (y >> 10) * DM + 1024 + (y & 1023)) + PBp[i % (size_t)(M * 8)]; }
            if (DBG_STOP == 4) { const size_t y = i % (size_t)(M * 1024); v = BFV(Yp, (y >> 10) * DM + (y & 1023)) + PAp[i % (size_t)(M * 64)]; }
            if (DBG_STOP == 5) v = p.out[i] + BFV(H1Bp, i) + P2p[i % (size_t)(M * 32)];
            if (DBG_STOP == 6) v = BFV(HIDp, i) + BFV(HIDp, i + NT) + BFV(HIDp, i + 2 * NT) + BFV(HIDp, i + 3 * NT);
            if (DBG_STOP == 7) v = p.out[i] + P3p[i % (size_t)(M * 32)];
            p.out[i] = v;
        }
    }
#endif
#undef IN
#undef SEAM
}

extern "C" void kernel_launch(void* const* d_in, const int* in_sizes, int n_in, void* d_out, int out_size, void* d_ws, size_t ws_size, hipStream_t stream) {
    static int grid = 0;
    if (grid == 0) {
        if (n_in != 21 || out_size != M * DM || ws_size < WS_END) { fprintf(stderr, "kernel_launch: unexpected shapes (n_in %d, out %d, ws %zu)\n", n_in, out_size, ws_size); grid = -1; return; }
        int dev = 0, cus = 0, per_cu = 0;
        hipGetDevice(&dev); hipDeviceGetAttribute(&cus, hipDeviceAttributeMultiprocessorCount, dev);
        if (hipFuncSetAttribute((const void*)fwd_megakernel, hipFuncAttributeMaxDynamicSharedMemorySize, LDS_BYTES) != hipSuccess) { fprintf(stderr, "kernel_launch: hipFuncSetAttribute failed\n"); grid = -1; return; }
        if (hipOccupancyMaxActiveBlocksPerMultiprocessor(&per_cu, (const void*)fwd_megakernel, NTHR, LDS_BYTES) != hipSuccess || per_cu < 1) { fprintf(stderr, "kernel_launch: occupancy query failed (%d)\n", per_cu); (void)hipGetLastError(); per_cu = 1; }
        grid = cus * per_cu;
        if (grid > 256) grid = 256;
    }
    if (grid < 0) return;
#ifdef DIAG_POISON_WS
    (void)hipMemsetAsync((unsigned char*)d_ws, 0xAA, WS_END, stream);
#endif
    Params p{};
    for (int i = 0; i < 21; ++i) p.in[i] = (const float*)d_in[i];
    p.out = (float*)d_out; p.ws = (unsigned char*)d_ws;
#if MK_MULTI
    for (int ph = 0; ph < 7; ++ph) { p.ph_lo = ph; p.ph_hi = ph + 1; hipLaunchKernelGGL(fwd_megakernel, dim3(grid), dim3(NTHR), LDS_BYTES, stream, p); }
#else
#ifdef DBG_STOP
    p.ph_lo = 0; p.ph_hi = DBG_STOP + 1;
#else
    p.ph_lo = 0; p.ph_hi = 7;
#endif
    (void)hipMemsetAsync(d_ws, 0, 32768, stream);
    void* args[] = {&p};
    hipError_t e = hipLaunchCooperativeKernel((const void*)fwd_megakernel, dim3(grid), dim3(NTHR), args, LDS_BYTES, stream);
    if (e != hipSuccess) fprintf(stderr, "cooperative launch failed: %s (grid %d)\n", hipGetErrorString(e), grid);
#endif
}
```
